# Optimizing an MI355X kernel written in HIP

```python
import jax, jax.numpy as jnp
from jax import lax
import numpy as np

D_MODEL = 1024
BATCH = 32
SEQ = 2048
DEPTH = 1

FOX_HEADS = 8
FOX_HEAD_DIM = 64
FOX_WIDTH = FOX_HEADS * FOX_HEAD_DIM
RET_HEADS = 4
RET_HEAD_DIM = 128
RET_WIDTH = RET_HEADS * RET_HEAD_DIM
MIX_WIDTH = FOX_WIDTH + RET_WIDTH
D_FF = 4 * D_MODEL
Q_BLOCK = 128
RET_CHUNK = 128
ROPE_BASE = 10000.0
EPS = 1e-6
N_MOD = 6
IN_COLS = 4 * FOX_WIDTH + FOX_HEADS + 4 * RET_WIDTH

kernel_name = "hybrid_fox_retention_adaln_block"


def _rms(x):
    x32 = x.astype(jnp.float32)
    return x32 * lax.rsqrt(jnp.mean(x32 * x32, axis=-1, keepdims=True) + EPS)


def _rope(x):
    s, d = x.shape[1], x.shape[-1]
    pos = jnp.arange(s, dtype=jnp.float32)
    inv_freq = ROPE_BASE ** (-jnp.arange(0, d, 2, dtype=jnp.float32) / d)
    ang = pos[:, None] * inv_freq[None, :]
    cos = jnp.cos(ang)[None, :, None, :]
    sin = jnp.sin(ang)[None, :, None, :]
    x32 = x.astype(jnp.float32)
    x1, x2 = x32[..., : d // 2], x32[..., d // 2:]
    return jnp.concatenate([x1 * cos - x2 * sin, x1 * sin + x2 * cos], axis=-1).astype(x.dtype)


def _forgetting_attention(q, k, v, log_f):
    b, s, h, d = q.shape
    scale = 1.0 / np.sqrt(d)
    cum = jnp.cumsum(log_f, axis=1).transpose(0, 2, 1)
    qh = q.transpose(0, 2, 1, 3)
    kh = k.transpose(0, 2, 1, 3)
    vh = v.transpose(0, 2, 1, 3)
    outs = []
    for blk in range(s // Q_BLOCK):
        s0, s1 = blk * Q_BLOCK, (blk + 1) * Q_BLOCK
        logits = jnp.einsum('bhqd,bhkd->bhqk', qh[:, :, s0:s1], kh[:, :, :s1]).astype(jnp.float32) * scale
        logits = logits + cum[:, :, s0:s1, None] - cum[:, :, None, :s1]
        q_pos = jnp.arange(s0, s1)[:, None]
        k_pos = jnp.arange(s1)[None, :]
        logits = jnp.where(q_pos >= k_pos, logits, -jnp.inf)
        p = jax.nn.softmax(logits, axis=-1).astype(v.dtype)
        outs.append(jnp.einsum('bhqk,bhkd->bhqd', p, vh[:, :, :s1]))
    out = jnp.concatenate(outs, axis=2)
    return out.transpose(0, 2, 1, 3)


def _retention(q, k, v):
    b, s, h, dk = q.shape
    dv = v.shape[-1]
    n_chunks = s // RET_CHUNK
    log_g = jnp.log(1.0 - 2.0 ** (-5.0 - jnp.arange(h, dtype=jnp.float32)))
    n = jnp.arange(RET_CHUNK, dtype=jnp.float32)
    diff = n[:, None] - n[None, :]
    decay_mask = jnp.where(diff[None] >= 0,
                           jnp.exp(jnp.maximum(diff, 0.0)[None] * log_g[:, None, None]), 0.0)
    xi = jnp.exp((n[None, :] + 1.0) * log_g[:, None])
    zeta = jnp.exp((RET_CHUNK - 1.0 - n[None, :]) * log_g[:, None])
    g_chunk = jnp.exp(RET_CHUNK * log_g)

    def to_chunks(t):
        return t.astype(jnp.float32).reshape(b, n_chunks, RET_CHUNK, h, t.shape[-1]).transpose(1, 0, 3, 2, 4)

    qc, kc, vc = to_chunks(q), to_chunks(k * (dk ** -0.5)), to_chunks(v)

    def step(state, inp):
        qi, ki, vi = inp
        inner = jnp.einsum('bhnd,bhmd->bhnm', qi, ki) * decay_mask[None]
        inner_out = jnp.einsum('bhnm,bhmv->bhnv', inner, vi)
        cross_out = jnp.einsum('bhnd,bhdv->bhnv', qi, state) * xi[None, :, :, None]
        new_state = state * g_chunk[None, :, None, None] + \
            jnp.einsum('bhmd,bhmv->bhdv', ki * zeta[None, :, :, None], vi)
        return new_state, inner_out + cross_out

    state0 = jnp.zeros((b, h, dk, dv), jnp.float32)
    _, out = lax.scan(step, state0, (qc, kc, vc))
    return out.transpose(1, 0, 3, 2, 4).reshape(b, s, h, dv)


def setup_inputs(seed: int = 0) -> dict:
    key = jax.random.key(seed)
    ks = jax.random.split(key, 16)
    nrm = jax.random.normal
    f32 = jnp.float32
    return {
        "x": nrm(ks[0], (BATCH, SEQ, D_MODEL), f32),
        "c": nrm(ks[1], (BATCH, D_MODEL), f32),
        "w_ada": nrm(ks[2], (DEPTH, D_MODEL, N_MOD * D_MODEL), f32) * (0.5 * D_MODEL ** -0.5),
        "b_ada": nrm(ks[3], (DEPTH, N_MOD * D_MODEL), f32) * 0.02,
        "w_in": nrm(ks[4], (DEPTH, D_MODEL, IN_COLS), f32) * D_MODEL ** -0.5,
        "b_forget": 2.0 + 0.5 * nrm(ks[5], (DEPTH, FOX_HEADS), f32),
        "q_norm_gain": 1.0 + 0.05 * nrm(ks[6], (DEPTH, FOX_HEAD_DIM), f32),
        "k_norm_gain": 1.0 + 0.05 * nrm(ks[7], (DEPTH, FOX_HEAD_DIM), f32),
        "fox_out_gain": 1.0 + 0.05 * nrm(ks[8], (DEPTH, FOX_HEADS, FOX_HEAD_DIM), f32),
        "ret_out_gain": 1.0 + 0.05 * nrm(ks[9], (DEPTH, RET_HEADS, RET_HEAD_DIM), f32),
        "w_out": nrm(ks[10], (DEPTH, MIX_WIDTH, D_MODEL), f32) * MIX_WIDTH ** -0.5,
        "w_mlp_in": nrm(ks[11], (DEPTH, D_MODEL, D_FF), f32) * D_MODEL ** -0.5,
        "w_mlp_out": nrm(ks[12], (DEPTH, D_FF, D_MODEL), f32) * D_FF ** -0.5,
    }


def reference(x, c, w_ada, b_ada, w_in, b_forget, q_norm_gain, k_norm_gain,
              fox_out_gain, ret_out_gain, w_out, w_mlp_in, w_mlp_out):
    b, s, _ = x.shape
    dt = x.dtype
    c_act = jax.nn.silu(c)
    o_fq, o_fk, o_fv, o_fog = 0, FOX_WIDTH, 2 * FOX_WIDTH, 3 * FOX_WIDTH
    o_ff = 4 * FOX_WIDTH
    o_rq = o_ff + FOX_HEADS
    o_rk, o_rv, o_rg = o_rq + RET_WIDTH, o_rq + 2 * RET_WIDTH, o_rq + 3 * RET_WIDTH
    for l in range(DEPTH):
        mod = jnp.einsum('bd,de->be', c_act, w_ada[l]) + b_ada[l]
        shift_m, scale_m, gate_m, shift_f, scale_f, gate_f = [m[:, None, :] for m in jnp.split(mod, N_MOD, axis=-1)]

        h = (_rms(x) * (1.0 + scale_m) + shift_m).astype(dt)
        proj = jnp.einsum('bsd,de->bse', h, w_in[l])

        fq = proj[..., o_fq:o_fk].reshape(b, s, FOX_HEADS, FOX_HEAD_DIM)
        fk = proj[..., o_fk:o_fv].reshape(b, s, FOX_HEADS, FOX_HEAD_DIM)
        fv = proj[..., o_fv:o_fog].reshape(b, s, FOX_HEADS, FOX_HEAD_DIM)
        f_og = proj[..., o_fog:o_ff]
        f_logit = proj[..., o_ff:o_rq]
        fq = (_rms(fq) * q_norm_gain[l]).astype(dt)
        fk = (_rms(fk) * k_norm_gain[l]).astype(dt)
        log_f = jax.nn.log_sigmoid(f_logit.astype(jnp.float32) + b_forget[l])
        fox = _forgetting_attention(fq, fk, fv, log_f)
        fox = (_rms(fox) * fox_out_gain[l]).reshape(b, s, FOX_WIDTH) * jax.nn.sigmoid(f_og.astype(jnp.float32))

        rq = _rope(proj[..., o_rq:o_rk].reshape(b, s, RET_HEADS, RET_HEAD_DIM))
        rk = _rope(proj[..., o_rk:o_rv].reshape(b, s, RET_HEADS, RET_HEAD_DIM))
        rv = proj[..., o_rv:o_rg].reshape(b, s, RET_HEADS, RET_HEAD_DIM)
        r_gate = proj[..., o_rg:]
        ret = _retention(rq, rk, rv)
        ret = (_rms(ret) * ret_out_gain[l]).reshape(b, s, RET_WIDTH) * jax.nn.silu(r_gate.astype(jnp.float32))

        mixed = jnp.concatenate([fox, ret], axis=-1).astype(dt)
        x = x + gate_m * jnp.einsum('bse,ed->bsd', mixed, w_out[l])

        h = (_rms(x) * (1.0 + scale_f) + shift_f).astype(dt)
        u = jnp.square(jax.nn.relu(jnp.einsum('bsd,df->bsf', h, w_mlp_in[l])))
        x = x + gate_f * jnp.einsum('bsf,fd->bsd', u, w_mlp_out[l])
    return x
```

```cpp
#include <hip/hip_runtime.h>
#include <cstdio>
#include <cstdint>
#include <cmath>
namespace pg8 {
#define PG8_LAS __attribute__((address_space(3)))
typedef unsigned short bf16_t;
typedef short bf16x8 __attribute__((ext_vector_type(8)));
typedef float f32x4 __attribute__((ext_vector_type(4)));
typedef unsigned u32x4 __attribute__((ext_vector_type(4)));
constexpr int BM = 256, BK = 64, HALF = 128, HTB = HALF * BK * 2  , STAGE_BYTES = 8 * HTB, NXCD = 8, WGM = 8;

__host__ __device__ __forceinline__ int lds_byte(int r, int c) { const int st = (r >> 4) * 2 + (c >> 5), rr = r & 15, cc = c & 31, ob = rr * 64 + cc * 2; return st * 1024 + (ob ^ (((ob >> 9) & 1) << 5)); }
__host__ __device__ __forceinline__ void stage_rc(int b, int& R, int& C) { const int st = b / 1024, sb = b % 1024, swz = sb ^ (((sb >> 9) & 1) << 5); R = (st >> 1) * 16 + swz / 64; C = (st & 1) * 32 + (swz % 64) / 2; }
__host__ __device__ __forceinline__ int perm32(int rho) { const int n = rho >> 4, i = rho & 15; return 8 * (i >> 2) + 4 * n + (i & 3); }

struct Unit { int pm, pn; };
struct Gemm { const bf16_t* A; const bf16_t* Bt; int M, N, K; };

struct StaticOrder {
    int nM, nN, nwg, G, c;
    __host__ __device__ void init(int M, int N, int G_, int c_) { nM = M / BM; nN = N / BM; nwg = nM * nN; G = G_; c = c_; }
    __host__ __device__ bool next(int i, Unit& u) const {
        const long L = (long)i * G + c; if (L >= nwg) return false;
        int wgid = (int)L; { const int q = nwg / NXCD, r = nwg % NXCD, xcd = wgid % NXCD, off = wgid / NXCD; wgid = (xcd < r ? xcd * (q + 1) : r * (q + 1) + (xcd - r) * q) + off; }
        const int nig = WGM * nN, gid = wgid / nig, fm = gid * WGM, gsz = (nM - fm) < WGM ? (nM - fm) : WGM;
        u.pm = fm + ((wgid % nig) % gsz); u.pn = (wgid % nig) / gsz; return true;
    }
    __device__ __forceinline__ void a_ready(const Unit&) const {}
    __device__ __forceinline__ void done(const Unit&) const {}
};

__device__ __forceinline__ unsigned cvt_pk_bf16(float lo, float hi) { unsigned r; asm volatile("v_cvt_pk_bf16_f32 %0, %1, %2" : "=v"(r) : "v"(lo), "v"(hi)); return r; }

template <int ACT> struct EpiBf16 {
    static constexpr bool PERM = true, AFTER_DRAIN = false;
    bf16_t* O; int ldc;
    __device__ __forceinline__ void operator()(const f32x4 (&acc)[2][2][4][2], const Unit& u, int wr, int wc, int fr, int fq) const {
        const int row0 = u.pm * BM + wr * 64 + fr; const int col0 = u.pn * BM + wc * 32 + 8 * fq;
#pragma unroll
        for (int ai = 0; ai < 2; ++ai)
#pragma unroll
            for (int m = 0; m < 4; ++m) { bf16_t* rowp = O + (size_t)(row0 + ai * HALF + m * 16) * ldc + col0;
#pragma unroll
                for (int bj = 0; bj < 2; ++bj) { f32x4 v0 = acc[ai][bj][m][0], v1 = acc[ai][bj][m][1];
                    if (ACT == 2) {
#pragma unroll
                        for (int e = 0; e < 4; ++e) { const float a = fmaxf(v0[e], 0.f), b = fmaxf(v1[e], 0.f); v0[e] = a * a; v1[e] = b * b; } }
                    u32x4 w; w.x = cvt_pk_bf16(v0[0], v0[1]); w.y = cvt_pk_bf16(v0[2], v0[3]); w.z = cvt_pk_bf16(v1[0], v1[1]); w.w = cvt_pk_bf16(v1[2], v1[3]);
                    *(u32x4*)(rowp + bj * HALF) = w; } }
    }
};

struct EpiResGate {
    static constexpr bool PERM = false, AFTER_DRAIN = false;
    const float* base; float* out; int ldc; const float* gate; int gate_stride; int tiles_per_batch;
    __device__ __forceinline__ void operator()(const f32x4 (&acc)[2][2][4][2], const Unit& u, int wr, int wc, int fr, int fq) const {
        const int col0 = u.pn * BM + wc * 32 + 4 * fq;
        const float* g = gate + (size_t)(u.pm / tiles_per_batch) * gate_stride + col0;
        f32x4 gv[2][2];
#pragma unroll
        for (int bj = 0; bj < 2; ++bj)
#pragma unroll
            for (int n = 0; n < 2; ++n) gv[bj][n] = *(const f32x4*)(g + bj * HALF + n * 16);
#pragma unroll
        for (int ai = 0; ai < 2; ++ai)
#pragma unroll
            for (int m = 0; m < 4; ++m) { const size_t off = (size_t)(u.pm * BM + ai * HALF + wr * 64 + m * 16 + fr) * ldc + col0;
#pragma unroll
                for (int bj = 0; bj < 2; ++bj)
#pragma unroll
                    for (int n = 0; n < 2; ++n) { const f32x4 bs = *(const f32x4*)(base + off + bj * HALF + n * 16); const f32x4 o = bs + gv[bj][n] * acc[ai][bj][m][n];
                        *(f32x4*)(out + off + bj * HALF + n * 16) = o; }
                if (m & 1) asm volatile("" ::: "memory"); }
    }
};
template <class Epi, class Sched, bool ALIGN_EPI = false, bool SP2 = false>
__device__ __forceinline__ void gemm_phase(PG8_LAS unsigned char* lds, const Gemm g, const Sched& S, const Epi& E) {
    const int tid = threadIdx.x, wid = __builtin_amdgcn_readfirstlane(tid >> 6), lane = tid & 63, wr = wid >> 2, wc = wid & 3, fr = lane & 15, fq = lane >> 4;
    const int K = g.K, nt = K / BK;
    unsigned voffA[2], voffB[2];
#pragma unroll
    for (int i = 0; i < 2; ++i) { int R, C; stage_rc(tid * 16 + i * 8192, R, C); const int Rb = Epi::PERM ? ((R & ~31) + perm32(R & 31)) : R;
        voffA[i] = (unsigned)(R * K + C) * 2u; voffB[i] = (unsigned)(Rb * K + C) * 2u; }
    const size_t kstep = (size_t)(BK * 2);
    const size_t hstep = (size_t)HALF * K * 2;
    const size_t tstep = 2 * hstep;
    const unsigned ldsw = (unsigned)wid * 1024u;
    const int aoff = lds_byte(wr * 64 + fr, fq * 8), boff = lds_byte(wc * 32 + fr, fq * 8);
#define PG8_SA(b, h) (((b) * 2 + (h)) * HTB)
#define PG8_SB(b, h) ((4 + (b) * 2 + (h)) * HTB)
#define PG8_STAGE(bufoff, gbase, voff) do { _Pragma("unroll") for (int _i = 0; _i < 2; ++_i) \
        __builtin_amdgcn_global_load_lds((const unsigned*)((const char*)(gbase) + (voff)[_i]), (PG8_LAS unsigned*)(lds + (bufoff) + ldsw + _i * 8192), 16, 0, 0); } while (0)
#define PG8_LDA(dst, b, h) do { _Pragma("unroll") for (int m = 0; m < 4; ++m) _Pragma("unroll") for (int k = 0; k < 2; ++k) dst[m][k] = *(const PG8_LAS bf16x8*)(lds + PG8_SA(b, h) + aoff + m * 2048 + k * 1024); } while (0)
#define PG8_LDB(dst, b, h) do { _Pragma("unroll") for (int n = 0; n < 2; ++n) _Pragma("unroll") for (int k = 0; k < 2; ++k) dst[n][k] = *(const PG8_LAS bf16x8*)(lds + PG8_SB(b, h) + boff + n * 2048 + k * 1024); } while (0)
#define PG8_MMA(ai, bj, At, Bt) do { __builtin_amdgcn_s_setprio(1); _Pragma("unroll") for (int m = 0; m < 4; ++m) _Pragma("unroll") for (int n = 0; n < 2; ++n) _Pragma("unroll") for (int k = 0; k < 2; ++k) \
        acc[ai][bj][m][n] = __builtin_amdgcn_mfma_f32_16x16x32_bf16(Bt[n][k], At[m][k], acc[ai][bj][m][n], 0, 0, 0); __builtin_amdgcn_s_setprio(0); } while (0)
#define PG8_WAIT_V(n) asm volatile("s_waitcnt vmcnt(" #n ")" ::: "memory")
#define PG8_WAIT_L(n) asm volatile("s_waitcnt lgkmcnt(" #n ")" ::: "memory")
#define PG8_BAR __builtin_amdgcn_s_barrier()
#define PG8_SCHED __builtin_amdgcn_sched_barrier(0)
    Unit cur, nxt; int ui = 0;
    if (!S.next(0, cur)) return;
    f32x4 acc[2][2][4][2];
#pragma unroll
    for (int a = 0; a < 2; ++a)
#pragma unroll
        for (int b = 0; b < 2; ++b)
#pragma unroll
            for (int m = 0; m < 4; ++m)
#pragma unroll
                for (int n = 0; n < 2; ++n) acc[a][b][m][n] = (f32x4){0.f, 0.f, 0.f, 0.f};
    bf16x8 At[4][2], B0[2][2], B1[2][2];
    const char* cA = (const char*)g.A + (size_t)cur.pm * tstep; const char* cB = (const char*)g.Bt + (size_t)cur.pn * tstep;
    S.a_ready(cur);
    if constexpr (SP2) {
        PG8_STAGE(PG8_SB(0, 0), cB, voffB); PG8_STAGE(PG8_SB(0, 1), cB + hstep, voffB); PG8_STAGE(PG8_SA(0, 0), cA, voffA); PG8_STAGE(PG8_SA(0, 1), cA + hstep, voffA);
        if (wr == 1) PG8_BAR;
        PG8_WAIT_V(2); PG8_BAR;
        PG8_STAGE(PG8_SB(1, 0), cB + kstep, voffB); PG8_STAGE(PG8_SA(1, 0), cA + kstep, voffA); PG8_STAGE(PG8_SB(1, 1), cB + hstep + kstep, voffB);
        PG8_WAIT_V(6); PG8_BAR;
    } else {
        PG8_STAGE(PG8_SB(0, 0), cB, voffB); PG8_STAGE(PG8_SA(0, 0), cA, voffA); PG8_STAGE(PG8_SB(0, 1), cB + hstep, voffB); PG8_STAGE(PG8_SA(0, 1), cA + hstep, voffA);
        if (wr == 1) PG8_BAR;
        PG8_WAIT_V(4); PG8_BAR;
        PG8_STAGE(PG8_SB(1, 0), cB + kstep, voffB); PG8_STAGE(PG8_SA(1, 0), cA + kstep, voffA); PG8_STAGE(PG8_SB(1, 1), cB + hstep + kstep, voffB);
        PG8_WAIT_V(6); PG8_BAR;
    }
    for (;;) {
        const bool has_next = S.next(ui + 1, nxt);
        const char* nA = has_next ? (const char*)g.A + (size_t)nxt.pm * tstep : cA; const char* nB = has_next ? (const char*)g.Bt + (size_t)nxt.pn * tstep : cB;
        for (int t = 0; t < nt; t += 2) {
            const bool last = (t == nt - 2);
            const char* a1 = cA + (size_t)(t + 1) * kstep;
            const char* a2 = last ? nA : cA + (size_t)(t + 2) * kstep; const char* b2 = last ? nB : cB + (size_t)(t + 2) * kstep;
            const char* a3 = a2 + kstep; const char* b3 = b2 + kstep;
            if (last && has_next) S.a_ready(nxt);
            if constexpr (SP2) {
            PG8_LDB(B0, 0, 0); PG8_LDB(B1, 0, 1); PG8_SCHED; PG8_LDA(At, 0, 0); PG8_STAGE(PG8_SA(1, 1), a1 + hstep, voffA);
            PG8_WAIT_V(8); PG8_WAIT_L(0); PG8_BAR; PG8_MMA(0, 0, At, B0); PG8_MMA(0, 1, At, B1); PG8_BAR; PG8_SCHED;
            PG8_LDA(At, 0, 1); PG8_STAGE(PG8_SB(0, 0), b2, voffB); PG8_STAGE(PG8_SB(0, 1), b2 + hstep, voffB); PG8_STAGE(PG8_SA(0, 0), a2, voffA);
            PG8_WAIT_V(8); PG8_WAIT_L(0); PG8_BAR; PG8_MMA(1, 0, At, B0); PG8_MMA(1, 1, At, B1); PG8_BAR; PG8_SCHED;
            PG8_LDB(B0, 1, 0); PG8_LDB(B1, 1, 1); PG8_SCHED; PG8_LDA(At, 1, 0); PG8_STAGE(PG8_SA(0, 1), a2 + hstep, voffA);
            PG8_WAIT_V(8); PG8_WAIT_L(0); PG8_BAR; PG8_MMA(0, 0, At, B0); PG8_MMA(0, 1, At, B1); PG8_BAR; PG8_SCHED;
            PG8_LDA(At, 1, 1); PG8_STAGE(PG8_SB(1, 0), b3, voffB); PG8_STAGE(PG8_SB(1, 1), b3 + hstep, voffB); PG8_STAGE(PG8_SA(1, 0), a3, voffA);
            PG8_WAIT_V(8); PG8_WAIT_L(0); PG8_BAR; PG8_MMA(1, 0, At, B0); PG8_MMA(1, 1, At, B1); PG8_BAR; PG8_SCHED;
            } else {
            PG8_LDB(B0, 0, 0); PG8_SCHED; PG8_LDA(At, 0, 0); PG8_STAGE(PG8_SA(1, 1), a1 + hstep, voffA);
            PG8_WAIT_L(8); PG8_BAR; PG8_WAIT_L(0); PG8_MMA(0, 0, At, B0); PG8_BAR; PG8_SCHED;
            PG8_LDB(B1, 0, 1); PG8_STAGE(PG8_SB(0, 0), b2, voffB);
            PG8_BAR; PG8_WAIT_L(0); PG8_MMA(0, 1, At, B1); PG8_BAR;
            PG8_LDA(At, 0, 1); PG8_STAGE(PG8_SA(0, 0), a2, voffA);
            PG8_BAR; PG8_WAIT_L(0); PG8_MMA(1, 0, At, B0); PG8_BAR; PG8_SCHED;
            PG8_STAGE(PG8_SB(0, 1), b2 + hstep, voffB);
            PG8_WAIT_V(6); PG8_BAR; PG8_MMA(1, 1, At, B1); PG8_BAR;
            PG8_LDB(B0, 1, 0); PG8_SCHED; PG8_LDA(At, 1, 0); PG8_STAGE(PG8_SA(0, 1), a2 + hstep, voffA);
            PG8_WAIT_L(8); PG8_BAR; PG8_WAIT_L(0); PG8_MMA(0, 0, At, B0); PG8_BAR; PG8_SCHED;
            PG8_LDB(B1, 1, 1); PG8_STAGE(PG8_SB(1, 0), b3, voffB);
            PG8_BAR; PG8_WAIT_L(0); PG8_MMA(0, 1, At, B1); PG8_BAR;
            PG8_LDA(At, 1, 1); PG8_STAGE(PG8_SA(1, 0), a3, voffA);
            PG8_BAR; PG8_WAIT_L(0); PG8_MMA(1, 0, At, B0); PG8_BAR; PG8_SCHED;
            PG8_STAGE(PG8_SB(1, 1), b3 + hstep, voffB);
            PG8_WAIT_V(6); PG8_BAR; PG8_MMA(1, 1, At, B1); PG8_BAR;
            }
        }
        if constexpr (ALIGN_EPI) { if (wr == 0) PG8_BAR; }
        if constexpr (!Epi::AFTER_DRAIN) { E(acc, cur, wr, wc, fr, fq); S.done(cur); }
        if (!has_next) break;
#pragma unroll
        for (int a = 0; a < 2; ++a)
#pragma unroll
            for (int b = 0; b < 2; ++b)
#pragma unroll
                for (int m = 0; m < 4; ++m)
#pragma unroll
                    for (int n = 0; n < 2; ++n) acc[a][b][m][n] = (f32x4){0.f, 0.f, 0.f, 0.f};
        cur = nxt; cA = nA; cB = nB; ++ui;
        if constexpr (ALIGN_EPI) { if (wr == 1) PG8_BAR; }
    }
    PG8_WAIT_V(0);
    if constexpr (!ALIGN_EPI) { if (wr == 0) PG8_BAR; }
    PG8_BAR;
    if constexpr (Epi::AFTER_DRAIN) { E.fused(acc, cur, wr, wc, fr, fq, lds, wid, lane); S.done(cur); }
#undef PG8_SA
#undef PG8_SB
#undef PG8_STAGE
#undef PG8_LDA
#undef PG8_LDB
#undef PG8_MMA
#undef PG8_WAIT_V
#undef PG8_WAIT_L
#undef PG8_BAR
#undef PG8_SCHED
}
}
#ifndef PG8_SP2
#define PG8_SP2 true
#endif
#ifndef PG8_ALIGN
#define PG8_ALIGN true
#endif

constexpr int NWAVES = 8;
#ifndef MK_N_LAUNCHES
#define MK_N_LAUNCHES 9
#endif
constexpr int PER_PHASE = 9;
constexpr int N_LAUNCHES = MK_N_LAUNCHES;

constexpr int BATCH = 32, SEQ = 2048, D = 1024, M = BATCH * SEQ, FF = 4096, NPROJ = 4096, IN_COLS = 4104, NMOD = 6 * D;
constexpr float EPS = 1e-6f;
constexpr float LOG2E = 1.4426950408889634f, C2 = 0.18033688011112042f;
constexpr int C_FQ = 0, C_FK = 512, C_FV = 1024, C_FOG = 1536, C_RQ = 2048, C_RK = 2560, C_RV = 3072, C_RG = 3584;
constexpr int MOD_SHIFT_M = 0, MOD_SCALE_M = 1024, MOD_GATE_M = 2048, MOD_SHIFT_F = 3072, MOD_SCALE_F = 4096, MOD_GATE_F = 5120;

constexpr size_t MiB = 1u << 20;
constexpr size_t WS_CTL = 0, CTL_ZERO_BYTES = 2 * MiB;
constexpr size_t WS_MOD = 1 * MiB;
constexpr size_t WS_WIN = 2 * MiB, WS_WOUT = 10 * MiB, WS_W1 = 12 * MiB, WS_W2 = 20 * MiB;
constexpr size_t WS_WF = 28 * MiB;
constexpr size_t WS_ROPE = 29 * MiB;
constexpr size_t WS_LOGF = 30 * MiB, WS_CUM = 32 * MiB;
constexpr size_t WS_H = 64 * MiB, WS_MIX = 192 * MiB, WS_PROJ = 320 * MiB, WS_U = 320 * MiB, WS_END = 832 * MiB;
constexpr int CW_BAR = 4096;

constexpr int RING_OFF = 0, RING_BYTES = 131072;
constexpr int LDSCTL_OFF = RING_BYTES, MISC_OFF = LDSCTL_OFF + 320;
constexpr int LDS_BYTES = 147456;
#define GAS __attribute__((address_space(1)))
#define LAS __attribute__((address_space(3)))
typedef unsigned short bf16;
typedef unsigned v4u __attribute__((ext_vector_type(4)));
typedef float f32x4 __attribute__((ext_vector_type(4)));
typedef short bf16x8 __attribute__((ext_vector_type(8)));
typedef GAS unsigned gu32;
typedef GAS unsigned long long gu64;
#define RLX_AGENT __ATOMIC_RELAXED, __HIP_MEMORY_SCOPE_AGENT
#define LDS_WAIT() asm volatile("s_waitcnt lgkmcnt(0)" ::: "memory")
#define VM_WAIT() asm volatile("s_waitcnt vmcnt(0)" ::: "memory")
__device__ __forceinline__ unsigned long long rt() { return __builtin_amdgcn_s_memrealtime(); }
__device__ __forceinline__ unsigned f2bf(float f) { unsigned u = __builtin_bit_cast(unsigned, f); return (u + 0x7fffu + ((u >> 16) & 1u)) >> 16; }
__device__ __forceinline__ unsigned pk2(float lo, float hi) { return f2bf(lo) | (f2bf(hi) << 16); }

#define XB_TMO      128
#define XB_XCNT(j)  (256  + 64 * (j))
#define XB_XSUB(j)  (1280 + 64 * (j))
#define XB_XGEN(j)  (2304 + 64 * (j))
#define XB_TOP      3328
#define XB_TOPGEN   3392
#define XCD_BAR_WORDS 3456
#define XB_SPIN_CAP (1u << 18)

__device__ __forceinline__ unsigned xb_ld(unsigned* p)              { return __hip_atomic_load(p, __ATOMIC_RELAXED, __HIP_MEMORY_SCOPE_AGENT); }
__device__ __forceinline__ unsigned xb_add(unsigned* p, unsigned v) { return __hip_atomic_fetch_add(p, v, __ATOMIC_RELAXED, __HIP_MEMORY_SCOPE_AGENT); }
__device__ __forceinline__ unsigned xb_xcc_id() { return (unsigned)__builtin_amdgcn_s_getreg((3 << 11) | 20) & 0xFu; }
#define XB_SPIN(cond, bar) do { unsigned _sp = 0; while (cond) { __builtin_amdgcn_s_sleep(1); \
    if ((++_sp & 255u) == 0u) { if (xb_ld(&(bar)[XB_TMO])) break; if (_sp > XB_SPIN_CAP) { atomicAdd(&(bar)[XB_TMO], 1u); break; } } } } while (0)

struct XcdBarrier {
    unsigned* bar; unsigned x;
    volatile LAS unsigned* st;
};

__device__ __forceinline__ XcdBarrier xcd_barrier_post(unsigned* bar, volatile LAS unsigned* st) {
    XcdBarrier b; b.bar = bar; b.x = xb_xcc_id(); b.st = st;
    if (threadIdx.x == 0) (void)xb_add(&bar[XB_XCNT(b.x)], 1u);
    return b;
}
__device__ __forceinline__ void xcd_barrier_complete(unsigned* bar, unsigned x, unsigned& nloc, unsigned& nx) {
    const unsigned G = gridDim.x * gridDim.y * gridDim.z;
    unsigned sum, cnt, mine, sp = 0u;
    for (;;) {
        sum = 0u; cnt = 0u; mine = 0u;
#pragma unroll
        for (unsigned j = 0; j < 16; ++j) { const unsigned c = xb_ld(&bar[XB_XCNT(j)]); sum += c; cnt += (c > 0u) ? 1u : 0u; mine = (j == x) ? c : mine; }
        if (sum == G) break;
        __builtin_amdgcn_s_sleep(1);
        if ((++sp & 255u) == 0u) { if (xb_ld(&bar[XB_TMO])) break; if (sp > XB_SPIN_CAP) { atomicAdd(&bar[XB_TMO], 1u); break; } }
    }
    nloc = mine > 0u ? mine : 1u; nx = cnt > 0u ? cnt : 1u;
}

__device__ __forceinline__ void xcd_barrier(const XcdBarrier& b) {
    asm volatile("s_waitcnt vmcnt(0)" ::: "memory");
    __syncthreads();
    if (threadIdx.x == 0) {
        unsigned* bar = b.bar;
        __builtin_amdgcn_s_waitcnt(0);
        unsigned nloc = b.st[0], nx = b.st[1];
        if (nloc == 0u) { xcd_barrier_complete(bar, b.x, nloc, nx); b.st[0] = nloc; b.st[1] = nx; }
        const unsigned old = xb_add(&bar[XB_XSUB(b.x)], 1u);
        const unsigned gen = old / nloc;
        if (old + 1u == (gen + 1u) * nloc) {
            __builtin_amdgcn_fence(__ATOMIC_RELEASE, "agent");
            asm volatile("s_waitcnt vmcnt(0)" ::: "memory");
            const unsigned og = xb_add(&bar[XB_TOP], 1u);
            const unsigned tg = og / nx;
            if (og + 1u == (tg + 1u) * nx) xb_add(&bar[XB_TOPGEN], 1u);
            else XB_SPIN(xb_ld(&bar[XB_TOPGEN]) == tg, bar);
            __builtin_amdgcn_fence(__ATOMIC_ACQUIRE, "agent");
            xb_add(&bar[XB_XGEN(b.x)], 1u);
            asm volatile("s_waitcnt vmcnt(0)" ::: "memory");
        } else {
            XB_SPIN(xb_ld(&bar[XB_XGEN(b.x)]) == gen, bar);
            __builtin_amdgcn_fence(__ATOMIC_ACQUIRE, "agent");
            asm volatile("s_waitcnt vmcnt(0)" ::: "memory");
        }
    }
    __syncthreads();
}

struct Frame {
    LAS unsigned char* lds;
    volatile LAS unsigned* MISC;
    gu32* ctl;
    int tid, lane, wave;
    int vcu, G;
    const float *x, *c, *w_ada, *b_ada, *w_in, *b_forget, *qg, *kg, *fog, *rog, *w_out, *w1, *w2; float* out;
    bf16 *Win_t, *Wout_t, *W1_t, *W2_t;
    float *wf, *rope, *logf, *cum, *mod;
    bf16 *H, *MIXB, *PROJ, *U;
};
__device__ __forceinline__ float bf2f(unsigned short v) { return __uint_as_float((unsigned)v << 16); }
__device__ __forceinline__ float bflo(unsigned w) { return __uint_as_float(w << 16); }
__device__ __forceinline__ float bfhi(unsigned w) { return __uint_as_float(w & 0xffff0000u); }
__device__ __forceinline__ void unpack8(const v4u w, float* f) { f[0] = bflo(w.x); f[1] = bfhi(w.x); f[2] = bflo(w.y); f[3] = bfhi(w.y); f[4] = bflo(w.z); f[5] = bfhi(w.z); f[6] = bflo(w.w); f[7] = bfhi(w.w); }
__device__ __forceinline__ v4u pack8(const float* f) { v4u w; w.x = pk2(f[0], f[1]); w.y = pk2(f[2], f[3]); w.z = pk2(f[4], f[5]); w.w = pk2(f[6], f[7]); return w; }

__device__ __forceinline__ void p0_transpose_item(const float* W, int K, int ldn, int col_off, int nblk, bf16* WT, int row_off, LAS float* scr, int item, int lane) {
    const int kb = item / nblk, nb = item % nblk, k0 = 64 * kb, n0 = 32 * nb;
#pragma unroll 8
    for (int i = 0; i < 32; ++i) { const int kk = 2 * i + (lane >> 5); scr[kk * 33 + (lane & 31)] = W[(size_t)(k0 + kk) * ldn + col_off + n0 + (lane & 31)]; }
    LDS_WAIT(); asm volatile("" ::: "memory");
    const int c = lane & 7;
#pragma unroll
    for (int j = 0; j < 4; ++j) { const int n = (lane >> 3) + 8 * j; const LAS float* s = scr + (8 * c) * 33 + n;
        v4u o; o.x = pk2(s[0 * 33], s[1 * 33]); o.y = pk2(s[2 * 33], s[3 * 33]); o.z = pk2(s[4 * 33], s[5 * 33]); o.w = pk2(s[6 * 33], s[7 * 33]);
        *(GAS v4u*)(WT + (size_t)(row_off + n0 + n) * K + k0 + 8 * c) = o; }
    LDS_WAIT(); asm volatile("" ::: "memory");
}
__device__ __forceinline__ void p0_mod_item(Frame& F, LAS float* scr, int item) {
    const int cg = item % 96, ks = item / 96; const int e = cg * 64 + F.lane, k0 = ks * 128;
#pragma unroll 4
    for (int i = 0; i < 64; ++i) { const int idx = i * 64 + F.lane; const int kk = idx >> 5, b = idx & 31; const float cv = F.c[b * D + k0 + kk]; scr[idx] = cv / (1.f + expf(-cv)); }
    LDS_WAIT(); asm volatile("" ::: "memory");
    float acc[32];
#pragma unroll
    for (int b = 0; b < 32; ++b) acc[b] = 0.f;
#pragma unroll 4
    for (int kk = 0; kk < 128; ++kk) { const float w = F.w_ada[(size_t)(k0 + kk) * NMOD + e];
#pragma unroll
        for (int b4 = 0; b4 < 8; ++b4) { const f32x4 s = *(const LAS f32x4*)(scr + kk * 32 + 4 * b4);
            acc[4 * b4 + 0] += s.x * w; acc[4 * b4 + 1] += s.y * w; acc[4 * b4 + 2] += s.z * w; acc[4 * b4 + 3] += s.w * w; } }
    const float bias = (ks == 0) ? F.b_ada[e] : 0.f;
#pragma unroll
    for (int b = 0; b < 32; ++b) atomicAdd(&F.mod[b * NMOD + e], acc[b] + bias);
    LDS_WAIT(); asm volatile("" ::: "memory");
}
__device__ __forceinline__ void p0_rope_item(Frame& F, int s) {
    const int j = F.lane;
    double f = 1.0, p = 0.86596432336006535; int e = j;
#pragma unroll
    for (int bit = 0; bit < 6; ++bit) { if (e & 1) f *= p; p *= p; e >>= 1; }
    const double ang = (double)s * f;
    const double kq = rint(ang * 0.63661977236758134);
    const double r = fma(-kq, 1.5707963267948966, ang) - kq * 6.123233995736766e-17;
    const double r2 = r * r;
    const double sn = r * (1.0 + r2 * (-1.0 / 6.0 + r2 * (1.0 / 120.0 + r2 * (-1.0 / 5040.0 + r2 * (1.0 / 362880.0 + r2 * (-1.0 / 39916800.0 + r2 * (1.0 / 6227020800.0)))))));
    const double cs = 1.0 + r2 * (-0.5 + r2 * (1.0 / 24.0 + r2 * (-1.0 / 720.0 + r2 * (1.0 / 40320.0 + r2 * (-1.0 / 3628800.0 + r2 * (1.0 / 479001600.0 + r2 * (-1.0 / 87178291200.0)))))));
    const int q = ((int)kq) & 3;
    const double S = (q == 0) ? sn : (q == 1) ? cs : (q == 2) ? -sn : -cs;
    const double C = (q == 0) ? cs : (q == 1) ? -sn : (q == 2) ? -cs : sn;
    F.rope[s * 128 + j] = (float)C; F.rope[s * 128 + 64 + j] = (float)S;
}
__device__ __forceinline__ void p0_prologue(Frame& F) {
    LAS float* scr = (LAS float*)(F.lds + RING_OFF + F.wave * 16384);
    const int gw = F.vcu * NWAVES + F.wave, NGW = F.G * NWAVES;
    constexpr int I_INA = (D / 64) * (2048 / 32), I_INB = I_INA, I_O = (D / 64) * (D / 32), I_1 = (D / 64) * (FF / 32), I_2 = (FF / 64) * (D / 32);
    constexpr int I_MOD = 96 * 8, I_ROPE = SEQ, I_WF = 8;
    constexpr int NITEMS = I_MOD + I_INA + I_INB + I_O + I_1 + I_2 + I_ROPE + I_WF;
    for (int it = gw; it < NITEMS; it += NGW) {
        int r = it;
        if (r < I_MOD) { p0_mod_item(F, scr, r); continue; } r -= I_MOD;
        if (r < I_INA) { p0_transpose_item(F.w_in, D, IN_COLS, 0, 2048 / 32, F.Win_t, 0, scr, r, F.lane); continue; } r -= I_INA;
        if (r < I_INB) { p0_transpose_item(F.w_in, D, IN_COLS, 2056, 2048 / 32, F.Win_t, 2048, scr, r, F.lane); continue; } r -= I_INB;
        if (r < I_O) { p0_transpose_item(F.w_out, D, D, 0, D / 32, F.Wout_t, 0, scr, r, F.lane); continue; } r -= I_O;
        if (r < I_1) { p0_transpose_item(F.w1, D, FF, 0, FF / 32, F.W1_t, 0, scr, r, F.lane); continue; } r -= I_1;
        if (r < I_2) { p0_transpose_item(F.w2, FF, D, 0, D / 32, F.W2_t, 0, scr, r, F.lane); continue; } r -= I_2;
        if (r < I_ROPE) { p0_rope_item(F, r); continue; } r -= I_ROPE;
        { for (int k = F.lane; k < D; k += 64) F.wf[r * D + k] = F.w_in[(size_t)k * IN_COLS + 2048 + r]; }
    }
}

__device__ __forceinline__ float wave_sum(float v) {
#pragma unroll
    for (int o = 1; o < 64; o <<= 1) v += __shfl_xor(v, o);
    return v;
}
__device__ __forceinline__ float reduce8(const float* p, int lane) {
    const bool b0 = lane & 1, b1 = lane & 2, b2 = lane & 4;
    float q[4], r[2];
#pragma unroll
    for (int i = 0; i < 4; ++i) { const float send = b0 ? p[i] : p[i + 4], keep = b0 ? p[i + 4] : p[i]; q[i] = keep + __shfl_xor(send, 1); }
#pragma unroll
    for (int i = 0; i < 2; ++i) { const float send = b1 ? q[i] : q[i + 2], keep = b1 ? q[i + 2] : q[i]; r[i] = keep + __shfl_xor(send, 2); }
    const float send = b2 ? r[0] : r[1], keep = b2 ? r[1] : r[0];
    float s = keep + __shfl_xor(send, 4);
    s += __shfl_xor(s, 8); s += __shfl_xor(s, 16); s += __shfl_xor(s, 32);
    return s;
}
template <bool FORGET> __device__ __forceinline__ void norm_phase(Frame& F, const float* xin, int mod_scale, int mod_shift) {
    LAS float* sc = (LAS float*)F.lds; LAS float* sh = sc + 1024; LAS float* wfl = sh + 1024; LAS float* bfl = wfl + 8192;
    for (int chunk = F.vcu; chunk < M / 256; chunk += F.G) {
        const int b = chunk >> 3;
        __syncthreads();
        for (int i = F.tid; i < 1024; i += NWAVES * 64) { sc[i] = 1.f + F.mod[b * NMOD + mod_scale + i]; sh[i] = F.mod[b * NMOD + mod_shift + i]; }
        if (FORGET) { for (int i = F.tid; i < 8192; i += NWAVES * 64) wfl[i] = F.wf[i]; if (F.tid < 8) bfl[F.tid] = F.b_forget[F.tid]; }
        __syncthreads();
        for (int rp = 0; rp < 32; ++rp) {
            const int row = chunk * 256 + F.wave * 32 + rp;
            const GAS f32x4* xr = (const GAS f32x4*)(xin + (size_t)row * D) + F.lane;
            f32x4 v[4]; float ss = 0.f;
#pragma unroll
            for (int j = 0; j < 4; ++j) { v[j] = xr[64 * j]; ss += (v[j].x * v[j].x + v[j].y * v[j].y) + (v[j].z * v[j].z + v[j].w * v[j].w); }
            const float rstd = rsqrtf(wave_sum(ss) * (1.f / D) + EPS);
            GAS unsigned long long* o8 = (GAS unsigned long long*)(F.H + (size_t)row * D) + F.lane;
#pragma unroll
            for (int j = 0; j < 4; ++j) { const f32x4 s4 = *(const LAS f32x4*)(sc + 4 * F.lane + 256 * j), h4 = *(const LAS f32x4*)(sh + 4 * F.lane + 256 * j);
                v[j] = v[j] * rstd * s4 + h4;
                o8[64 * j] = (unsigned long long)pk2(v[j].x, v[j].y) | ((unsigned long long)pk2(v[j].z, v[j].w) << 32); }
            if (FORGET) {
                float p[8];
#pragma unroll
                for (int hh = 0; hh < 8; ++hh) { float a = 0.f;
#pragma unroll
                    for (int j = 0; j < 4; ++j) { const f32x4 w4 = *(const LAS f32x4*)(wfl + hh * 1024 + 4 * F.lane + 256 * j); a += (v[j].x * w4.x + v[j].y * w4.y) + (v[j].z * w4.z + v[j].w * w4.w); }
                    p[hh] = a; }
                const float tot = reduce8(p, F.lane);
                if (F.lane < 8) { const int hs = 4 * (F.lane & 1) + 2 * ((F.lane >> 1) & 1) + ((F.lane >> 2) & 1);
                    const float z = tot + bfl[hs];
                    const float lf = fminf(z, 0.f) - log1pf(expf(-fabsf(z)));
                    F.logf[((size_t)(b * 8 + hs)) * SEQ + (row & (SEQ - 1))] = lf; }
            }
        }
    }
}
__device__ __forceinline__ void cumsum_seq(Frame& F, int seq) {
    const float* src = F.logf + (size_t)seq * SEQ + 32 * F.lane; float* dst = F.cum + (size_t)seq * SEQ + 32 * F.lane;
    double run = 0.0; float v[32];
#pragma unroll
    for (int i = 0; i < 8; ++i) { const f32x4 t = *(const f32x4*)(src + 4 * i); v[4 * i] = t.x; v[4 * i + 1] = t.y; v[4 * i + 2] = t.z; v[4 * i + 3] = t.w; }
#pragma unroll
    for (int i = 0; i < 32; ++i) run += (double)v[i];
    double t = run;
#pragma unroll
    for (int o = 1; o < 64; o <<= 1) { const double n = __shfl_up(t, o); if (F.lane >= o) t += n; }
    double acc = t - run;
#pragma unroll
    for (int i = 0; i < 8; ++i) { f32x4 o4; acc += (double)v[4 * i]; o4.x = (float)(acc * 1.4426950408889634); acc += (double)v[4 * i + 1]; o4.y = (float)(acc * 1.4426950408889634);
        acc += (double)v[4 * i + 2]; o4.z = (float)(acc * 1.4426950408889634); acc += (double)v[4 * i + 3]; o4.w = (float)(acc * 1.4426950408889634); *(f32x4*)(dst + 4 * i) = o4; }
}

__device__ __forceinline__ void post_row(Frame& F, size_t row) {
    bf16* p = F.PROJ + row * NPROJ; const int lane = F.lane; const int s = (int)(row & (SEQ - 1));
    {
        const int hd = lane >> 2, sl = lane & 3; bf16* a = p + hd * 64 + sl * 16;
        float v[16]; unpack8(*(const v4u*)a, v); unpack8(*(const v4u*)(a + 8), v + 8);
        float ss = 0.f;
#pragma unroll
        for (int i = 0; i < 16; ++i) ss += v[i] * v[i];
        ss += __shfl_xor(ss, 1); ss += __shfl_xor(ss, 2);
        const float rstd = rsqrtf(ss * (1.f / 64.f) + EPS);
        const float* g = ((hd < 8) ? F.qg : F.kg) + sl * 16; const float scl = (hd < 8) ? C2 * rstd : rstd;
#pragma unroll
        for (int i = 0; i < 16; ++i) v[i] = v[i] * scl * g[i];
        *(v4u*)a = pack8(v); *(v4u*)(a + 8) = pack8(v + 8);
    }
    {
        const int hh = lane >> 3, i0 = (lane & 7) * 8; bf16* a = p + C_RQ + hh * 128 + i0;
        float x1[8], x2[8]; unpack8(*(const v4u*)a, x1); unpack8(*(const v4u*)(a + 64), x2);
        const float* ct = F.rope + s * 128 + i0; const float* st = ct + 64;
        const float scl = (hh >= 4) ? 0.08838834764831845f : 1.f;
        float y1[8], y2[8];
#pragma unroll
        for (int i = 0; i < 8; ++i) { const float c = ct[i], sn = st[i]; y1[i] = (x1[i] * c - x2[i] * sn) * scl; y2[i] = (x1[i] * sn + x2[i] * c) * scl; }
        *(v4u*)a = pack8(y1); *(v4u*)(a + 64) = pack8(y2);
    }
}

__device__ __forceinline__ void fox_naive_unit(Frame& F, int b, int h, int qb) {
    LAS float* Ks = (LAS float*)F.lds; LAS float* Vs = Ks + 4096; LAS float* ck = Vs + 4096;
    const int t = F.tid, qi = t >> 2, sl = t & 3; const int tq = 128 * qb + qi; const size_t row = (size_t)b * SEQ + tq;
    const bf16* P = F.PROJ;
    float q[16]; unpack8(*(const v4u*)(P + row * NPROJ + C_FQ + h * 64 + sl * 16), q); unpack8(*(const v4u*)(P + row * NPROJ + C_FQ + h * 64 + sl * 16 + 8), q + 8);
    const float* cum = F.cum + (size_t)(b * 8 + h) * SEQ; const float cq = cum[tq];
    float m = -INFINITY, l = 0.f; float o[16];
#pragma unroll
    for (int i = 0; i < 16; ++i) o[i] = 0.f;
    const int nkt = 2 * (qb + 1);
    for (int kt = 0; kt < nkt; ++kt) {
        __syncthreads();
        { const size_t krow = (size_t)b * SEQ + 64 * kt + (t >> 3); float f[8];
          unpack8(*(const v4u*)(P + krow * NPROJ + C_FK + h * 64 + (t & 7) * 8), f);
          *(LAS f32x4*)(Ks + (t >> 3) * 64 + (t & 7) * 8) = (f32x4){f[0], f[1], f[2], f[3]}; *(LAS f32x4*)(Ks + (t >> 3) * 64 + (t & 7) * 8 + 4) = (f32x4){f[4], f[5], f[6], f[7]};
          unpack8(*(const v4u*)(P + krow * NPROJ + C_FV + h * 64 + (t & 7) * 8), f);
          *(LAS f32x4*)(Vs + (t >> 3) * 64 + (t & 7) * 8) = (f32x4){f[0], f[1], f[2], f[3]}; *(LAS f32x4*)(Vs + (t >> 3) * 64 + (t & 7) * 8 + 4) = (f32x4){f[4], f[5], f[6], f[7]};
          if (t < 64) ck[t] = cum[64 * kt + t]; }
        __syncthreads();
#pragma unroll 2
        for (int kk = 0; kk < 64; ++kk) {
            const LAS float* kr = Ks + kk * 64 + sl * 16; float part = 0.f;
#pragma unroll
            for (int i4 = 0; i4 < 4; ++i4) { const f32x4 k4 = *(const LAS f32x4*)(kr + 4 * i4); part += (q[4 * i4] * k4.x + q[4 * i4 + 1] * k4.y) + (q[4 * i4 + 2] * k4.z + q[4 * i4 + 3] * k4.w); }
            part += __shfl_xor(part, 1); part += __shfl_xor(part, 2);
            float lg = part + (cq - ck[kk]); if (64 * kt + kk > tq) lg = -INFINITY;
            const float mn = fmaxf(m, lg); const float al = exp2f(m - mn), pp = exp2f(lg - mn);
            l = l * al + pp; m = mn;
            const LAS float* vr = Vs + kk * 64 + sl * 16;
#pragma unroll
            for (int i4 = 0; i4 < 4; ++i4) { const f32x4 v4 = *(const LAS f32x4*)(vr + 4 * i4);
                o[4 * i4] = o[4 * i4] * al + pp * v4.x; o[4 * i4 + 1] = o[4 * i4 + 1] * al + pp * v4.y; o[4 * i4 + 2] = o[4 * i4 + 2] * al + pp * v4.z; o[4 * i4 + 3] = o[4 * i4 + 3] * al + pp * v4.w; }
        }
    }
    const float il = 1.f / l; float ss = 0.f;
#pragma unroll
    for (int i = 0; i < 16; ++i) { o[i] *= il; ss += o[i] * o[i]; }
    ss += __shfl_xor(ss, 1); ss += __shfl_xor(ss, 2);
    const float rstd = rsqrtf(ss * (1.f / 64.f) + EPS);
    float g[16]; unpack8(*(const v4u*)(P + row * NPROJ + C_FOG + h * 64 + sl * 16), g); unpack8(*(const v4u*)(P + row * NPROJ + C_FOG + h * 64 + sl * 16 + 8), g + 8);
    const float* gn = F.fog + h * 64 + sl * 16;
#pragma unroll
    for (int i = 0; i < 16; ++i) o[i] = o[i] * rstd * gn[i] * (1.f / (1.f + expf(-g[i])));
    bf16* dst = F.MIXB + row * D + h * 64 + sl * 16;
    *(v4u*)dst = pack8(o); *(v4u*)(dst + 8) = pack8(o + 8);
}
__device__ __forceinline__ void ret_naive_unit(Frame& F, int b, int h, int qb) {
    LAS float* Ks = (LAS float*)F.lds; LAS float* Vs = Ks + 8192;
    const int t = F.tid, qi = t >> 2, sl = t & 3; const int tq = 128 * qb + qi; const size_t row = (size_t)b * SEQ + tq;
    const bf16* P = F.PROJ;
    float q[32];
#pragma unroll
    for (int i = 0; i < 4; ++i) unpack8(*(const v4u*)(P + row * NPROJ + C_RQ + h * 128 + sl * 32 + 8 * i), q + 8 * i);
    const float lg2 = (h == 0) ? -0.04580368961312479f : (h == 1) ? -0.02272007650008353f : (h == 2) ? -0.011315313227834146f : -0.005646563141142063f;
    float o[32];
#pragma unroll
    for (int i = 0; i < 32; ++i) o[i] = 0.f;
    const int nkt = 2 * (qb + 1);
    for (int kt = 0; kt < nkt; ++kt) {
        __syncthreads();
#pragma unroll
        for (int rep = 0; rep < 2; ++rep) { const int id = t + rep * 512; const int kr = id >> 4, ch = id & 15; const size_t krow = (size_t)b * SEQ + 64 * kt + kr; float f[8];
            unpack8(*(const v4u*)(P + krow * NPROJ + C_RK + h * 128 + ch * 8), f);
            *(LAS f32x4*)(Ks + kr * 128 + ch * 8) = (f32x4){f[0], f[1], f[2], f[3]}; *(LAS f32x4*)(Ks + kr * 128 + ch * 8 + 4) = (f32x4){f[4], f[5], f[6], f[7]};
            unpack8(*(const v4u*)(P + krow * NPROJ + C_RV + h * 128 + ch * 8), f);
            *(LAS f32x4*)(Vs + kr * 128 + ch * 8) = (f32x4){f[0], f[1], f[2], f[3]}; *(LAS f32x4*)(Vs + kr * 128 + ch * 8 + 4) = (f32x4){f[4], f[5], f[6], f[7]}; }
        __syncthreads();
#pragma unroll 2
        for (int kk = 0; kk < 64; ++kk) {
            const LAS float* kr = Ks + kk * 128 + sl * 32; float part = 0.f;
#pragma unroll
            for (int i4 = 0; i4 < 8; ++i4) { const f32x4 k4 = *(const LAS f32x4*)(kr + 4 * i4); part += (q[4 * i4] * k4.x + q[4 * i4 + 1] * k4.y) + (q[4 * i4 + 2] * k4.z + q[4 * i4 + 3] * k4.w); }
            part += __shfl_xor(part, 1); part += __shfl_xor(part, 2);
            const int dist = tq - (64 * kt + kk);
            const float w = (dist >= 0) ? part * exp2f((float)dist * lg2) : 0.f;
            const LAS float* vr = Vs + kk * 128 + sl * 32;
#pragma unroll
            for (int i4 = 0; i4 < 8; ++i4) { const f32x4 v4 = *(const LAS f32x4*)(vr + 4 * i4);
                o[4 * i4] += w * v4.x; o[4 * i4 + 1] += w * v4.y; o[4 * i4 + 2] += w * v4.z; o[4 * i4 + 3] += w * v4.w; }
        }
    }
    float ss = 0.f;
#pragma unroll
    for (int i = 0; i < 32; ++i) ss += o[i] * o[i];
    ss += __shfl_xor(ss, 1); ss += __shfl_xor(ss, 2);
    const float rstd = rsqrtf(ss * (1.f / 128.f) + EPS);
    const float* gn = F.rog + h * 128 + sl * 32;
    bf16* dst = F.MIXB + row * D + 512 + h * 128 + sl * 32;
#pragma unroll
    for (int i = 0; i < 4; ++i) { float g[8]; unpack8(*(const v4u*)(P + row * NPROJ + C_RG + h * 128 + sl * 32 + 8 * i), g); float r[8];
#pragma unroll
        for (int e = 0; e < 8; ++e) { const float z = g[e]; r[e] = o[8 * i + e] * rstd * gn[8 * i + e] * (z / (1.f + expf(-z))); }
        *(v4u*)(dst + 8 * i) = pack8(r); }
}
__device__ __forceinline__ void mixer_naive_phase(Frame& F) {
    for (int bh = F.vcu; bh < BATCH * 8; bh += F.G) for (int qb = 0; qb < 16; ++qb) fox_naive_unit(F, bh >> 3, bh & 7, qb);
    for (int id = F.vcu; id < BATCH * 4 * 2; id += F.G) { const int bh = id >> 1, par = id & 1;
        for (int i = 0; i < 8; ++i) { const int qb = (i & 1) ? 15 - (i - 1) - par : i + par; ret_naive_unit(F, bh >> 2, bh & 3, qb); } }
    __syncthreads();
}

struct Args { const float* in[13]; float* out; unsigned char* ws; int ph_lo, ph_hi, li, pad; };
__global__ void __launch_bounds__(NWAVES * 64, 2) skel_fwd(Args args) {
    extern __shared__ __attribute__((aligned(16))) unsigned char lds[];
    Frame F;
    F.lds = (LAS unsigned char*)lds;
    F.MISC = (volatile LAS unsigned*)(F.lds + MISC_OFF);
    F.tid = threadIdx.x; F.lane = F.tid & 63; F.wave = __builtin_amdgcn_readfirstlane(F.tid >> 6);
    F.G = gridDim.x; { const int bx = blockIdx.x; F.vcu = (F.G % 8 == 0) ? (bx % 8) * (F.G / 8) + bx / 8 : bx; }
    unsigned char* ws = args.ws;
    F.ctl = (gu32*)(ws + WS_CTL);
    F.x = args.in[0]; F.c = args.in[1]; F.w_ada = args.in[2]; F.b_ada = args.in[3]; F.w_in = args.in[4]; F.b_forget = args.in[5]; F.qg = args.in[6]; F.kg = args.in[7];
    F.fog = args.in[8]; F.rog = args.in[9]; F.w_out = args.in[10]; F.w1 = args.in[11]; F.w2 = args.in[12]; F.out = args.out;
    F.Win_t = (bf16*)(ws + WS_WIN); F.Wout_t = (bf16*)(ws + WS_WOUT); F.W1_t = (bf16*)(ws + WS_W1); F.W2_t = (bf16*)(ws + WS_W2);
    F.wf = (float*)(ws + WS_WF); F.rope = (float*)(ws + WS_ROPE); F.logf = (float*)(ws + WS_LOGF); F.cum = (float*)(ws + WS_CUM); F.mod = (float*)(ws + WS_MOD);
    F.H = (bf16*)(ws + WS_H); F.MIXB = (bf16*)(ws + WS_MIX); F.PROJ = (bf16*)(ws + WS_PROJ); F.U = (bf16*)(ws + WS_U);
    for (int u = F.tid; u < (LDS_BYTES - LDSCTL_OFF) / 4; u += NWAVES * 64) ((LAS unsigned*)(F.lds + LDSCTL_OFF))[u] = 0u;
    __syncthreads();
    XcdBarrier bar; bar.bar = (unsigned*)(F.ctl + CW_BAR); bar.x = 0; bar.st = nullptr;
    if (N_LAUNCHES != PER_PHASE) bar = xcd_barrier_post((unsigned*)(F.ctl + CW_BAR), F.MISC + 8);
#define GRID_BAR() do { if (N_LAUNCHES != PER_PHASE) xcd_barrier(bar); } while (0)
    const int lo = args.ph_lo, hi = args.ph_hi;
#define IN(k) (lo <= (k) && (k) < hi)
#define BOTH(k) (IN(k) && IN((k) + 1))
    if (IN(0)) { p0_prologue(F); if (BOTH(0)) GRID_BAR(); }
    if (IN(1)) { norm_phase<true>(F, F.x, MOD_SCALE_M, MOD_SHIFT_M); if (BOTH(1)) GRID_BAR(); }
    if (IN(2)) {
        for (int seq = F.vcu; seq < BATCH * 8; seq += F.G) if (F.wave == 0) cumsum_seq(F, seq);
        pg8::Gemm g{F.H, F.Win_t, M, NPROJ, D}; pg8::StaticOrder S; S.init(M, NPROJ, F.G, (int)blockIdx.x);
        pg8::EpiBf16<0> E{F.PROJ, NPROJ};
        pg8::gemm_phase<pg8::EpiBf16<0>, pg8::StaticOrder, PG8_ALIGN, PG8_SP2>(F.lds + RING_OFF, g, S, E);
        if (BOTH(2)) GRID_BAR();
    }
    if (IN(3)) { const int gw = F.vcu * NWAVES + F.wave, NGW = F.G * NWAVES; for (int r = gw; r < M; r += NGW) post_row(F, (size_t)r); if (BOTH(3)) GRID_BAR(); }
    if (IN(4)) { mixer_naive_phase(F); if (BOTH(4)) GRID_BAR(); }
    if (IN(5)) {
        pg8::Gemm g{F.MIXB, F.Wout_t, M, D, D}; pg8::StaticOrder S; S.init(M, D, F.G, (int)blockIdx.x);
        pg8::EpiResGate E{F.x, F.out, D, F.mod + MOD_GATE_M, NMOD, SEQ / 256};
        pg8::gemm_phase<pg8::EpiResGate, pg8::StaticOrder, PG8_ALIGN, PG8_SP2>(F.lds + RING_OFF, g, S, E);
        if (BOTH(5)) GRID_BAR();
    }
    if (IN(6)) { norm_phase<false>(F, F.out, MOD_SCALE_F, MOD_SHIFT_F); if (BOTH(6)) GRID_BAR(); }
    if (IN(7)) {
        pg8::Gemm g{F.H, F.W1_t, M, FF, D}; pg8::StaticOrder S; S.init(M, FF, F.G, (int)blockIdx.x);
        pg8::EpiBf16<2> E{F.U, FF};
        pg8::gemm_phase<pg8::EpiBf16<2>, pg8::StaticOrder, PG8_ALIGN, PG8_SP2>(F.lds + RING_OFF, g, S, E);
        if (BOTH(7)) GRID_BAR();
    }
    if (IN(8)) {
        pg8::Gemm g{F.U, F.W2_t, M, D, FF}; pg8::StaticOrder S; S.init(M, D, F.G, (int)blockIdx.x);
        pg8::EpiResGate E{F.out, F.out, D, F.mod + MOD_GATE_F, NMOD, SEQ / 256};
        pg8::gemm_phase<pg8::EpiResGate, pg8::StaticOrder, PG8_ALIGN, PG8_SP2>(F.lds + RING_OFF, g, S, E);
    }
#undef IN
#undef BOTH
}

extern "C" void kernel_launch(void* const* d_in, const int* in_sizes, int n_in, void* d_out, int out_size, void* d_ws, size_t ws_size, hipStream_t stream) {
    static int grid = 0;
    if (grid == 0) {
        if (n_in != 13 || in_sizes[0] != M * D || out_size != M * D || ws_size < WS_END) { fprintf(stderr, "kernel_launch: unexpected shapes/workspace (n_in %d, in0 %d, out %d, ws %zu); nothing launched\n", n_in, n_in > 0 ? in_sizes[0] : -1, out_size, ws_size); grid = -1; return; }
        int dev = 0, cus = 0, per_cu = 0;
        if (hipGetDevice(&dev) != hipSuccess || hipDeviceGetAttribute(&cus, hipDeviceAttributeMultiprocessorCount, dev) != hipSuccess) { fprintf(stderr, "kernel_launch: device query failed\n"); grid = -1; return; }
        if (hipFuncSetAttribute((const void*)skel_fwd, hipFuncAttributeMaxDynamicSharedMemorySize, LDS_BYTES) != hipSuccess) { fprintf(stderr, "kernel_launch: hipFuncSetAttribute failed\n"); grid = -1; return; }
        if (hipOccupancyMaxActiveBlocksPerMultiprocessor(&per_cu, (const void*)skel_fwd, NWAVES * 64, LDS_BYTES) != hipSuccess || per_cu < 1) { fprintf(stderr, "kernel_launch: occupancy query reports %d workgroups per CU; nothing launched\n", per_cu); (void)hipGetLastError(); grid = -1; return; }
        grid = cus;
    }
    if (grid < 0) return;
    if (hipMemsetAsync((char*)d_ws + WS_CTL, 0, CTL_ZERO_BYTES, stream) != hipSuccess) { fprintf(stderr, "kernel_launch: hipMemsetAsync failed\n"); return; }
    Args a{};
    for (int i = 0; i < 13; ++i) a.in[i] = (const float*)d_in[i];
    a.out = (float*)d_out; a.ws = (unsigned char*)d_ws;
    for (int li = 0; li < N_LAUNCHES; ++li) {
        a.ph_lo = (N_LAUNCHES == PER_PHASE) ? li : 0; a.ph_hi = (N_LAUNCHES == PER_PHASE) ? li + 1 : PER_PHASE; a.li = li;
        hipLaunchKernelGGL(skel_fwd, dim3(grid), dim3(NWAVES * 64), LDS_BYTES, stream, a);
        const hipError_t le = hipPeekAtLastError();
        if (le != hipSuccess) { fprintf(stderr, "kernel_launch: launch %d failed: %s\n", li, hipGetErrorName(le)); break; }
    }
}
```

```cpp
#include <hip/hip_runtime.h>
#include <cstdio>
#include <cstdint>
#include <cmath>
namespace pg8 {
#define PG8_LAS __attribute__((address_space(3)))
typedef unsigned short bf16_t;
typedef short bf16x8 __attribute__((ext_vector_type(8)));
typedef float f32x4 __attribute__((ext_vector_type(4)));
typedef unsigned u32x4 __attribute__((ext_vector_type(4)));
constexpr int BM = 256, BK = 64, HALF = 128, HTB = HALF * BK * 2  , STAGE_BYTES = 8 * HTB, NXCD = 8, WGM = 8;

__host__ __device__ __forceinline__ int lds_byte(int r, int c) { const int st = (r >> 4) * 2 + (c >> 5), rr = r & 15, cc = c & 31, ob = rr * 64 + cc * 2; return st * 1024 + (ob ^ (((ob >> 9) & 1) << 5)); }
__host__ __device__ __forceinline__ void stage_rc(int b, int& R, int& C) { const int st = b / 1024, sb = b % 1024, swz = sb ^ (((sb >> 9) & 1) << 5); R = (st >> 1) * 16 + swz / 64; C = (st & 1) * 32 + (swz % 64) / 2; }
__host__ __device__ __forceinline__ int perm32(int rho) { const int n = rho >> 4, i = rho & 15; return 8 * (i >> 2) + 4 * n + (i & 3); }

struct Unit { int pm, pn; };
struct Gemm { const bf16_t* A; const bf16_t* Bt; int M, N, K; };

struct StaticOrder {
    int nM, nN, nwg, G, c;
    __host__ __device__ void init(int M, int N, int G_, int c_) { nM = M / BM; nN = N / BM; nwg = nM * nN; G = G_; c = c_; }
    __host__ __device__ bool next(int i, Unit& u) const {
        const long L = (long)i * G + c; if (L >= nwg) return false;
        int wgid = (int)L; { const int q = nwg / NXCD, r = nwg % NXCD, xcd = wgid % NXCD, off = wgid / NXCD; wgid = (xcd < r ? xcd * (q + 1) : r * (q + 1) + (xcd - r) * q) + off; }
        const int nig = WGM * nN, gid = wgid / nig, fm = gid * WGM, gsz = (nM - fm) < WGM ? (nM - fm) : WGM;
        u.pm = fm + ((wgid % nig) % gsz); u.pn = (wgid % nig) / gsz; return true;
    }
    __device__ __forceinline__ void a_ready(const Unit&) const {}
    __device__ __forceinline__ void done(const Unit&) const {}
};

__device__ __forceinline__ unsigned cvt_pk_bf16(float lo, float hi) { unsigned r; asm volatile("v_cvt_pk_bf16_f32 %0, %1, %2" : "=v"(r) : "v"(lo), "v"(hi)); return r; }

template <int ACT> struct EpiBf16 {
    static constexpr bool PERM = true, AFTER_DRAIN = false;
    bf16_t* O; int ldc;
    __device__ __forceinline__ void operator()(const f32x4 (&acc)[2][2][4][2], const Unit& u, int wr, int wc, int fr, int fq) const {
        const int row0 = u.pm * BM + wr * 64 + fr; const int col0 = u.pn * BM + wc * 32 + 8 * fq;
#pragma unroll
        for (int ai = 0; ai < 2; ++ai)
#pragma unroll
            for (int m = 0; m < 4; ++m) { bf16_t* rowp = O + (size_t)(row0 + ai * HALF + m * 16) * ldc + col0;
#pragma unroll
                for (int bj = 0; bj < 2; ++bj) { f32x4 v0 = acc[ai][bj][m][0], v1 = acc[ai][bj][m][1];
                    if (ACT == 2) {
#pragma unroll
                        for (int e = 0; e < 4; ++e) { const float a = fmaxf(v0[e], 0.f), b = fmaxf(v1[e], 0.f); v0[e] = a * a; v1[e] = b * b; } }
                    u32x4 w; w.x = cvt_pk_bf16(v0[0], v0[1]); w.y = cvt_pk_bf16(v0[2], v0[3]); w.z = cvt_pk_bf16(v1[0], v1[1]); w.w = cvt_pk_bf16(v1[2], v1[3]);
                    *(u32x4*)(rowp + bj * HALF) = w; } }
    }
};

struct EpiResGate {
    static constexpr bool PERM = false, AFTER_DRAIN = false;
    const float* base; float* out; int ldc; const float* gate; int gate_stride; int tiles_per_batch;
    __device__ __forceinline__ void operator()(const f32x4 (&acc)[2][2][4][2], const Unit& u, int wr, int wc, int fr, int fq) const {
        const int col0 = u.pn * BM + wc * 32 + 4 * fq;
        const float* g = gate + (size_t)(u.pm / tiles_per_batch) * gate_stride + col0;
        f32x4 gv[2][2];
#pragma unroll
        for (int bj = 0; bj < 2; ++bj)
#pragma unroll
            for (int n = 0; n < 2; ++n) gv[bj][n] = *(const f32x4*)(g + bj * HALF + n * 16);
#pragma unroll
        for (int ai = 0; ai < 2; ++ai)
#pragma unroll
            for (int m = 0; m < 4; ++m) { const size_t off = (size_t)(u.pm * BM + ai * HALF + wr * 64 + m * 16 + fr) * ldc + col0;
#pragma unroll
                for (int bj = 0; bj < 2; ++bj)
#pragma unroll
                    for (int n = 0; n < 2; ++n) { const f32x4 bs = *(const f32x4*)(base + off + bj * HALF + n * 16); const f32x4 o = bs + gv[bj][n] * acc[ai][bj][m][n];
                        *(f32x4*)(out + off + bj * HALF + n * 16) = o; }
                if (m & 1) asm volatile("" ::: "memory"); }
    }
};
template <class Epi, class Sched, bool ALIGN_EPI = false, bool SP2 = false>
__device__ __forceinline__ void gemm_phase(PG8_LAS unsigned char* lds, const Gemm g, const Sched& S, const Epi& E) {
    const int tid = threadIdx.x, wid = __builtin_amdgcn_readfirstlane(tid >> 6), lane = tid & 63, wr = wid >> 2, wc = wid & 3, fr = lane & 15, fq = lane >> 4;
    const int K = g.K, nt = K / BK;
    unsigned voffA[2], voffB[2];
#pragma unroll
    for (int i = 0; i < 2; ++i) { int R, C; stage_rc(tid * 16 + i * 8192, R, C); const int Rb = Epi::PERM ? ((R & ~31) + perm32(R & 31)) : R;
        voffA[i] = (unsigned)(R * K + C) * 2u; voffB[i] = (unsigned)(Rb * K + C) * 2u; }
    const size_t kstep = (size_t)(BK * 2);
    const size_t hstep = (size_t)HALF * K * 2;
    const size_t tstep = 2 * hstep;
    const unsigned ldsw = (unsigned)wid * 1024u;
    const int aoff = lds_byte(wr * 64 + fr, fq * 8), boff = lds_byte(wc * 32 + fr, fq * 8);
#define PG8_SA(b, h) (((b) * 2 + (h)) * HTB)
#define PG8_SB(b, h) ((4 + (b) * 2 + (h)) * HTB)
#define PG8_STAGE(bufoff, gbase, voff) do { _Pragma("unroll") for (int _i = 0; _i < 2; ++_i) \
        __builtin_amdgcn_global_load_lds((const unsigned*)((const char*)(gbase) + (voff)[_i]), (PG8_LAS unsigned*)(lds + (bufoff) + ldsw + _i * 8192), 16, 0, 0); } while (0)
#define PG8_LDA(dst, b, h) do { _Pragma("unroll") for (int m = 0; m < 4; ++m) _Pragma("unroll") for (int k = 0; k < 2; ++k) dst[m][k] = *(const PG8_LAS bf16x8*)(lds + PG8_SA(b, h) + aoff + m * 2048 + k * 1024); } while (0)
#define PG8_LDB(dst, b, h) do { _Pragma("unroll") for (int n = 0; n < 2; ++n) _Pragma("unroll") for (int k = 0; k < 2; ++k) dst[n][k] = *(const PG8_LAS bf16x8*)(lds + PG8_SB(b, h) + boff + n * 2048 + k * 1024); } while (0)
#define PG8_MMA(ai, bj, At, Bt) do { __builtin_amdgcn_s_setprio(1); _Pragma("unroll") for (int m = 0; m < 4; ++m) _Pragma("unroll") for (int n = 0; n < 2; ++n) _Pragma("unroll") for (int k = 0; k < 2; ++k) \
        acc[ai][bj][m][n] = __builtin_amdgcn_mfma_f32_16x16x32_bf16(Bt[n][k], At[m][k], acc[ai][bj][m][n], 0, 0, 0); __builtin_amdgcn_s_setprio(0); } while (0)
#define PG8_WAIT_V(n) asm volatile("s_waitcnt vmcnt(" #n ")" ::: "memory")
#define PG8_WAIT_L(n) asm volatile("s_waitcnt lgkmcnt(" #n ")" ::: "memory")
#define PG8_BAR __builtin_amdgcn_s_barrier()
#define PG8_SCHED __builtin_amdgcn_sched_barrier(0)
    Unit cur, nxt; int ui = 0;
    if (!S.next(0, cur)) return;
    f32x4 acc[2][2][4][2];
#pragma unroll
    for (int a = 0; a < 2; ++a)
#pragma unroll
        for (int b = 0; b < 2; ++b)
#pragma unroll
            for (int m = 0; m < 4; ++m)
#pragma unroll
                for (int n = 0; n < 2; ++n) acc[a][b][m][n] = (f32x4){0.f, 0.f, 0.f, 0.f};
    bf16x8 At[4][2], B0[2][2], B1[2][2];
    const char* cA = (const char*)g.A + (size_t)cur.pm * tstep; const char* cB = (const char*)g.Bt + (size_t)cur.pn * tstep;
    S.a_ready(cur);
    if constexpr (SP2) {
        PG8_STAGE(PG8_SB(0, 0), cB, voffB); PG8_STAGE(PG8_SB(0, 1), cB + hstep, voffB); PG8_STAGE(PG8_SA(0, 0), cA, voffA); PG8_STAGE(PG8_SA(0, 1), cA + hstep, voffA);
        if (wr == 1) PG8_BAR;
        PG8_WAIT_V(2); PG8_BAR;
        PG8_STAGE(PG8_SB(1, 0), cB + kstep, voffB); PG8_STAGE(PG8_SA(1, 0), cA + kstep, voffA); PG8_STAGE(PG8_SB(1, 1), cB + hstep + kstep, voffB);
        PG8_WAIT_V(6); PG8_BAR;
    } else {
        PG8_STAGE(PG8_SB(0, 0), cB, voffB); PG8_STAGE(PG8_SA(0, 0), cA, voffA); PG8_STAGE(PG8_SB(0, 1), cB + hstep, voffB); PG8_STAGE(PG8_SA(0, 1), cA + hstep, voffA);
        if (wr == 1) PG8_BAR;
        PG8_WAIT_V(4); PG8_BAR;
        PG8_STAGE(PG8_SB(1, 0), cB + kstep, voffB); PG8_STAGE(PG8_SA(1, 0), cA + kstep, voffA); PG8_STAGE(PG8_SB(1, 1), cB + hstep + kstep, voffB);
        PG8_WAIT_V(6); PG8_BAR;
    }
    for (;;) {
        const bool has_next = S.next(ui + 1, nxt);
        const char* nA = has_next ? (const char*)g.A + (size_t)nxt.pm * tstep : cA; const char* nB = has_next ? (const char*)g.Bt + (size_t)nxt.pn * tstep : cB;
        for (int t = 0; t < nt; t += 2) {
            const bool last = (t == nt - 2);
            const char* a1 = cA + (size_t)(t + 1) * kstep;
            const char* a2 = last ? nA : cA + (size_t)(t + 2) * kstep; const char* b2 = last ? nB : cB + (size_t)(t + 2) * kstep;
            const char* a3 = a2 + kstep; const char* b3 = b2 + kstep;
            if (last && has_next) S.a_ready(nxt);
            if constexpr (SP2) {
            PG8_LDB(B0, 0, 0); PG8_LDB(B1, 0, 1); PG8_SCHED; PG8_LDA(At, 0, 0); PG8_STAGE(PG8_SA(1, 1), a1 + hstep, voffA);
            PG8_WAIT_V(8); PG8_WAIT_L(0); PG8_BAR; PG8_MMA(0, 0, At, B0); PG8_MMA(0, 1, At, B1); PG8_BAR; PG8_SCHED;
            PG8_LDA(At, 0, 1); PG8_STAGE(PG8_SB(0, 0), b2, voffB); PG8_STAGE(PG8_SB(0, 1), b2 + hstep, voffB); PG8_STAGE(PG8_SA(0, 0), a2, voffA);
            PG8_WAIT_V(8); PG8_WAIT_L(0); PG8_BAR; PG8_MMA(1, 0, At, B0); PG8_MMA(1, 1, At, B1); PG8_BAR; PG8_SCHED;
            PG8_LDB(B0, 1, 0); PG8_LDB(B1, 1, 1); PG8_SCHED; PG8_LDA(At, 1, 0); PG8_STAGE(PG8_SA(0, 1), a2 + hstep, voffA);
            PG8_WAIT_V(8); PG8_WAIT_L(0); PG8_BAR; PG8_MMA(0, 0, At, B0); PG8_MMA(0, 1, At, B1); PG8_BAR; PG8_SCHED;
            PG8_LDA(At, 1, 1); PG8_STAGE(PG8_SB(1, 0), b3, voffB); PG8_STAGE(PG8_SB(1, 1), b3 + hstep, voffB); PG8_STAGE(PG8_SA(1, 0), a3, voffA);
            PG8_WAIT_V(8); PG8_WAIT_L(0); PG8_BAR; PG8_MMA(1, 0, At, B0); PG8_MMA(1, 1, At, B1); PG8_BAR; PG8_SCHED;
            } else {
            PG8_LDB(B0, 0, 0); PG8_SCHED; PG8_LDA(At, 0, 0); PG8_STAGE(PG8_SA(1, 1), a1 + hstep, voffA);
            PG8_WAIT_L(8); PG8_BAR; PG8_WAIT_L(0); PG8_MMA(0, 0, At, B0); PG8_BAR; PG8_SCHED;
            PG8_LDB(B1, 0, 1); PG8_STAGE(PG8_SB(0, 0), b2, voffB);
            PG8_BAR; PG8_WAIT_L(0); PG8_MMA(0, 1, At, B1); PG8_BAR;
            PG8_LDA(At, 0, 1); PG8_STAGE(PG8_SA(0, 0), a2, voffA);
            PG8_BAR; PG8_WAIT_L(0); PG8_MMA(1, 0, At, B0); PG8_BAR; PG8_SCHED;
            PG8_STAGE(PG8_SB(0, 1), b2 + hstep, voffB);
            PG8_WAIT_V(6); PG8_BAR; PG8_MMA(1, 1, At, B1); PG8_BAR;
            PG8_LDB(B0, 1, 0); PG8_SCHED; PG8_LDA(At, 1, 0); PG8_STAGE(PG8_SA(0, 1), a2 + hstep, voffA);
            PG8_WAIT_L(8); PG8_BAR; PG8_WAIT_L(0); PG8_MMA(0, 0, At, B0); PG8_BAR; PG8_SCHED;
            PG8_LDB(B1, 1, 1); PG8_STAGE(PG8_SB(1, 0), b3, voffB);
            PG8_BAR; PG8_WAIT_L(0); PG8_MMA(0, 1, At, B1); PG8_BAR;
            PG8_LDA(At, 1, 1); PG8_STAGE(PG8_SA(1, 0), a3, voffA);
            PG8_BAR; PG8_WAIT_L(0); PG8_MMA(1, 0, At, B0); PG8_BAR; PG8_SCHED;
            PG8_STAGE(PG8_SB(1, 1), b3 + hstep, voffB);
            PG8_WAIT_V(6); PG8_BAR; PG8_MMA(1, 1, At, B1); PG8_BAR;
            }
        }
        if constexpr (ALIGN_EPI) { if (wr == 0) PG8_BAR; }
        if constexpr (!Epi::AFTER_DRAIN) { E(acc, cur, wr, wc, fr, fq); S.done(cur); }
        if (!has_next) break;
#pragma unroll
        for (int a = 0; a < 2; ++a)
#pragma unroll
            for (int b = 0; b < 2; ++b)
#pragma unroll
                for (int m = 0; m < 4; ++m)
#pragma unroll
                    for (int n = 0; n < 2; ++n) acc[a][b][m][n] = (f32x4){0.f, 0.f, 0.f, 0.f};
        cur = nxt; cA = nA; cB = nB; ++ui;
        if constexpr (ALIGN_EPI) { if (wr == 1) PG8_BAR; }
    }
    PG8_WAIT_V(0);
    if constexpr (!ALIGN_EPI) { if (wr == 0) PG8_BAR; }
    PG8_BAR;
    if constexpr (Epi::AFTER_DRAIN) { E.fused(acc, cur, wr, wc, fr, fq, lds, wid, lane); S.done(cur); }
#undef PG8_SA
#undef PG8_SB
#undef PG8_STAGE
#undef PG8_LDA
#undef PG8_LDB
#undef PG8_MMA
#undef PG8_WAIT_V
#undef PG8_WAIT_L
#undef PG8_BAR
#undef PG8_SCHED
}
}
#ifndef PG8_SP2
#define PG8_SP2 true
#endif
#ifndef PG8_ALIGN
#define PG8_ALIGN true
#endif

constexpr int NWAVES = 8;
#ifndef MK_N_LAUNCHES
#define MK_N_LAUNCHES 1
#endif
constexpr int PER_PHASE = 9;
constexpr int N_LAUNCHES = MK_N_LAUNCHES;

constexpr int BATCH = 32, SEQ = 2048, D = 1024, M = BATCH * SEQ, FF = 4096, NPROJ = 4096, IN_COLS = 4104, NMOD = 6 * D;
constexpr float EPS = 1e-6f;
constexpr float LOG2E = 1.4426950408889634f, C2 = 0.18033688011112042f;
constexpr int C_FQ = 0, C_FK = 512, C_FV = 1024, C_FOG = 1536, C_RQ = 2048, C_RK = 2560, C_RV = 3072, C_RG = 3584;
constexpr int MOD_SHIFT_M = 0, MOD_SCALE_M = 1024, MOD_GATE_M = 2048, MOD_SHIFT_F = 3072, MOD_SCALE_F = 4096, MOD_GATE_F = 5120;

constexpr size_t MiB = 1u << 20;
constexpr size_t WS_CTL = 0, CTL_ZERO_BYTES = 2 * MiB;
constexpr size_t WS_MOD = 1 * MiB;
constexpr size_t WS_WIN = 2 * MiB, WS_WOUT = 10 * MiB, WS_W1 = 12 * MiB, WS_W2 = 20 * MiB;
constexpr size_t WS_WF = 28 * MiB;
constexpr size_t WS_ROPE = 29 * MiB;
constexpr size_t WS_LOGF = 30 * MiB, WS_CUM = 32 * MiB;
constexpr size_t WS_H = 64 * MiB, WS_MIX = 192 * MiB, WS_PROJ = 320 * MiB, WS_U = 320 * MiB, WS_END = 832 * MiB;
constexpr int CW_BAR = 4096;

constexpr int RING_OFF = 0, RING_BYTES = 131072;
constexpr int LDSCTL_OFF = RING_BYTES, MISC_OFF = LDSCTL_OFF + 320;
constexpr int LDS_BYTES = 147456;
#define GAS __attribute__((address_space(1)))
#define LAS __attribute__((address_space(3)))
typedef unsigned short bf16;
typedef unsigned v4u __attribute__((ext_vector_type(4)));
typedef float f32x4 __attribute__((ext_vector_type(4)));
typedef short bf16x8 __attribute__((ext_vector_type(8)));
typedef GAS unsigned gu32;
typedef GAS unsigned long long gu64;
#define RLX_AGENT __ATOMIC_RELAXED, __HIP_MEMORY_SCOPE_AGENT
#define LDS_WAIT() asm volatile("s_waitcnt lgkmcnt(0)" ::: "memory")
#define VM_WAIT() asm volatile("s_waitcnt vmcnt(0)" ::: "memory")
__device__ __forceinline__ unsigned long long rt() { return __builtin_amdgcn_s_memrealtime(); }
__device__ __forceinline__ unsigned f2bf(float f) { unsigned u = __builtin_bit_cast(unsigned, f); return (u + 0x7fffu + ((u >> 16) & 1u)) >> 16; }
__device__ __forceinline__ unsigned pk2(float lo, float hi) { return f2bf(lo) | (f2bf(hi) << 16); }

#define XB_TMO      128
#define XB_XCNT(j)  (256  + 64 * (j))
#define XB_XSUB(j)  (1280 + 64 * (j))
#define XB_XGEN(j)  (2304 + 64 * (j))
#define XB_TOP      3328
#define XB_TOPGEN   3392
#define XCD_BAR_WORDS 3456
#define XB_SPIN_CAP (1u << 18)

__device__ __forceinline__ unsigned xb_ld(unsigned* p)              { return __hip_atomic_load(p, __ATOMIC_RELAXED, __HIP_MEMORY_SCOPE_AGENT); }
__device__ __forceinline__ unsigned xb_add(unsigned* p, unsigned v) { return __hip_atomic_fetch_add(p, v, __ATOMIC_RELAXED, __HIP_MEMORY_SCOPE_AGENT); }
__device__ __forceinline__ unsigned xb_xcc_id() { return (unsigned)__builtin_amdgcn_s_getreg((3 << 11) | 20) & 0xFu; }
#define XB_SPIN(cond, bar) do { unsigned _sp = 0; while (cond) { __builtin_amdgcn_s_sleep(1); \
    if ((++_sp & 255u) == 0u) { if (xb_ld(&(bar)[XB_TMO])) break; if (_sp > XB_SPIN_CAP) { atomicAdd(&(bar)[XB_TMO], 1u); break; } } } } while (0)

struct XcdBarrier {
    unsigned* bar; unsigned x;
    volatile LAS unsigned* st;
};

__device__ __forceinline__ XcdBarrier xcd_barrier_post(unsigned* bar, volatile LAS unsigned* st) {
    XcdBarrier b; b.bar = bar; b.x = xb_xcc_id(); b.st = st;
    if (threadIdx.x == 0) (void)xb_add(&bar[XB_XCNT(b.x)], 1u);
    return b;
}
__device__ __forceinline__ void xcd_barrier_complete(unsigned* bar, unsigned x, unsigned& nloc, unsigned& nx) {
    const unsigned G = gridDim.x * gridDim.y * gridDim.z;
    unsigned sum, cnt, mine, sp = 0u;
    for (;;) {
        sum = 0u; cnt = 0u; mine = 0u;
#pragma unroll
        for (unsigned j = 0; j < 16; ++j) { const unsigned c = xb_ld(&bar[XB_XCNT(j)]); sum += c; cnt += (c > 0u) ? 1u : 0u; mine = (j == x) ? c : mine; }
        if (sum == G) break;
        __builtin_amdgcn_s_sleep(1);
        if ((++sp & 255u) == 0u) { if (xb_ld(&bar[XB_TMO])) break; if (sp > XB_SPIN_CAP) { atomicAdd(&bar[XB_TMO], 1u); break; } }
    }
    nloc = mine > 0u ? mine : 1u; nx = cnt > 0u ? cnt : 1u;
}

__device__ __forceinline__ void xcd_barrier(const XcdBarrier& b) {
    asm volatile("s_waitcnt vmcnt(0)" ::: "memory");
    __syncthreads();
    if (threadIdx.x == 0) {
        unsigned* bar = b.bar;
        __builtin_amdgcn_s_waitcnt(0);
        unsigned nloc = b.st[0], nx = b.st[1];
        if (nloc == 0u) { xcd_barrier_complete(bar, b.x, nloc, nx); b.st[0] = nloc; b.st[1] = nx; }
        const unsigned old = xb_add(&bar[XB_XSUB(b.x)], 1u);
        const unsigned gen = old / nloc;
        if (old + 1u == (gen + 1u) * nloc) {
            __builtin_amdgcn_fence(__ATOMIC_RELEASE, "agent");
            asm volatile("s_waitcnt vmcnt(0)" ::: "memory");
            const unsigned og = xb_add(&bar[XB_TOP], 1u);
            const unsigned tg = og / nx;
            if (og + 1u == (tg + 1u) * nx) xb_add(&bar[XB_TOPGEN], 1u);
            else XB_SPIN(xb_ld(&bar[XB_TOPGEN]) == tg, bar);
            __builtin_amdgcn_fence(__ATOMIC_ACQUIRE, "agent");
            xb_add(&bar[XB_XGEN(b.x)], 1u);
            asm volatile("s_waitcnt vmcnt(0)" ::: "memory");
        } else {
            XB_SPIN(xb_ld(&bar[XB_XGEN(b.x)]) == gen, bar);
            __builtin_amdgcn_fence(__ATOMIC_ACQUIRE, "agent");
            asm volatile("s_waitcnt vmcnt(0)" ::: "memory");
        }
    }
    __syncthreads();
}

struct Frame {
    LAS unsigned char* lds;
    volatile LAS unsigned* MISC;
    gu32* ctl;
    int tid, lane, wave;
    int vcu, G;
    const float *x, *c, *w_ada, *b_ada, *w_in, *b_forget, *qg, *kg, *fog, *rog, *w_out, *w1, *w2; float* out;
    bf16 *Win_t, *Wout_t, *W1_t, *W2_t;
    float *wf, *rope, *logf, *cum, *mod;
    bf16 *H, *MIXB, *PROJ, *U;
};
__device__ __forceinline__ float bf2f(unsigned short v) { return __uint_as_float((unsigned)v << 16); }
__device__ __forceinline__ float bflo(unsigned w) { return __uint_as_float(w << 16); }
__device__ __forceinline__ float bfhi(unsigned w) { return __uint_as_float(w & 0xffff0000u); }
__device__ __forceinline__ void unpack8(const v4u w, float* f) { f[0] = bflo(w.x); f[1] = bfhi(w.x); f[2] = bflo(w.y); f[3] = bfhi(w.y); f[4] = bflo(w.z); f[5] = bfhi(w.z); f[6] = bflo(w.w); f[7] = bfhi(w.w); }
__device__ __forceinline__ v4u pack8(const float* f) { v4u w; w.x = pk2(f[0], f[1]); w.y = pk2(f[2], f[3]); w.z = pk2(f[4], f[5]); w.w = pk2(f[6], f[7]); return w; }

__device__ __forceinline__ void p0_transpose_item(const float* W, int K, int ldn, int col_off, int nblk, bf16* WT, int row_off, LAS float* scr, int item, int lane) {
    const int kb = item / nblk, nb = item % nblk, k0 = 64 * kb, n0 = 32 * nb;
#pragma unroll 8
    for (int i = 0; i < 32; ++i) { const int kk = 2 * i + (lane >> 5); scr[kk * 33 + (lane & 31)] = W[(size_t)(k0 + kk) * ldn + col_off + n0 + (lane & 31)]; }
    LDS_WAIT(); asm volatile("" ::: "memory");
    const int c = lane & 7;
#pragma unroll
    for (int j = 0; j < 4; ++j) { const int n = (lane >> 3) + 8 * j; const LAS float* s = scr + (8 * c) * 33 + n;
        v4u o; o.x = pk2(s[0 * 33], s[1 * 33]); o.y = pk2(s[2 * 33], s[3 * 33]); o.z = pk2(s[4 * 33], s[5 * 33]); o.w = pk2(s[6 * 33], s[7 * 33]);
        *(GAS v4u*)(WT + (size_t)(row_off + n0 + n) * K + k0 + 8 * c) = o; }
    LDS_WAIT(); asm volatile("" ::: "memory");
}
__device__ __forceinline__ void p0_mod_item(Frame& F, LAS float* scr, int item) {
    const int cg = item % 96, ks = item / 96; const int e = cg * 64 + F.lane, k0 = ks * 128;
#pragma unroll 4
    for (int i = 0; i < 64; ++i) { const int idx = i * 64 + F.lane; const int kk = idx >> 5, b = idx & 31; const float cv = F.c[b * D + k0 + kk]; scr[idx] = cv / (1.f + expf(-cv)); }
    LDS_WAIT(); asm volatile("" ::: "memory");
    float acc[32];
#pragma unroll
    for (int b = 0; b < 32; ++b) acc[b] = 0.f;
#pragma unroll 4
    for (int kk = 0; kk < 128; ++kk) { const float w = F.w_ada[(size_t)(k0 + kk) * NMOD + e];
#pragma unroll
        for (int b4 = 0; b4 < 8; ++b4) { const f32x4 s = *(const LAS f32x4*)(scr + kk * 32 + 4 * b4);
            acc[4 * b4 + 0] += s.x * w; acc[4 * b4 + 1] += s.y * w; acc[4 * b4 + 2] += s.z * w; acc[4 * b4 + 3] += s.w * w; } }
    const float bias = (ks == 0) ? F.b_ada[e] : 0.f;
#pragma unroll
    for (int b = 0; b < 32; ++b) atomicAdd(&F.mod[b * NMOD + e], acc[b] + bias);
    LDS_WAIT(); asm volatile("" ::: "memory");
}
__device__ __forceinline__ void p0_rope_item(Frame& F, int s) {
    const int j = F.lane;
    double f = 1.0, p = 0.86596432336006535; int e = j;
#pragma unroll
    for (int bit = 0; bit < 6; ++bit) { if (e & 1) f *= p; p *= p; e >>= 1; }
    const double ang = (double)s * f;
    const double kq = rint(ang * 0.63661977236758134);
    const double r = fma(-kq, 1.5707963267948966, ang) - kq * 6.123233995736766e-17;
    const double r2 = r * r;
    const double sn = r * (1.0 + r2 * (-1.0 / 6.0 + r2 * (1.0 / 120.0 + r2 * (-1.0 / 5040.0 + r2 * (1.0 / 362880.0 + r2 * (-1.0 / 39916800.0 + r2 * (1.0 / 6227020800.0)))))));
    const double cs = 1.0 + r2 * (-0.5 + r2 * (1.0 / 24.0 + r2 * (-1.0 / 720.0 + r2 * (1.0 / 40320.0 + r2 * (-1.0 / 3628800.0 + r2 * (1.0 / 479001600.0 + r2 * (-1.0 / 87178291200.0)))))));
    const int q = ((int)kq) & 3;
    const double S = (q == 0) ? sn : (q == 1) ? cs : (q == 2) ? -sn : -cs;
    const double C = (q == 0) ? cs : (q == 1) ? -sn : (q == 2) ? -cs : sn;
    F.rope[s * 128 + j] = (float)C; F.rope[s * 128 + 64 + j] = (float)S;
}
__device__ __forceinline__ void p0_prologue(Frame& F) {
    LAS float* scr = (LAS float*)(F.lds + RING_OFF + F.wave * 16384);
    const int gw = F.vcu * NWAVES + F.wave, NGW = F.G * NWAVES;
    constexpr int I_INA = (D / 64) * (2048 / 32), I_INB = I_INA, I_O = (D / 64) * (D / 32), I_1 = (D / 64) * (FF / 32), I_2 = (FF / 64) * (D / 32);
    constexpr int I_MOD = 96 * 8, I_ROPE = SEQ, I_WF = 8;
    constexpr int NITEMS = I_MOD + I_INA + I_INB + I_O + I_1 + I_2 + I_ROPE + I_WF;
    for (int it = gw; it < NITEMS; it += NGW) {
        int r = it;
        if (r < I_MOD) { p0_mod_item(F, scr, r); continue; } r -= I_MOD;
        if (r < I_INA) { p0_transpose_item(F.w_in, D, IN_COLS, 0, 2048 / 32, F.Win_t, 0, scr, r, F.lane); continue; } r -= I_INA;
        if (r < I_INB) { p0_transpose_item(F.w_in, D, IN_COLS, 2056, 2048 / 32, F.Win_t, 2048, scr, r, F.lane); continue; } r -= I_INB;
        if (r < I_O) { p0_transpose_item(F.w_out, D, D, 0, D / 32, F.Wout_t, 0, scr, r, F.lane); continue; } r -= I_O;
        if (r < I_1) { p0_transpose_item(F.w1, D, FF, 0, FF / 32, F.W1_t, 0, scr, r, F.lane); continue; } r -= I_1;
        if (r < I_2) { p0_transpose_item(F.w2, FF, D, 0, D / 32, F.W2_t, 0, scr, r, F.lane); continue; } r -= I_2;
        if (r < I_ROPE) { p0_rope_item(F, r); continue; } r -= I_ROPE;
        { for (int k = F.lane; k < D; k += 64) F.wf[r * D + k] = F.w_in[(size_t)k * IN_COLS + 2048 + r]; }
    }
}

__device__ __forceinline__ float wave_sum(float v) {
#pragma unroll
    for (int o = 1; o < 64; o <<= 1) v += __shfl_xor(v, o);
    return v;
}
__device__ __forceinline__ float reduce8(const float* p, int lane) {
    const bool b0 = lane & 1, b1 = lane & 2, b2 = lane & 4;
    float q[4], r[2];
#pragma unroll
    for (int i = 0; i < 4; ++i) { const float send = b0 ? p[i] : p[i + 4], keep = b0 ? p[i + 4] : p[i]; q[i] = keep + __shfl_xor(send, 1); }
#pragma unroll
    for (int i = 0; i < 2; ++i) { const float send = b1 ? q[i] : q[i + 2], keep = b1 ? q[i + 2] : q[i]; r[i] = keep + __shfl_xor(send, 2); }
    const float send = b2 ? r[0] : r[1], keep = b2 ? r[1] : r[0];
    float s = keep + __shfl_xor(send, 4);
    s += __shfl_xor(s, 8); s += __shfl_xor(s, 16); s += __shfl_xor(s, 32);
    return s;
}
template <bool FORGET> __device__ __forceinline__ void norm_phase(Frame& F, const float* xin, int mod_scale, int mod_shift) {
    LAS float* sc = (LAS float*)F.lds; LAS float* sh = sc + 1024; LAS float* wfl = sh + 1024; LAS float* bfl = wfl + 8192;
    for (int chunk = F.vcu; chunk < M / 256; chunk += F.G) {
        const int b = chunk >> 3;
        __syncthreads();
        for (int i = F.tid; i < 1024; i += NWAVES * 64) { sc[i] = 1.f + F.mod[b * NMOD + mod_scale + i]; sh[i] = F.mod[b * NMOD + mod_shift + i]; }
        if (FORGET) { for (int i = F.tid; i < 8192; i += NWAVES * 64) wfl[i] = F.wf[i]; if (F.tid < 8) bfl[F.tid] = F.b_forget[F.tid]; }
        __syncthreads();
        for (int rp = 0; rp < 32; ++rp) {
            const int row = chunk * 256 + F.wave * 32 + rp;
            const GAS f32x4* xr = (const GAS f32x4*)(xin + (size_t)row * D) + F.lane;
            f32x4 v[4]; float ss = 0.f;
#pragma unroll
            for (int j = 0; j < 4; ++j) { v[j] = xr[64 * j]; ss += (v[j].x * v[j].x + v[j].y * v[j].y) + (v[j].z * v[j].z + v[j].w * v[j].w); }
            const float rstd = rsqrtf(wave_sum(ss) * (1.f / D) + EPS);
            GAS unsigned long long* o8 = (GAS unsigned long long*)(F.H + (size_t)row * D) + F.lane;
#pragma unroll
            for (int j = 0; j < 4; ++j) { const f32x4 s4 = *(const LAS f32x4*)(sc + 4 * F.lane + 256 * j), h4 = *(const LAS f32x4*)(sh + 4 * F.lane + 256 * j);
                v[j] = v[j] * rstd * s4 + h4;
                o8[64 * j] = (unsigned long long)pk2(v[j].x, v[j].y) | ((unsigned long long)pk2(v[j].z, v[j].w) << 32); }
            if (FORGET) {
                float p[8];
#pragma unroll
                for (int hh = 0; hh < 8; ++hh) { float a = 0.f;
#pragma unroll
                    for (int j = 0; j < 4; ++j) { const f32x4 w4 = *(const LAS f32x4*)(wfl + hh * 1024 + 4 * F.lane + 256 * j); a += (v[j].x * w4.x + v[j].y * w4.y) + (v[j].z * w4.z + v[j].w * w4.w); }
                    p[hh] = a; }
                const float tot = reduce8(p, F.lane);
                if (F.lane < 8) { const int hs = 4 * (F.lane & 1) + 2 * ((F.lane >> 1) & 1) + ((F.lane >> 2) & 1);
                    const float z = tot + bfl[hs];
                    const float lf = fminf(z, 0.f) - log1pf(expf(-fabsf(z)));
                    F.logf[((size_t)(b * 8 + hs)) * SEQ + (row & (SEQ - 1))] = lf; }
            }
        }
    }
}
__device__ __forceinline__ void cumsum_seq(Frame& F, int seq) {
    const float* src = F.logf + (size_t)seq * SEQ + 32 * F.lane; float* dst = F.cum + (size_t)seq * SEQ + 32 * F.lane;
    double run = 0.0; float v[32];
#pragma unroll
    for (int i = 0; i < 8; ++i) { const f32x4 t = *(const f32x4*)(src + 4 * i); v[4 * i] = t.x; v[4 * i + 1] = t.y; v[4 * i + 2] = t.z; v[4 * i + 3] = t.w; }
#pragma unroll
    for (int i = 0; i < 32; ++i) run += (double)v[i];
    double t = run;
#pragma unroll
    for (int o = 1; o < 64; o <<= 1) { const double n = __shfl_up(t, o); if (F.lane >= o) t += n; }
    double acc = t - run;
#pragma unroll
    for (int i = 0; i < 8; ++i) { f32x4 o4; acc += (double)v[4 * i]; o4.x = (float)(acc * 1.4426950408889634); acc += (double)v[4 * i + 1]; o4.y = (float)(acc * 1.4426950408889634);
        acc += (double)v[4 * i + 2]; o4.z = (float)(acc * 1.4426950408889634); acc += (double)v[4 * i + 3]; o4.w = (float)(acc * 1.4426950408889634); *(f32x4*)(dst + 4 * i) = o4; }
}

__device__ __forceinline__ void post_row(Frame& F, size_t row) {
    bf16* p = F.PROJ + row * NPROJ; const int lane = F.lane; const int s = (int)(row & (SEQ - 1));
    {
        const int hd = lane >> 2, sl = lane & 3; bf16* a = p + hd * 64 + sl * 16;
        float v[16]; unpack8(*(const v4u*)a, v); unpack8(*(const v4u*)(a + 8), v + 8);
        float ss = 0.f;
#pragma unroll
        for (int i = 0; i < 16; ++i) ss += v[i] * v[i];
        ss += __shfl_xor(ss, 1); ss += __shfl_xor(ss, 2);
        const float rstd = rsqrtf(ss * (1.f / 64.f) + EPS);
        const float* g = ((hd < 8) ? F.qg : F.kg) + sl * 16; const float scl = (hd < 8) ? C2 * rstd : rstd;
#pragma unroll
        for (int i = 0; i < 16; ++i) v[i] = v[i] * scl * g[i];
        *(v4u*)a = pack8(v); *(v4u*)(a + 8) = pack8(v + 8);
    }
    {
        const int hh = lane >> 3, i0 = (lane & 7) * 8; bf16* a = p + C_RQ + hh * 128 + i0;
        float x1[8], x2[8]; unpack8(*(const v4u*)a, x1); unpack8(*(const v4u*)(a + 64), x2);
        const float* ct = F.rope + s * 128 + i0; const float* st = ct + 64;
        const float scl = (hh >= 4) ? 0.08838834764831845f : 1.f;
        float y1[8], y2[8];
#pragma unroll
        for (int i = 0; i < 8; ++i) { const float c = ct[i], sn = st[i]; y1[i] = (x1[i] * c - x2[i] * sn) * scl; y2[i] = (x1[i] * sn + x2[i] * c) * scl; }
        *(v4u*)a = pack8(y1); *(v4u*)(a + 64) = pack8(y2);
    }
}

__device__ __forceinline__ void fox_naive_unit(Frame& F, int b, int h, int qb) {
    LAS float* Ks = (LAS float*)F.lds; LAS float* Vs = Ks + 4096; LAS float* ck = Vs + 4096;
    const int t = F.tid, qi = t >> 2, sl = t & 3; const int tq = 128 * qb + qi; const size_t row = (size_t)b * SEQ + tq;
    const bf16* P = F.PROJ;
    float q[16]; unpack8(*(const v4u*)(P + row * NPROJ + C_FQ + h * 64 + sl * 16), q); unpack8(*(const v4u*)(P + row * NPROJ + C_FQ + h * 64 + sl * 16 + 8), q + 8);
    const float* cum = F.cum + (size_t)(b * 8 + h) * SEQ; const float cq = cum[tq];
    float m = -INFINITY, l = 0.f; float o[16];
#pragma unroll
    for (int i = 0; i < 16; ++i) o[i] = 0.f;
    const int nkt = 2 * (qb + 1);
    for (int kt = 0; kt < nkt; ++kt) {
        __syncthreads();
        { const size_t krow = (size_t)b * SEQ + 64 * kt + (t >> 3); float f[8];
          unpack8(*(const v4u*)(P + krow * NPROJ + C_FK + h * 64 + (t & 7) * 8), f);
          *(LAS f32x4*)(Ks + (t >> 3) * 64 + (t & 7) * 8) = (f32x4){f[0], f[1], f[2], f[3]}; *(LAS f32x4*)(Ks + (t >> 3) * 64 + (t & 7) * 8 + 4) = (f32x4){f[4], f[5], f[6], f[7]};
          unpack8(*(const v4u*)(P + krow * NPROJ + C_FV + h * 64 + (t & 7) * 8), f);
          *(LAS f32x4*)(Vs + (t >> 3) * 64 + (t & 7) * 8) = (f32x4){f[0], f[1], f[2], f[3]}; *(LAS f32x4*)(Vs + (t >> 3) * 64 + (t & 7) * 8 + 4) = (f32x4){f[4], f[5], f[6], f[7]};
          if (t < 64) ck[t] = cum[64 * kt + t]; }
        __syncthreads();
#pragma unroll 2
        for (int kk = 0; kk < 64; ++kk) {
            const LAS float* kr = Ks + kk * 64 + sl * 16; float part = 0.f;
#pragma unroll
            for (int i4 = 0; i4 < 4; ++i4) { const f32x4 k4 = *(const LAS f32x4*)(kr + 4 * i4); part += (q[4 * i4] * k4.x + q[4 * i4 + 1] * k4.y) + (q[4 * i4 + 2] * k4.z + q[4 * i4 + 3] * k4.w); }
            part += __shfl_xor(part, 1); part += __shfl_xor(part, 2);
            float lg = part + (cq - ck[kk]); if (64 * kt + kk > tq) lg = -INFINITY;
            const float mn = fmaxf(m, lg); const float al = exp2f(m - mn), pp = exp2f(lg - mn);
            l = l * al + pp; m = mn;
            const LAS float* vr = Vs + kk * 64 + sl * 16;
#pragma unroll
            for (int i4 = 0; i4 < 4; ++i4) { const f32x4 v4 = *(const LAS f32x4*)(vr + 4 * i4);
                o[4 * i4] = o[4 * i4] * al + pp * v4.x; o[4 * i4 + 1] = o[4 * i4 + 1] * al + pp * v4.y; o[4 * i4 + 2] = o[4 * i4 + 2] * al + pp * v4.z; o[4 * i4 + 3] = o[4 * i4 + 3] * al + pp * v4.w; }
        }
    }
    const float il = 1.f / l; float ss = 0.f;
#pragma unroll
    for (int i = 0; i < 16; ++i) { o[i] *= il; ss += o[i] * o[i]; }
    ss += __shfl_xor(ss, 1); ss += __shfl_xor(ss, 2);
    const float rstd = rsqrtf(ss * (1.f / 64.f) + EPS);
    float g[16]; unpack8(*(const v4u*)(P + row * NPROJ + C_FOG + h * 64 + sl * 16), g); unpack8(*(const v4u*)(P + row * NPROJ + C_FOG + h * 64 + sl * 16 + 8), g + 8);
    const float* gn = F.fog + h * 64 + sl * 16;
#pragma unroll
    for (int i = 0; i < 16; ++i) o[i] = o[i] * rstd * gn[i] * (1.f / (1.f + expf(-g[i])));
    bf16* dst = F.MIXB + row * D + h * 64 + sl * 16;
    *(v4u*)dst = pack8(o); *(v4u*)(dst + 8) = pack8(o + 8);
}
__device__ __forceinline__ void ret_naive_unit(Frame& F, int b, int h, int qb) {
    LAS float* Ks = (LAS float*)F.lds; LAS float* Vs = Ks + 8192;
    const int t = F.tid, qi = t >> 2, sl = t & 3; const int tq = 128 * qb + qi; const size_t row = (size_t)b * SEQ + tq;
    const bf16* P = F.PROJ;
    float q[32];
#pragma unroll
    for (int i = 0; i < 4; ++i) unpack8(*(const v4u*)(P + row * NPROJ + C_RQ + h * 128 + sl * 32 + 8 * i), q + 8 * i);
    const float lg2 = (h == 0) ? -0.04580368961312479f : (h == 1) ? -0.02272007650008353f : (h == 2) ? -0.011315313227834146f : -0.005646563141142063f;
    float o[32];
#pragma unroll
    for (int i = 0; i < 32; ++i) o[i] = 0.f;
    const int nkt = 2 * (qb + 1);
    for (int kt = 0; kt < nkt; ++kt) {
        __syncthreads();
#pragma unroll
        for (int rep = 0; rep < 2; ++rep) { const int id = t + rep * 512; const int kr = id >> 4, ch = id & 15; const size_t krow = (size_t)b * SEQ + 64 * kt + kr; float f[8];
            unpack8(*(const v4u*)(P + krow * NPROJ + C_RK + h * 128 + ch * 8), f);
            *(LAS f32x4*)(Ks + kr * 128 + ch * 8) = (f32x4){f[0], f[1], f[2], f[3]}; *(LAS f32x4*)(Ks + kr * 128 + ch * 8 + 4) = (f32x4){f[4], f[5], f[6], f[7]};
            unpack8(*(const v4u*)(P + krow * NPROJ + C_RV + h * 128 + ch * 8), f);
            *(LAS f32x4*)(Vs + kr * 128 + ch * 8) = (f32x4){f[0], f[1], f[2], f[3]}; *(LAS f32x4*)(Vs + kr * 128 + ch * 8 + 4) = (f32x4){f[4], f[5], f[6], f[7]}; }
        __syncthreads();
#pragma unroll 2
        for (int kk = 0; kk < 64; ++kk) {
            const LAS float* kr = Ks + kk * 128 + sl * 32; float part = 0.f;
#pragma unroll
            for (int i4 = 0; i4 < 8; ++i4) { const f32x4 k4 = *(const LAS f32x4*)(kr + 4 * i4); part += (q[4 * i4] * k4.x + q[4 * i4 + 1] * k4.y) + (q[4 * i4 + 2] * k4.z + q[4 * i4 + 3] * k4.w); }
            part += __shfl_xor(part, 1); part += __shfl_xor(part, 2);
            const int dist = tq - (64 * kt + kk);
            const float w = (dist >= 0) ? part * exp2f((float)dist * lg2) : 0.f;
            const LAS float* vr = Vs + kk * 128 + sl * 32;
#pragma unroll
            for (int i4 = 0; i4 < 8; ++i4) { const f32x4 v4 = *(const LAS f32x4*)(vr + 4 * i4);
                o[4 * i4] += w * v4.x; o[4 * i4 + 1] += w * v4.y; o[4 * i4 + 2] += w * v4.z; o[4 * i4 + 3] += w * v4.w; }
        }
    }
    float ss = 0.f;
#pragma unroll
    for (int i = 0; i < 32; ++i) ss += o[i] * o[i];
    ss += __shfl_xor(ss, 1); ss += __shfl_xor(ss, 2);
    const float rstd = rsqrtf(ss * (1.f / 128.f) + EPS);
    const float* gn = F.rog + h * 128 + sl * 32;
    bf16* dst = F.MIXB + row * D + 512 + h * 128 + sl * 32;
#pragma unroll
    for (int i = 0; i < 4; ++i) { float g[8]; unpack8(*(const v4u*)(P + row * NPROJ + C_RG + h * 128 + sl * 32 + 8 * i), g); float r[8];
#pragma unroll
        for (int e = 0; e < 8; ++e) { const float z = g[e]; r[e] = o[8 * i + e] * rstd * gn[8 * i + e] * (z / (1.f + expf(-z))); }
        *(v4u*)(dst + 8 * i) = pack8(r); }
}
__device__ __forceinline__ void mixer_naive_phase(Frame& F) {
    for (int bh = F.vcu; bh < BATCH * 8; bh += F.G) for (int qb = 0; qb < 16; ++qb) fox_naive_unit(F, bh >> 3, bh & 7, qb);
    for (int id = F.vcu; id < BATCH * 4 * 2; id += F.G) { const int bh = id >> 1, par = id & 1;
        for (int i = 0; i < 8; ++i) { const int qb = (i & 1) ? 15 - (i - 1) - par : i + par; ret_naive_unit(F, bh >> 2, bh & 3, qb); } }
    __syncthreads();
}

struct Args { const float* in[13]; float* out; unsigned char* ws; int ph_lo, ph_hi, li, pad; };
__global__ void __launch_bounds__(NWAVES * 64, 2) skel_fwd(Args args) {
    extern __shared__ __attribute__((aligned(16))) unsigned char lds[];
    Frame F;
    F.lds = (LAS unsigned char*)lds;
    F.MISC = (volatile LAS unsigned*)(F.lds + MISC_OFF);
    F.tid = threadIdx.x; F.lane = F.tid & 63; F.wave = __builtin_amdgcn_readfirstlane(F.tid >> 6);
    F.G = gridDim.x; { const int bx = blockIdx.x; F.vcu = (F.G % 8 == 0) ? (bx % 8) * (F.G / 8) + bx / 8 : bx; }
    unsigned char* ws = args.ws;
    F.ctl = (gu32*)(ws + WS_CTL);
    F.x = args.in[0]; F.c = args.in[1]; F.w_ada = args.in[2]; F.b_ada = args.in[3]; F.w_in = args.in[4]; F.b_forget = args.in[5]; F.qg = args.in[6]; F.kg = args.in[7];
    F.fog = args.in[8]; F.rog = args.in[9]; F.w_out = args.in[10]; F.w1 = args.in[11]; F.w2 = args.in[12]; F.out = args.out;
    F.Win_t = (bf16*)(ws + WS_WIN); F.Wout_t = (bf16*)(ws + WS_WOUT); F.W1_t = (bf16*)(ws + WS_W1); F.W2_t = (bf16*)(ws + WS_W2);
    F.wf = (float*)(ws + WS_WF); F.rope = (float*)(ws + WS_ROPE); F.logf = (float*)(ws + WS_LOGF); F.cum = (float*)(ws + WS_CUM); F.mod = (float*)(ws + WS_MOD);
    F.H = (bf16*)(ws + WS_H); F.MIXB = (bf16*)(ws + WS_MIX); F.PROJ = (bf16*)(ws + WS_PROJ); F.U = (bf16*)(ws + WS_U);
    for (int u = F.tid; u < (LDS_BYTES - LDSCTL_OFF) / 4; u += NWAVES * 64) ((LAS unsigned*)(F.lds + LDSCTL_OFF))[u] = 0u;
    __syncthreads();
    XcdBarrier bar; bar.bar = (unsigned*)(F.ctl + CW_BAR); bar.x = 0; bar.st = nullptr;
    if (N_LAUNCHES != PER_PHASE) bar = xcd_barrier_post((unsigned*)(F.ctl + CW_BAR), F.MISC + 8);
#define GRID_BAR() do { if (N_LAUNCHES != PER_PHASE) xcd_barrier(bar); } while (0)
    const int lo = args.ph_lo, hi = args.ph_hi;
#define IN(k) (lo <= (k) && (k) < hi)
#define BOTH(k) (IN(k) && IN((k) + 1))
    if (IN(0)) { p0_prologue(F); if (BOTH(0)) GRID_BAR(); }
    if (IN(1)) { norm_phase<true>(F, F.x, MOD_SCALE_M, MOD_SHIFT_M); if (BOTH(1)) GRID_BAR(); }
    if (IN(2)) {
        for (int seq = F.vcu; seq < BATCH * 8; seq += F.G) if (F.wave == 0) cumsum_seq(F, seq);
        pg8::Gemm g{F.H, F.Win_t, M, NPROJ, D}; pg8::StaticOrder S; S.init(M, NPROJ, F.G, (int)blockIdx.x);
        pg8::EpiBf16<0> E{F.PROJ, NPROJ};
        pg8::gemm_phase<pg8::EpiBf16<0>, pg8::StaticOrder, PG8_ALIGN, PG8_SP2>(F.lds + RING_OFF, g, S, E);
        if (BOTH(2)) GRID_BAR();
    }
    if (IN(3)) { const int gw = F.vcu * NWAVES + F.wave, NGW = F.G * NWAVES; for (int r = gw; r < M; r += NGW) post_row(F, (size_t)r); if (BOTH(3)) GRID_BAR(); }
    if (IN(4)) { mixer_naive_phase(F); if (BOTH(4)) GRID_BAR(); }
    if (IN(5)) {
        pg8::Gemm g{F.MIXB, F.Wout_t, M, D, D}; pg8::StaticOrder S; S.init(M, D, F.G, (int)blockIdx.x);
        pg8::EpiResGate E{F.x, F.out, D, F.mod + MOD_GATE_M, NMOD, SEQ / 256};
        pg8::gemm_phase<pg8::EpiResGate, pg8::StaticOrder, PG8_ALIGN, PG8_SP2>(F.lds + RING_OFF, g, S, E);
        if (BOTH(5)) GRID_BAR();
    }
    if (IN(6)) { norm_phase<false>(F, F.out, MOD_SCALE_F, MOD_SHIFT_F); if (BOTH(6)) GRID_BAR(); }
    if (IN(7)) {
        pg8::Gemm g{F.H, F.W1_t, M, FF, D}; pg8::StaticOrder S; S.init(M, FF, F.G, (int)blockIdx.x);
        pg8::EpiBf16<2> E{F.U, FF};
        pg8::gemm_phase<pg8::EpiBf16<2>, pg8::StaticOrder, PG8_ALIGN, PG8_SP2>(F.lds + RING_OFF, g, S, E);
        if (BOTH(7)) GRID_BAR();
    }
    if (IN(8)) {
        pg8::Gemm g{F.U, F.W2_t, M, D, FF}; pg8::StaticOrder S; S.init(M, D, F.G, (int)blockIdx.x);
        pg8::EpiResGate E{F.out, F.out, D, F.mod + MOD_GATE_F, NMOD, SEQ / 256};
        pg8::gemm_phase<pg8::EpiResGate, pg8::StaticOrder, PG8_ALIGN, PG8_SP2>(F.lds + RING_OFF, g, S, E);
    }
#undef IN
#undef BOTH
}

extern "C" void kernel_launch(void* const* d_in, const int* in_sizes, int n_in, void* d_out, int out_size, void* d_ws, size_t ws_size, hipStream_t stream) {
    static int grid = 0;
    if (grid == 0) {
        if (n_in != 13 || in_sizes[0] != M * D || out_size != M * D || ws_size < WS_END) { fprintf(stderr, "kernel_launch: unexpected shapes/workspace (n_in %d, in0 %d, out %d, ws %zu); nothing launched\n", n_in, n_in > 0 ? in_sizes[0] : -1, out_size, ws_size); grid = -1; return; }
        int dev = 0, cus = 0, per_cu = 0;
        if (hipGetDevice(&dev) != hipSuccess || hipDeviceGetAttribute(&cus, hipDeviceAttributeMultiprocessorCount, dev) != hipSuccess) { fprintf(stderr, "kernel_launch: device query failed\n"); grid = -1; return; }
        if (hipFuncSetAttribute((const void*)skel_fwd, hipFuncAttributeMaxDynamicSharedMemorySize, LDS_BYTES) != hipSuccess) { fprintf(stderr, "kernel_launch: hipFuncSetAttribute failed\n"); grid = -1; return; }
        if (hipOccupancyMaxActiveBlocksPerMultiprocessor(&per_cu, (const void*)skel_fwd, NWAVES * 64, LDS_BYTES) != hipSuccess || per_cu < 1) { fprintf(stderr, "kernel_launch: occupancy query reports %d workgroups per CU; nothing launched\n", per_cu); (void)hipGetLastError(); grid = -1; return; }
        grid = cus;
    }
    if (grid < 0) return;
    if (hipMemsetAsync((char*)d_ws + WS_CTL, 0, CTL_ZERO_BYTES, stream) != hipSuccess) { fprintf(stderr, "kernel_launch: hipMemsetAsync failed\n"); return; }
    Args a{};
    for (int i = 0; i < 13; ++i) a.in[i] = (const float*)d_in[i];
    a.out = (float*)d_out; a.ws = (unsigned char*)d_ws;
    for (int li = 0; li < N_LAUNCHES; ++li) {
        a.ph_lo = (N_LAUNCHES == PER_PHASE) ? li : 0; a.ph_hi = (N_LAUNCHES == PER_PHASE) ? li + 1 : PER_PHASE; a.li = li;
        hipLaunchKernelGGL(skel_fwd, dim3(grid), dim3(NWAVES * 64), LDS_BYTES, stream, a);
        const hipError_t le = hipPeekAtLastError();
        if (le != hipSuccess) { fprintf(stderr, "kernel_launch: launch %d failed: %s\n", li, hipGetErrorName(le)); break; }
    }
}
```

```cpp
#include <hip/hip_runtime.h>
#include <cstdio>
#include <cstdint>
#include <cmath>
namespace pg8 {
#define PG8_LAS __attribute__((address_space(3)))
typedef unsigned short bf16_t;
typedef short bf16x8 __attribute__((ext_vector_type(8)));
typedef float f32x4 __attribute__((ext_vector_type(4)));
typedef unsigned u32x4 __attribute__((ext_vector_type(4)));
constexpr int BM = 256, BK = 64, HALF = 128, HTB = HALF * BK * 2  , STAGE_BYTES = 8 * HTB, NXCD = 8, WGM = 8;

__host__ __device__ __forceinline__ int lds_byte(int r, int c) { const int st = (r >> 4) * 2 + (c >> 5), rr = r & 15, cc = c & 31, ob = rr * 64 + cc * 2; return st * 1024 + (ob ^ (((ob >> 9) & 1) << 5)); }
__host__ __device__ __forceinline__ void stage_rc(int b, int& R, int& C) { const int st = b / 1024, sb = b % 1024, swz = sb ^ (((sb >> 9) & 1) << 5); R = (st >> 1) * 16 + swz / 64; C = (st & 1) * 32 + (swz % 64) / 2; }
__host__ __device__ __forceinline__ int perm32(int rho) { const int n = rho >> 4, i = rho & 15; return 8 * (i >> 2) + 4 * n + (i & 3); }

struct Unit { int pm, pn; };
struct Gemm { const bf16_t* A; const bf16_t* Bt; int M, N, K; };

struct StaticOrder {
    int nM, nN, nwg, G, c;
    __host__ __device__ void init(int M, int N, int G_, int c_) { nM = M / BM; nN = N / BM; nwg = nM * nN; G = G_; c = c_; }
    __host__ __device__ bool next(int i, Unit& u) const {
        const long L = (long)i * G + c; if (L >= nwg) return false;
        int wgid = (int)L; { const int q = nwg / NXCD, r = nwg % NXCD, xcd = wgid % NXCD, off = wgid / NXCD; wgid = (xcd < r ? xcd * (q + 1) : r * (q + 1) + (xcd - r) * q) + off; }
        const int nig = WGM * nN, gid = wgid / nig, fm = gid * WGM, gsz = (nM - fm) < WGM ? (nM - fm) : WGM;
        u.pm = fm + ((wgid % nig) % gsz); u.pn = (wgid % nig) / gsz; return true;
    }
    __device__ __forceinline__ void a_ready(const Unit&) const {}
    __device__ __forceinline__ void done(const Unit&) const {}
};

__device__ __forceinline__ unsigned cvt_pk_bf16(float lo, float hi) { unsigned r; asm volatile("v_cvt_pk_bf16_f32 %0, %1, %2" : "=v"(r) : "v"(lo), "v"(hi)); return r; }

template <int ACT> struct EpiBf16 {
    static constexpr bool PERM = true, AFTER_DRAIN = false;
    bf16_t* O; int ldc;
    __device__ __forceinline__ void operator()(const f32x4 (&acc)[2][2][4][2], const Unit& u, int wr, int wc, int fr, int fq) const {
        const int row0 = u.pm * BM + wr * 64 + fr; const int col0 = u.pn * BM + wc * 32 + 8 * fq;
#pragma unroll
        for (int ai = 0; ai < 2; ++ai)
#pragma unroll
            for (int m = 0; m < 4; ++m) { bf16_t* rowp = O + (size_t)(row0 + ai * HALF + m * 16) * ldc + col0;
#pragma unroll
                for (int bj = 0; bj < 2; ++bj) { f32x4 v0 = acc[ai][bj][m][0], v1 = acc[ai][bj][m][1];
                    if (ACT == 2) {
#pragma unroll
                        for (int e = 0; e < 4; ++e) { const float a = fmaxf(v0[e], 0.f), b = fmaxf(v1[e], 0.f); v0[e] = a * a; v1[e] = b * b; } }
                    u32x4 w; w.x = cvt_pk_bf16(v0[0], v0[1]); w.y = cvt_pk_bf16(v0[2], v0[3]); w.z = cvt_pk_bf16(v1[0], v1[1]); w.w = cvt_pk_bf16(v1[2], v1[3]);
                    *(u32x4*)(rowp + bj * HALF) = w; } }
    }
};

struct EpiResGate {
    static constexpr bool PERM = false, AFTER_DRAIN = false;
    const float* base; float* out; int ldc; const float* gate; int gate_stride; int tiles_per_batch;
    __device__ __forceinline__ void operator()(const f32x4 (&acc)[2][2][4][2], const Unit& u, int wr, int wc, int fr, int fq) const {
        const int col0 = u.pn * BM + wc * 32 + 4 * fq;
        const float* g = gate + (size_t)(u.pm / tiles_per_batch) * gate_stride + col0;
        f32x4 gv[2][2];
#pragma unroll
        for (int bj = 0; bj < 2; ++bj)
#pragma unroll
            for (int n = 0; n < 2; ++n) gv[bj][n] = *(const f32x4*)(g + bj * HALF + n * 16);
#pragma unroll
        for (int ai = 0; ai < 2; ++ai)
#pragma unroll
            for (int m = 0; m < 4; ++m) { const size_t off = (size_t)(u.pm * BM + ai * HALF + wr * 64 + m * 16 + fr) * ldc + col0;
#pragma unroll
                for (int bj = 0; bj < 2; ++bj)
#pragma unroll
                    for (int n = 0; n < 2; ++n) { const f32x4 bs = *(const f32x4*)(base + off + bj * HALF + n * 16); const f32x4 o = bs + gv[bj][n] * acc[ai][bj][m][n];
                        *(f32x4*)(out + off + bj * HALF + n * 16) = o; }
                if (m & 1) asm volatile("" ::: "memory"); }
    }
};
template <class Epi, class Sched, bool ALIGN_EPI = false, bool SP2 = false>
__device__ __forceinline__ void gemm_phase(PG8_LAS unsigned char* lds, const Gemm g, const Sched& S, const Epi& E) {
    const int tid = threadIdx.x, wid = __builtin_amdgcn_readfirstlane(tid >> 6), lane = tid & 63, wr = wid >> 2, wc = wid & 3, fr = lane & 15, fq = lane >> 4;
    const int K = g.K, nt = K / BK;
    unsigned voffA[2], voffB[2];
#pragma unroll
    for (int i = 0; i < 2; ++i) { int R, C; stage_rc(tid * 16 + i * 8192, R, C); const int Rb = Epi::PERM ? ((R & ~31) + perm32(R & 31)) : R;
        voffA[i] = (unsigned)(R * K + C) * 2u; voffB[i] = (unsigned)(Rb * K + C) * 2u; }
    const size_t kstep = (size_t)(BK * 2);
    const size_t hstep = (size_t)HALF * K * 2;
    const size_t tstep = 2 * hstep;
    const unsigned ldsw = (unsigned)wid * 1024u;
    const int aoff = lds_byte(wr * 64 + fr, fq * 8), boff = lds_byte(wc * 32 + fr, fq * 8);
#define PG8_SA(b, h) (((b) * 2 + (h)) * HTB)
#define PG8_SB(b, h) ((4 + (b) * 2 + (h)) * HTB)
#define PG8_STAGE(bufoff, gbase, voff) do { _Pragma("unroll") for (int _i = 0; _i < 2; ++_i) \
        __builtin_amdgcn_global_load_lds((const unsigned*)((const char*)(gbase) + (voff)[_i]), (PG8_LAS unsigned*)(lds + (bufoff) + ldsw + _i * 8192), 16, 0, 0); } while (0)
#define PG8_LDA(dst, b, h) do { _Pragma("unroll") for (int m = 0; m < 4; ++m) _Pragma("unroll") for (int k = 0; k < 2; ++k) dst[m][k] = *(const PG8_LAS bf16x8*)(lds + PG8_SA(b, h) + aoff + m * 2048 + k * 1024); } while (0)
#define PG8_LDB(dst, b, h) do { _Pragma("unroll") for (int n = 0; n < 2; ++n) _Pragma("unroll") for (int k = 0; k < 2; ++k) dst[n][k] = *(const PG8_LAS bf16x8*)(lds + PG8_SB(b, h) + boff + n * 2048 + k * 1024); } while (0)
#define PG8_MMA(ai, bj, At, Bt) do { __builtin_amdgcn_s_setprio(1); _Pragma("unroll") for (int m = 0; m < 4; ++m) _Pragma("unroll") for (int n = 0; n < 2; ++n) _Pragma("unroll") for (int k = 0; k < 2; ++k) \
        acc[ai][bj][m][n] = __builtin_amdgcn_mfma_f32_16x16x32_bf16(Bt[n][k], At[m][k], acc[ai][bj][m][n], 0, 0, 0); __builtin_amdgcn_s_setprio(0); } while (0)
#define PG8_WAIT_V(n) asm volatile("s_waitcnt vmcnt(" #n ")" ::: "memory")
#define PG8_WAIT_L(n) asm volatile("s_waitcnt lgkmcnt(" #n ")" ::: "memory")
#define PG8_BAR __builtin_amdgcn_s_barrier()
#define PG8_SCHED __builtin_amdgcn_sched_barrier(0)
    Unit cur, nxt; int ui = 0;
    if (!S.next(0, cur)) return;
    f32x4 acc[2][2][4][2];
#pragma unroll
    for (int a = 0; a < 2; ++a)
#pragma unroll
        for (int b = 0; b < 2; ++b)
#pragma unroll
            for (int m = 0; m < 4; ++m)
#pragma unroll
                for (int n = 0; n < 2; ++n) acc[a][b][m][n] = (f32x4){0.f, 0.f, 0.f, 0.f};
    bf16x8 At[4][2], B0[2][2], B1[2][2];
    const char* cA = (const char*)g.A + (size_t)cur.pm * tstep; const char* cB = (const char*)g.Bt + (size_t)cur.pn * tstep;
    S.a_ready(cur);
    if constexpr (SP2) {
        PG8_STAGE(PG8_SB(0, 0), cB, voffB); PG8_STAGE(PG8_SB(0, 1), cB + hstep, voffB); PG8_STAGE(PG8_SA(0, 0), cA, voffA); PG8_STAGE(PG8_SA(0, 1), cA + hstep, voffA);
        if (wr == 1) PG8_BAR;
        PG8_WAIT_V(2); PG8_BAR;
        PG8_STAGE(PG8_SB(1, 0), cB + kstep, voffB); PG8_STAGE(PG8_SA(1, 0), cA + kstep, voffA); PG8_STAGE(PG8_SB(1, 1), cB + hstep + kstep, voffB);
        PG8_WAIT_V(6); PG8_BAR;
    } else {
        PG8_STAGE(PG8_SB(0, 0), cB, voffB); PG8_STAGE(PG8_SA(0, 0), cA, voffA); PG8_STAGE(PG8_SB(0, 1), cB + hstep, voffB); PG8_STAGE(PG8_SA(0, 1), cA + hstep, voffA);
        if (wr == 1) PG8_BAR;
        PG8_WAIT_V(4); PG8_BAR;
        PG8_STAGE(PG8_SB(1, 0), cB + kstep, voffB); PG8_STAGE(PG8_SA(1, 0), cA + kstep, voffA); PG8_STAGE(PG8_SB(1, 1), cB + hstep + kstep, voffB);
        PG8_WAIT_V(6); PG8_BAR;
    }
    for (;;) {
        const bool has_next = S.next(ui + 1, nxt);
        const char* nA = has_next ? (const char*)g.A + (size_t)nxt.pm * tstep : cA; const char* nB = has_next ? (const char*)g.Bt + (size_t)nxt.pn * tstep : cB;
        for (int t = 0; t < nt; t += 2) {
            const bool last = (t == nt - 2);
            const char* a1 = cA + (size_t)(t + 1) * kstep;
            const char* a2 = last ? nA : cA + (size_t)(t + 2) * kstep; const char* b2 = last ? nB : cB + (size_t)(t + 2) * kstep;
            const char* a3 = a2 + kstep; const char* b3 = b2 + kstep;
            if (last && has_next) S.a_ready(nxt);
            if constexpr (SP2) {
            PG8_LDB(B0, 0, 0); PG8_LDB(B1, 0, 1); PG8_SCHED; PG8_LDA(At, 0, 0); PG8_STAGE(PG8_SA(1, 1), a1 + hstep, voffA);
            PG8_WAIT_V(8); PG8_WAIT_L(0); PG8_BAR; PG8_MMA(0, 0, At, B0); PG8_MMA(0, 1, At, B1); PG8_BAR; PG8_SCHED;
            PG8_LDA(At, 0, 1); PG8_STAGE(PG8_SB(0, 0), b2, voffB); PG8_STAGE(PG8_SB(0, 1), b2 + hstep, voffB); PG8_STAGE(PG8_SA(0, 0), a2, voffA);
            PG8_WAIT_V(8); PG8_WAIT_L(0); PG8_BAR; PG8_MMA(1, 0, At, B0); PG8_MMA(1, 1, At, B1); PG8_BAR; PG8_SCHED;
            PG8_LDB(B0, 1, 0); PG8_LDB(B1, 1, 1); PG8_SCHED; PG8_LDA(At, 1, 0); PG8_STAGE(PG8_SA(0, 1), a2 + hstep, voffA);
            PG8_WAIT_V(8); PG8_WAIT_L(0); PG8_BAR; PG8_MMA(0, 0, At, B0); PG8_MMA(0, 1, At, B1); PG8_BAR; PG8_SCHED;
            PG8_LDA(At, 1, 1); PG8_STAGE(PG8_SB(1, 0), b3, voffB); PG8_STAGE(PG8_SB(1, 1), b3 + hstep, voffB); PG8_STAGE(PG8_SA(1, 0), a3, voffA);
            PG8_WAIT_V(8); PG8_WAIT_L(0); PG8_BAR; PG8_MMA(1, 0, At, B0); PG8_MMA(1, 1, At, B1); PG8_BAR; PG8_SCHED;
            } else {
            PG8_LDB(B0, 0, 0); PG8_SCHED; PG8_LDA(At, 0, 0); PG8_STAGE(PG8_SA(1, 1), a1 + hstep, voffA);
            PG8_WAIT_L(8); PG8_BAR; PG8_WAIT_L(0); PG8_MMA(0, 0, At, B0); PG8_BAR; PG8_SCHED;
            PG8_LDB(B1, 0, 1); PG8_STAGE(PG8_SB(0, 0), b2, voffB);
            PG8_BAR; PG8_WAIT_L(0); PG8_MMA(0, 1, At, B1); PG8_BAR;
            PG8_LDA(At, 0, 1); PG8_STAGE(PG8_SA(0, 0), a2, voffA);
            PG8_BAR; PG8_WAIT_L(0); PG8_MMA(1, 0, At, B0); PG8_BAR; PG8_SCHED;
            PG8_STAGE(PG8_SB(0, 1), b2 + hstep, voffB);
            PG8_WAIT_V(6); PG8_BAR; PG8_MMA(1, 1, At, B1); PG8_BAR;
            PG8_LDB(B0, 1, 0); PG8_SCHED; PG8_LDA(At, 1, 0); PG8_STAGE(PG8_SA(0, 1), a2 + hstep, voffA);
            PG8_WAIT_L(8); PG8_BAR; PG8_WAIT_L(0); PG8_MMA(0, 0, At, B0); PG8_BAR; PG8_SCHED;
            PG8_LDB(B1, 1, 1); PG8_STAGE(PG8_SB(1, 0), b3, voffB);
            PG8_BAR; PG8_WAIT_L(0); PG8_MMA(0, 1, At, B1); PG8_BAR;
            PG8_LDA(At, 1, 1); PG8_STAGE(PG8_SA(1, 0), a3, voffA);
            PG8_BAR; PG8_WAIT_L(0); PG8_MMA(1, 0, At, B0); PG8_BAR; PG8_SCHED;
            PG8_STAGE(PG8_SB(1, 1), b3 + hstep, voffB);
            PG8_WAIT_V(6); PG8_BAR; PG8_MMA(1, 1, At, B1); PG8_BAR;
            }
        }
        if constexpr (ALIGN_EPI) { if (wr == 0) PG8_BAR; }
        if constexpr (!Epi::AFTER_DRAIN) { E(acc, cur, wr, wc, fr, fq); S.done(cur); }
        if (!has_next) break;
#pragma unroll
        for (int a = 0; a < 2; ++a)
#pragma unroll
            for (int b = 0; b < 2; ++b)
#pragma unroll
                for (int m = 0; m < 4; ++m)
#pragma unroll
                    for (int n = 0; n < 2; ++n) acc[a][b][m][n] = (f32x4){0.f, 0.f, 0.f, 0.f};
        cur = nxt; cA = nA; cB = nB; ++ui;
        if constexpr (ALIGN_EPI) { if (wr == 1) PG8_BAR; }
    }
    PG8_WAIT_V(0);
    if constexpr (!ALIGN_EPI) { if (wr == 0) PG8_BAR; }
    PG8_BAR;
    if constexpr (Epi::AFTER_DRAIN) { E.fused(acc, cur, wr, wc, fr, fq, lds, wid, lane); S.done(cur); }
#undef PG8_SA
#undef PG8_SB
#undef PG8_STAGE
#undef PG8_LDA
#undef PG8_LDB
#undef PG8_MMA
#undef PG8_WAIT_V
#undef PG8_WAIT_L
#undef PG8_BAR
#undef PG8_SCHED
}
}
#ifndef PG8_SP2
#define PG8_SP2 true
#endif
#ifndef PG8_ALIGN
#define PG8_ALIGN true
#endif
#include <hip/hip_bf16.h>
#include <cmath>
namespace attn_body {
using bf16=__hip_bfloat16;
using bf16x8=__attribute__((ext_vector_type(8)))short;
using s16x4=__attribute__((ext_vector_type(4)))short;
using f32x16=__attribute__((ext_vector_type(16)))float;
using u32x4=__attribute__((ext_vector_type(4)))unsigned;
using f32x4=__attribute__((ext_vector_type(4)))float;
constexpr int BATCH=32,NHEAD=8,SEQ=2048,D=64,DM=4096,ODM=1024;
constexpr int NW=8,QBLK=32,QB=QBLK*NW,KVBLK=64,NQB=SEQ/QB;
constexpr int ATTN_UNIT_ROWS=QB;
__device__ __forceinline__ int crow(int r,int hi){return (r&3)+8*(r>>2)+4*hi;}
#define SBAR() __builtin_amdgcn_sched_barrier(0)
__device__ __forceinline__ void cmask(f32x16&p0,f32x16&p1,int jb,int qrel,int hi){
  const float NEG=-INFINITY; int kb=64*jb+4*hi;
  #pragma unroll
  for(int r=0;r<16;++r){int kv=kb+(r&3)+8*(r>>2); if(kv>qrel)p0[r]=NEG; if(kv+32>qrel)p1[r]=NEG;}
}

constexpr int NSLOT=3, SLOTB=8192;
constexpr int LDS_K=0, LDS_V=NSLOT*SLOTB, LDS_WS=2*NSLOT*SLOTB, LDS_OST=LDS_WS+NW*64*4, LDS_CK=LDS_OST+NW*8192, LDS_BYTES=LDS_CK+SEQ*4;
constexpr float C2=0.125f*1.4426950408889634f;
__device__ __forceinline__ void glds16(const void*gsrc,unsigned lds_dst){unsigned keep;
  asm volatile("s_mov_b32 %0, m0\n\ts_mov_b32 m0, %2\n\ts_nop 0\n\tglobal_load_lds_dwordx4 %1, off\n\ts_mov_b32 m0, %0":"=&s"(keep):"v"(gsrc),"s"(lds_dst):"memory");}
__device__ __forceinline__ float max3f(float a,float b,float c){float r;asm("v_max3_f32 %0, %1, %2, %3":"=v"(r):"v"(a),"v"(b),"v"(c));return r;}
__device__ __forceinline__ float max2f(float a,float b){float r;asm("v_max_f32_e32 %0, %1, %2":"=v"(r):"v"(a),"v"(b));return r;}
__device__ __forceinline__ float fadd_s(float a,float b){float r;asm("v_add_f32_e32 %0, %1, %2":"=v"(r):"v"(a),"v"(b));return r;}
__device__ __forceinline__ float fsub_s(float a,float b){float r;asm("v_sub_f32_e32 %0, %1, %2":"=v"(r):"v"(a),"v"(b));return r;}
typedef float f32x2_t __attribute__((ext_vector_type(2))); typedef __bf16 bf16x2_t __attribute__((ext_vector_type(2)));
__device__ __forceinline__ unsigned cvtpk_s(float lo,float hi){f32x2_t v={lo,hi};bf16x2_t b=__builtin_convertvector(v,bf16x2_t);return __builtin_bit_cast(unsigned,b);}
#define WAIT_BAR(N) asm volatile("s_waitcnt vmcnt(" #N ") lgkmcnt(0)\n\ts_barrier":::"memory")

__device__ __forceinline__ void qkt(f32x16&p0,f32x16&p1,const char*Kslot,const bf16x8*qr,int r32,int hi){
  const char*kb=Kslot+hi*1024+r32*16;
  #pragma unroll
  for(int d0=0;d0<4;++d0){
    const bf16x8 b0=*reinterpret_cast<const bf16x8*>(kb+d0*2048);
    const bf16x8 b1=*reinterpret_cast<const bf16x8*>(kb+d0*2048+512);
    p0=__builtin_amdgcn_mfma_f32_32x32x16_bf16(b0,qr[d0],p0,0,0,0);p1=__builtin_amdgcn_mfma_f32_32x32x16_bf16(b1,qr[d0],p1,0,0,0);}
}
typedef __attribute__((address_space(3))) const char* lds_cptr;
typedef __attribute__((address_space(3))) char* lds_wptr;
typedef __attribute__((address_space(3))) const f32x4* lds_f4c;
typedef __attribute__((address_space(3))) f32x4* lds_f4w;
typedef __attribute__((address_space(3))) float* lds_fw;
typedef short v4i16_t __attribute__((ext_vector_type(4)));
__device__ __forceinline__ void kload8(bf16x8*kf,lds_cptr kp){
  kf[0]=*(const __attribute__((address_space(3))) bf16x8*)(kp);      kf[1]=*(const __attribute__((address_space(3))) bf16x8*)(kp+512);
  kf[2]=*(const __attribute__((address_space(3))) bf16x8*)(kp+2048); kf[3]=*(const __attribute__((address_space(3))) bf16x8*)(kp+2560);
  kf[4]=*(const __attribute__((address_space(3))) bf16x8*)(kp+4096); kf[5]=*(const __attribute__((address_space(3))) bf16x8*)(kp+4608);
  kf[6]=*(const __attribute__((address_space(3))) bf16x8*)(kp+6144); kf[7]=*(const __attribute__((address_space(3))) bf16x8*)(kp+6656);
}
__device__ __forceinline__ void kload2(bf16x8*kf,lds_cptr kp,int j){ kf[2*j]=*(const __attribute__((address_space(3))) bf16x8*)(kp+j*2048); kf[2*j+1]=*(const __attribute__((address_space(3))) bf16x8*)(kp+j*2048+512); }
__device__ __forceinline__ s16x4 vtr(lds_cptr p){ return __builtin_bit_cast(s16x4,__builtin_amdgcn_ds_read_tr16_b64_v4i16((__attribute__((address_space(3))) v4i16_t*)p)); }
__device__ __forceinline__ float rowmax(const f32x16&p0,const f32x16&p1){
  float a=max3f(p0[0],p0[1],p1[0]),b=max3f(p0[2],p0[3],p1[1]);a=max3f(a,p1[2],p1[3]);
  #pragma unroll
  for(int r=4;r<16;r+=4){a=max3f(a,p0[r],p0[r+1]);b=max3f(b,p0[r+2],p0[r+3]);a=max3f(a,p1[r],p1[r+1]);b=max3f(b,p1[r+2],p1[r+3]);}
  const float m=max2f(a,b);
  auto rr=__builtin_amdgcn_permlane32_swap(__float_as_uint(m),__float_as_uint(m),false,false);
  return max2f(__uint_as_float(rr[0]),__uint_as_float(rr[1]));
}
__device__ __forceinline__ void pv(f32x16*o,int vb,bf16x8 pa0,bf16x8 pa1,bf16x8 pa2,bf16x8 pa3){
  #pragma unroll
  for(int d0=0;d0<2;++d0){s16x4 lo[4],hi[4];
    #pragma unroll
    for(int ks=0;ks<4;++ks){
      asm volatile("ds_read_b64_tr_b16 %0,%1 offset:%c2":"=&v"(lo[ks]):"v"(vb),"i"(d0*4096+ks*1024):"memory");
      asm volatile("ds_read_b64_tr_b16 %0,%1 offset:%c2":"=&v"(hi[ks]):"v"(vb),"i"(d0*4096+ks*1024+512):"memory");}
    asm volatile("s_waitcnt lgkmcnt(0)":::"memory");SBAR();
    #define PK(k) (bf16x8){lo[k][0],lo[k][1],lo[k][2],lo[k][3],hi[k][0],hi[k][1],hi[k][2],hi[k][3]}
    o[d0]=__builtin_amdgcn_mfma_f32_32x32x16_bf16(pa0,PK(0),o[d0],0,0,0);
    o[d0]=__builtin_amdgcn_mfma_f32_32x32x16_bf16(pa1,PK(1),o[d0],0,0,0);
    o[d0]=__builtin_amdgcn_mfma_f32_32x32x16_bf16(pa2,PK(2),o[d0],0,0,0);
    o[d0]=__builtin_amdgcn_mfma_f32_32x32x16_bf16(pa3,PK(3),o[d0],0,0,0);
    #undef PK
  }
}

#ifndef ATTN_STORE16
#define ATTN_STORE16(p,v) (*(u32x4*)(p)=(v))
#endif
template<int THRL> __device__ __forceinline__ void attn_unit(int b,int h,int qb,const bf16*Q,const bf16*__restrict__ K,const bf16*__restrict__ V,const bf16*__restrict__ G,const float*__restrict__ cum2,const float*__restrict__ gain,bf16*O,char*shm){
  int tid_=threadIdx.x; asm volatile("":"+v"(tid_));
  const int tid=tid_,lane=tid&63,r32=lane&31,hi=lane>>5; const int wid=__builtin_amdgcn_readfirstlane(tid>>6);
  const long rowbase=(long)b*SEQ; const int q0=qb*QB;
  const bf16*Qw=Q+(rowbase+q0+wid*QBLK)*DM+h*D;
  const bf16*Kh=K+rowbase*DM+h*D,*Vh=V+rowbase*DM+h*D;
  const unsigned lds0=(unsigned)(uintptr_t)shm;
  float*wsf=(float*)(shm+LDS_WS)+wid*64;
  const bf16*ksrc=Kh+(long)lane*DM+wid*8;
  const bf16*vsrc=Vh+(long)(16*(wid&3)+(lane>>2))*DM+(wid>>2)*32+(lane&3)*8;
  const unsigned kdst=lds0+LDS_K+wid*1024, vdst=lds0+LDS_V+wid*1024;
  #define DMA_K(t,slot) glds16(ksrc+(long)(t)*KVBLK*DM,(unsigned)__builtin_amdgcn_readfirstlane(kdst+(slot)))
  #define DMA_V(t,slot) glds16(vsrc+(long)(t)*KVBLK*DM,(unsigned)__builtin_amdgcn_readfirstlane(vdst+(slot)))
  const int vb0=(int)(lds0+LDS_V)+((lane>>4)&1)*32+(lane&3)*8+(4*hi+((lane&15)>>2))*64;
  const char*Kbase=shm+LDS_K; bf16x8 kf[8];
  const lds_cptr shm3=(lds_cptr)shm; const lds_wptr shm3w=(lds_wptr)shm; const lds_f4c ckb=(lds_f4c)(shm3+LDS_CK)+hi; const lds_cptr kp0=shm3+LDS_K+hi*1024+r32*16; const lds_cptr vp0=shm3+LDS_V+((lane>>4)&1)*32+(lane&3)*8+(4*hi+((lane&15)>>2))*64;
  const int NT=(q0+QB)/KVBLK;
  DMA_K(0,0);DMA_V(0,0);DMA_K(1,SLOTB);
  { const float*cs=cum2+((long)(b*NHEAD+h))*SEQ; if(tid*4<q0+QB){ const f32x4 v_=*(const f32x4*)(cs+tid*4); *(lds_f4w)(shm3w+LDS_CK+tid*16)=(f32x4){-v_.x,-v_.y,-v_.z,-v_.w}; } }
  bf16x8 qr[4];
  #pragma unroll
  for(int d0=0;d0<4;++d0)qr[d0]=*reinterpret_cast<const bf16x8*>(&Qw[(long)r32*DM+d0*16+hi*8]);
  float mhat=0.f,l_reg=0.f;f32x16 o[2];o[0]=f32x16{};o[1]=f32x16{};
  const int qrel=wid*QBLK+r32;
  #define CMASK(P0,P1,t) do{int jb_=(t)-(NT-4); if(jb_>=0)cmask(P0,P1,jb_,qrel,hi);}while(0)
  bool resc=false;
  #define START(P0,P1) do{ const float rm=rowmax(P0,P1); resc=false; \
    { const float dl=rm; mhat=fadd_s(mhat,dl); \
      _Pragma("unroll") for(int r=0;r<16;++r){P0[r]=fsub_s(P0[r],dl);P1[r]=fsub_s(P1[r],dl);} \
      } \
    _Pragma("unroll") for(int r=0;r<16;++r)P0[r]=__builtin_amdgcn_exp2f(P0[r]); }while(0)
  #define RESC() do{ if(resc){ asm volatile("s_waitcnt lgkmcnt(0)":::"memory"); \
      _Pragma("unroll") for(int d_=0;d_<2;++d_) _Pragma("unroll") for(int r=0;r<16;++r)o[d_][r]*=wsf[crow(r,hi)]; } }while(0)
  f32x16 pA0,pA1,pB0,pB1;
  #define CINIT(C0,C1,t) do{ const lds_f4c cb_=ckb+(t)*16; _Pragma("unroll") for(int g_=0;g_<4;++g_){ const f32x4 a_=cb_[2*g_],b_=cb_[2*g_+8]; \
      C0[4*g_]=a_.x-mhat;C0[4*g_+1]=a_.y-mhat;C0[4*g_+2]=a_.z-mhat;C0[4*g_+3]=a_.w-mhat; C1[4*g_]=b_.x-mhat;C1[4*g_+1]=b_.y-mhat;C1[4*g_+2]=b_.z-mhat;C1[4*g_+3]=b_.w-mhat; } }while(0)
  int sl_prev=0,sl_cur=0,sl_next=SLOTB;
  #define ROT() do{sl_prev=sl_cur;sl_cur=sl_next;sl_next=(sl_next==(NSLOT-1)*SLOTB)?0:sl_next+SLOTB;}while(0)
  DMA_K(2,2*SLOTB);
  WAIT_BAR(3);
  CINIT(pA0,pA1,0); qkt(pA0,pA1,Kbase,qr,r32,hi);asm volatile("s_nop 15\n\ts_nop 7":"+v"(pA0),"+v"(pA1));CMASK(pA0,pA1,0);
  START(pA0,pA1);
  _Pragma("unroll") for(int r=0;r<16;++r)pA1[r]=__builtin_amdgcn_exp2f(pA1[r]);
  CINIT(pB0,pB1,1);
  WAIT_BAR(0);
  DMA_K(3,0);DMA_V(1,SLOTB);
  ROT();
  kload8(kf,kp0+sl_cur);
  WAIT_BAR(2);
  s16x4 vlo[8],vhi[8]; u32x4 pw0,pw1,pw2,pw3;
  #define PKW(P,B) cvtpk_s(P[B],P[B+1])
  #define PAF(k) __builtin_bit_cast(bf16x8,pw##k)
  #define VFR(i) (bf16x8){vlo[i][0],vlo[i][1],vlo[i][2],vlo[i][3],vhi[i][0],vhi[i][1],vhi[i][2],vhi[i][3]}
  #define PIN(x) asm volatile("":"+v"(x))
  #define MX3(a,b,c) __builtin_fmaxf(__builtin_fmaxf((a),(b)),(c))
  #define GAPA(MF,A0,A1,A2,A3,W0,W1,PW) do{ MF; sacc+=A0; sacc+=A1; sacc+=A2; sacc+=A3; PIN(sacc); W0; W1; PIN(PW); SBAR(); }while(0)
  #define EX(v) __builtin_amdgcn_exp2f(v)
  #define GAPB(MF,X,B,NP,NG,NXI) do{ MF; X[B]=EX(X[B]); X[B+1]=EX(X[B+1]); X[B+2]=EX(X[B+2]); X[B+3]=EX(X[B+3]); PIN(X); \
      NP[4*(NG)]=nx_.x-mhat; NP[4*(NG)+1]=nx_.y-mhat; NP[4*(NG)+2]=nx_.z-mhat; NP[4*(NG)+3]=nx_.w-mhat; PIN(NP); nx_=cbn_[NXI]; SBAR(); }while(0)
  #define VRD(i) do{ vlo[i]=vtr(vp_+(((i)>>2)*4096+((i)&3)*1024)); vhi[i]=vtr(vp_+(((i)>>2)*4096+((i)&3)*1024+512)); }while(0)
  #define KRD(G,j) do{ if(G){ kload2(kf,kp0+sl_next,j); SBAR(); } }while(0)
  #define STEP(C0,C1,P0,P1,t,GK,GV,GL) do{ SBAR(); const lds_f4c cbn_=ckb+((t)+1)*16; \
    const lds_cptr vp_=vp0+sl_prev; \
    VRD(0); SBAR(); float sacc=(P0[0]+P0[1]); \
    GAPA(C0=__builtin_amdgcn_mfma_f32_32x32x16_bf16(kf[0],qr[0],C0,0,0,0), P0[2],P0[3],P0[4],P0[5],     pw0[0]=PKW(P0,0), pw0[1]=PKW(P0,2), pw0); \
    VRD(4); SBAR(); GAPA(C1=__builtin_amdgcn_mfma_f32_32x32x16_bf16(kf[1],qr[0],C1,0,0,0), P0[6],P0[7],P0[8],P0[9],     pw0[2]=PKW(P0,4), pw0[3]=PKW(P0,6), pw0); \
    VRD(1); SBAR(); GAPA(C0=__builtin_amdgcn_mfma_f32_32x32x16_bf16(kf[2],qr[1],C0,0,0,0),   P0[10],P0[11],P0[12],P0[13], pw1[0]=PKW(P0,8), pw1[1]=PKW(P0,10), pw1); \
    VRD(5); SBAR(); GAPA(C1=__builtin_amdgcn_mfma_f32_32x32x16_bf16(kf[3],qr[1],C1,0,0,0),   P0[14],P0[15],P1[0],P1[1],   pw1[2]=PKW(P0,12),pw1[3]=PKW(P0,14), pw1); \
    VRD(2); SBAR(); GAPA(C0=__builtin_amdgcn_mfma_f32_32x32x16_bf16(kf[4],qr[2],C0,0,0,0),   P1[2],P1[3],P1[4],P1[5],     pw2[0]=PKW(P1,0), pw2[1]=PKW(P1,2), pw2); \
    VRD(6); SBAR(); GAPA(C1=__builtin_amdgcn_mfma_f32_32x32x16_bf16(kf[5],qr[2],C1,0,0,0),   P1[6],P1[7],P1[8],P1[9],     pw2[2]=PKW(P1,4), pw2[3]=PKW(P1,6), pw2); \
    VRD(3); SBAR(); GAPA(C0=__builtin_amdgcn_mfma_f32_32x32x16_bf16(kf[6],qr[3],C0,0,0,0),   P1[10],P1[11],P1[12],P1[13], pw3[0]=PKW(P1,8), pw3[1]=PKW(P1,10), pw3); \
    VRD(7); SBAR(); GAPA(C1=__builtin_amdgcn_mfma_f32_32x32x16_bf16(kf[7],qr[3],C1,0,0,0),   P1[14],P1[15],0.f,0.f,       pw3[2]=PKW(P1,12),pw3[3]=PKW(P1,14), pw3); \
    l_reg+=sacc; \
    if(GK){DMA_K((t)+3,sl_cur);} if(GV){DMA_V((t)+1,sl_next);} \
    CMASK(C0,C1,t); \
    { float a=MX3(C0[0],C0[1],C1[0]),b=MX3(C0[2],C0[3],C1[1]); a=MX3(a,C1[2],C1[3]); \
      _Pragma("unroll") for(int r=4;r<16;r+=4){a=MX3(a,C0[r],C0[r+1]);b=MX3(b,C0[r+2],C0[r+3]);a=MX3(a,C1[r],C1[r+1]);b=MX3(b,C1[r+2],C1[r+3]);} \
      float rm=__builtin_fmaxf(a,b); { auto rr=__builtin_amdgcn_permlane32_swap(__float_as_uint(rm),__float_as_uint(rm),false,false); rm=__builtin_fmaxf(__uint_as_float(rr[0]),__uint_as_float(rr[1])); } \
      resc=false; \
      if(__builtin_expect(__any(rm>(float)THRL),1)){ const float dl=__builtin_fmaxf(rm,0.f); mhat+=dl; \
        _Pragma("unroll") for(int r=0;r<16;++r){C0[r]-=dl;C1[r]-=dl;} \
        const float f=__builtin_amdgcn_exp2f(-dl); l_reg*=f; if(hi==0)wsf[r32]=f; resc=true; } } \
    f32x4 nx_=cbn_[0]; SBAR(); \
    GAPB(o[0]=__builtin_amdgcn_mfma_f32_32x32x16_bf16(PAF(0),VFR(0),o[0],0,0,0), C0,0, P0,0,2); \
    GAPB(o[1]=__builtin_amdgcn_mfma_f32_32x32x16_bf16(PAF(0),VFR(4),o[1],0,0,0), C0,4, P0,1,4); \
    KRD(GL,0); GAPB(o[0]=__builtin_amdgcn_mfma_f32_32x32x16_bf16(PAF(1),VFR(1),o[0],0,0,0), C0,8, P0,2,6); \
    KRD(GL,1); GAPB(o[1]=__builtin_amdgcn_mfma_f32_32x32x16_bf16(PAF(1),VFR(5),o[1],0,0,0), C0,12, P0,3,8); \
    KRD(GL,2); GAPB(o[0]=__builtin_amdgcn_mfma_f32_32x32x16_bf16(PAF(2),VFR(2),o[0],0,0,0), C1,0, P1,0,10); \
    KRD(GL,3); GAPB(o[1]=__builtin_amdgcn_mfma_f32_32x32x16_bf16(PAF(2),VFR(6),o[1],0,0,0), C1,4, P1,1,12); \
    GAPB(o[0]=__builtin_amdgcn_mfma_f32_32x32x16_bf16(PAF(3),VFR(3),o[0],0,0,0), C1,8, P1,2,14); \
    GAPB(o[1]=__builtin_amdgcn_mfma_f32_32x32x16_bf16(PAF(3),VFR(7),o[1],0,0,0), C1,12, P1,3,14); \
    }while(0)
  int t=1;
  #undef CMASK
  #define CMASK(P0,P1,t) do{}while(0)
  for(;t+5<NT;t+=2){
    STEP(pB0,pB1,pA0,pA1,t,true,true,true);     WAIT_BAR(2); RESC(); ROT();
    STEP(pA0,pA1,pB0,pB1,t+1,true,true,true);   WAIT_BAR(2); RESC(); ROT();
  }
  #undef CMASK
  #define CMASK(P0,P1,t) do{int jb_=(t)-(NT-4); if(jb_>=0)cmask(P0,P1,jb_,qrel,hi);}while(0)
  #define ENDW(tt) do{ if((tt)+3<NT){WAIT_BAR(2);} else if((tt)+2<NT){WAIT_BAR(1);} else {WAIT_BAR(0);} }while(0)
  for(;t+1<NT;t+=2){
    STEP(pB0,pB1,pA0,pA1,t,(t+3<NT),(t+1<NT),(t+1<NT));       ENDW(t);   RESC(); ROT();
    STEP(pA0,pA1,pB0,pB1,t+1,(t+4<NT),(t+2<NT),(t+2<NT));     ENDW(t+1); RESC(); ROT();
  }
  STEP(pB0,pB1,pA0,pA1,NT-1,false,false,false); RESC();
  { float sacc=pB0[0]+pB0[1]; _Pragma("unroll") for(int r=2;r<16;++r)sacc+=pB0[r]; _Pragma("unroll") for(int r=0;r<16;++r)sacc+=pB1[r]; l_reg+=sacc;
    pw0=(u32x4){PKW(pB0,0),PKW(pB0,2),PKW(pB0,4),PKW(pB0,6)};pw1=(u32x4){PKW(pB0,8),PKW(pB0,10),PKW(pB0,12),PKW(pB0,14)};pw2=(u32x4){PKW(pB1,0),PKW(pB1,2),PKW(pB1,4),PKW(pB1,6)};pw3=(u32x4){PKW(pB1,8),PKW(pB1,10),PKW(pB1,12),PKW(pB1,14)};
    SBAR(); pv(o,vb0+sl_cur,PAF(0),PAF(1),PAF(2),PAF(3)); }
  #undef PKW
  #undef PAF
  #undef VFR
  #undef PIN
  #undef MX3
  #undef GAPA
  #undef GAPB
  #undef EX
  #undef VRD
  #undef KRD
  #undef STEP
  #undef ENDW
  {auto rr=__builtin_amdgcn_permlane32_swap(__float_as_uint(l_reg),__float_as_uint(l_reg),false,false);l_reg=__uint_as_float(rr[0])+__uint_as_float(rr[1]);}
  if(hi==0)wsf[32+r32]=l_reg;asm volatile("s_waitcnt lgkmcnt(0)":::"memory");
  float rli[16];
  #pragma unroll
  for(int r=0;r<16;++r)rli[r]=__builtin_amdgcn_rcpf(wsf[32+crow(r,hi)]);
  bf16*Ow=O+(rowbase+q0+wid*QBLK)*ODM+h*D; const bf16*Gw=G+(rowbase+q0+wid*QBLK)*DM+h*D;
  { const lds_fw stg=(lds_fw)(shm3w+LDS_OST)+wid*2048;
    #pragma unroll
    for(int r=0;r<16;++r){const int orow=crow(r,hi);
      #pragma unroll
      for(int d0=0;d0<2;++d0)stg[orow*64+d0*32+r32]=o[d0][r]*rli[r];}
    asm volatile("s_waitcnt lgkmcnt(0)":::"memory");
    int le=lane; asm volatile("":"+v"(le));
    const int ch=le&7; const f32x4 g0=*(const f32x4*)(gain+h*D+ch*8), g1=*(const f32x4*)(gain+h*D+ch*8+4);
    #pragma unroll
    for(int i=0;i<4;++i){const int row=i*8+(le>>3);
      const f32x4 a=*(lds_f4c)(stg+row*64+ch*8), c=*(lds_f4c)(stg+row*64+ch*8+4);
      const u32x4 gw=*(const u32x4*)(Gw+(long)row*DM+ch*8);
      float ss=(a.x*a.x+a.y*a.y)+(a.z*a.z+a.w*a.w)+(c.x*c.x+c.y*c.y)+(c.z*c.z+c.w*c.w);
      ss+=__shfl_xor(ss,1);ss+=__shfl_xor(ss,2);ss+=__shfl_xor(ss,4);
      const float rstd=__builtin_amdgcn_rsqf(ss*(1.f/64.f)+1e-6f);
      float gt[8];
      #pragma unroll
      for(int e=0;e<4;++e){ const unsigned w=gw[e]; const float lo=__uint_as_float(w<<16), hi_=__uint_as_float(w&0xffff0000u);
        gt[2*e]=__builtin_amdgcn_rcpf(1.f+__builtin_amdgcn_exp2f(-1.4426950408889634f*lo)); gt[2*e+1]=__builtin_amdgcn_rcpf(1.f+__builtin_amdgcn_exp2f(-1.4426950408889634f*hi_)); }
      u32x4 v; v.x=cvtpk_s(a.x*rstd*g0.x*gt[0],a.y*rstd*g0.y*gt[1]); v.y=cvtpk_s(a.z*rstd*g0.z*gt[2],a.w*rstd*g0.w*gt[3]);
      v.z=cvtpk_s(c.x*rstd*g1.x*gt[4],c.y*rstd*g1.y*gt[5]); v.w=cvtpk_s(c.z*rstd*g1.z*gt[6],c.w*rstd*g1.w*gt[7]);
      ATTN_STORE16(Ow+(long)row*ODM+ch*8,v);} }
  asm volatile("s_waitcnt lgkmcnt(0)\n\ts_barrier":::"memory");
  #undef DMA_K
  #undef DMA_V
  #undef CMASK
  #undef START
  #undef CINIT
  #undef RESC
  #undef ROT
}
constexpr int ATTN_LDS_BYTES=LDS_BYTES;
#undef SBAR
#undef WAIT_BAR
}

constexpr int NWAVES = 8;
#ifndef MK_N_LAUNCHES
#define MK_N_LAUNCHES 1
#endif
constexpr int PER_PHASE = 9;
constexpr int N_LAUNCHES = MK_N_LAUNCHES;

constexpr int BATCH = 32, SEQ = 2048, D = 1024, M = BATCH * SEQ, FF = 4096, NPROJ = 4096, IN_COLS = 4104, NMOD = 6 * D;
constexpr float EPS = 1e-6f;
constexpr float LOG2E = 1.4426950408889634f, C2 = 0.18033688011112042f;
constexpr int C_FQ = 0, C_FK = 512, C_FV = 1024, C_FOG = 1536, C_RQ = 2048, C_RK = 2560, C_RV = 3072, C_RG = 3584;
constexpr int MOD_SHIFT_M = 0, MOD_SCALE_M = 1024, MOD_GATE_M = 2048, MOD_SHIFT_F = 3072, MOD_SCALE_F = 4096, MOD_GATE_F = 5120;

constexpr size_t MiB = 1u << 20;
constexpr size_t WS_CTL = 0, CTL_ZERO_BYTES = 2 * MiB;
constexpr size_t WS_MOD = 1 * MiB;
constexpr size_t WS_WIN = 2 * MiB, WS_WOUT = 10 * MiB, WS_W1 = 12 * MiB, WS_W2 = 20 * MiB;
constexpr size_t WS_WF = 28 * MiB;
constexpr size_t WS_ROPE = 29 * MiB;
constexpr size_t WS_LOGF = 30 * MiB, WS_CUM = 32 * MiB;
constexpr size_t WS_H = 64 * MiB, WS_MIX = 192 * MiB, WS_PROJ = 320 * MiB, WS_U = 320 * MiB, WS_END = 832 * MiB;
constexpr int CW_BAR = 4096;

constexpr int RING_OFF = 0, RING_BYTES = 131072;
constexpr int LDSCTL_OFF = RING_BYTES, MISC_OFF = LDSCTL_OFF + 320;
constexpr int LDS_BYTES = 147456;
#define GAS __attribute__((address_space(1)))
#define LAS __attribute__((address_space(3)))
typedef unsigned short bf16;
typedef unsigned v4u __attribute__((ext_vector_type(4)));
typedef float f32x4 __attribute__((ext_vector_type(4)));
typedef short bf16x8 __attribute__((ext_vector_type(8)));
typedef GAS unsigned gu32;
typedef GAS unsigned long long gu64;
#define RLX_AGENT __ATOMIC_RELAXED, __HIP_MEMORY_SCOPE_AGENT
#define LDS_WAIT() asm volatile("s_waitcnt lgkmcnt(0)" ::: "memory")
#define VM_WAIT() asm volatile("s_waitcnt vmcnt(0)" ::: "memory")
__device__ __forceinline__ unsigned long long rt() { return __builtin_amdgcn_s_memrealtime(); }
__device__ __forceinline__ unsigned f2bf(float f) { unsigned u = __builtin_bit_cast(unsigned, f); return (u + 0x7fffu + ((u >> 16) & 1u)) >> 16; }
__device__ __forceinline__ unsigned pk2(float lo, float hi) { return f2bf(lo) | (f2bf(hi) << 16); }

#define XB_TMO      128
#define XB_XCNT(j)  (256  + 64 * (j))
#define XB_XSUB(j)  (1280 + 64 * (j))
#define XB_XGEN(j)  (2304 + 64 * (j))
#define XB_TOP      3328
#define XB_TOPGEN   3392
#define XCD_BAR_WORDS 3456
#define XB_SPIN_CAP (1u << 18)

__device__ __forceinline__ unsigned xb_ld(unsigned* p)              { return __hip_atomic_load(p, __ATOMIC_RELAXED, __HIP_MEMORY_SCOPE_AGENT); }
__device__ __forceinline__ unsigned xb_add(unsigned* p, unsigned v) { return __hip_atomic_fetch_add(p, v, __ATOMIC_RELAXED, __HIP_MEMORY_SCOPE_AGENT); }
__device__ __forceinline__ unsigned xb_xcc_id() { return (unsigned)__builtin_amdgcn_s_getreg((3 << 11) | 20) & 0xFu; }
#define XB_SPIN(cond, bar) do { unsigned _sp = 0; while (cond) { __builtin_amdgcn_s_sleep(1); \
    if ((++_sp & 255u) == 0u) { if (xb_ld(&(bar)[XB_TMO])) break; if (_sp > XB_SPIN_CAP) { atomicAdd(&(bar)[XB_TMO], 1u); break; } } } } while (0)

struct XcdBarrier {
    unsigned* bar; unsigned x;
    volatile LAS unsigned* st;
};

__device__ __forceinline__ XcdBarrier xcd_barrier_post(unsigned* bar, volatile LAS unsigned* st) {
    XcdBarrier b; b.bar = bar; b.x = xb_xcc_id(); b.st = st;
    if (threadIdx.x == 0) (void)xb_add(&bar[XB_XCNT(b.x)], 1u);
    return b;
}
__device__ __forceinline__ void xcd_barrier_complete(unsigned* bar, unsigned x, unsigned& nloc, unsigned& nx) {
    const unsigned G = gridDim.x * gridDim.y * gridDim.z;
    unsigned sum, cnt, mine, sp = 0u;
    for (;;) {
        sum = 0u; cnt = 0u; mine = 0u;
#pragma unroll
        for (unsigned j = 0; j < 16; ++j) { const unsigned c = xb_ld(&bar[XB_XCNT(j)]); sum += c; cnt += (c > 0u) ? 1u : 0u; mine = (j == x) ? c : mine; }
        if (sum == G) break;
        __builtin_amdgcn_s_sleep(1);
        if ((++sp & 255u) == 0u) { if (xb_ld(&bar[XB_TMO])) break; if (sp > XB_SPIN_CAP) { atomicAdd(&bar[XB_TMO], 1u); break; } }
    }
    nloc = mine > 0u ? mine : 1u; nx = cnt > 0u ? cnt : 1u;
}

__device__ __forceinline__ void xcd_barrier(const XcdBarrier& b) {
    asm volatile("s_waitcnt vmcnt(0)" ::: "memory");
    __syncthreads();
    if (threadIdx.x == 0) {
        unsigned* bar = b.bar;
        __builtin_amdgcn_s_waitcnt(0);
        unsigned nloc = b.st[0], nx = b.st[1];
        if (nloc == 0u) { xcd_barrier_complete(bar, b.x, nloc, nx); b.st[0] = nloc; b.st[1] = nx; }
        const unsigned old = xb_add(&bar[XB_XSUB(b.x)], 1u);
        const unsigned gen = old / nloc;
        if (old + 1u == (gen + 1u) * nloc) {
            __builtin_amdgcn_fence(__ATOMIC_RELEASE, "agent");
            asm volatile("s_waitcnt vmcnt(0)" ::: "memory");
            const unsigned og = xb_add(&bar[XB_TOP], 1u);
            const unsigned tg = og / nx;
            if (og + 1u == (tg + 1u) * nx) xb_add(&bar[XB_TOPGEN], 1u);
            else XB_SPIN(xb_ld(&bar[XB_TOPGEN]) == tg, bar);
            __builtin_amdgcn_fence(__ATOMIC_ACQUIRE, "agent");
            xb_add(&bar[XB_XGEN(b.x)], 1u);
            asm volatile("s_waitcnt vmcnt(0)" ::: "memory");
        } else {
            XB_SPIN(xb_ld(&bar[XB_XGEN(b.x)]) == gen, bar);
            __builtin_amdgcn_fence(__ATOMIC_ACQUIRE, "agent");
            asm volatile("s_waitcnt vmcnt(0)" ::: "memory");
        }
    }
    __syncthreads();
}

struct Frame {
    LAS unsigned char* lds;
    volatile LAS unsigned* MISC;
    gu32* ctl;
    int tid, lane, wave;
    int vcu, G;
    const float *x, *c, *w_ada, *b_ada, *w_in, *b_forget, *qg, *kg, *fog, *rog, *w_out, *w1, *w2; float* out;
    bf16 *Win_t, *Wout_t, *W1_t, *W2_t;
    float *wf, *rope, *logf, *cum, *mod;
    bf16 *H, *MIXB, *PROJ, *U;
};
__device__ __forceinline__ float bf2f(unsigned short v) { return __uint_as_float((unsigned)v << 16); }
__device__ __forceinline__ float bflo(unsigned w) { return __uint_as_float(w << 16); }
__device__ __forceinline__ float bfhi(unsigned w) { return __uint_as_float(w & 0xffff0000u); }
__device__ __forceinline__ void unpack8(const v4u w, float* f) { f[0] = bflo(w.x); f[1] = bfhi(w.x); f[2] = bflo(w.y); f[3] = bfhi(w.y); f[4] = bflo(w.z); f[5] = bfhi(w.z); f[6] = bflo(w.w); f[7] = bfhi(w.w); }
__device__ __forceinline__ v4u pack8(const float* f) { v4u w; w.x = pk2(f[0], f[1]); w.y = pk2(f[2], f[3]); w.z = pk2(f[4], f[5]); w.w = pk2(f[6], f[7]); return w; }

__device__ __forceinline__ void p0_transpose_item(const float* W, int K, int ldn, int col_off, int nblk, bf16* WT, int row_off, LAS float* scr, int item, int lane) {
    const int kb = item / nblk, nb = item % nblk, k0 = 64 * kb, n0 = 32 * nb;
#pragma unroll 8
    for (int i = 0; i < 32; ++i) { const int kk = 2 * i + (lane >> 5); scr[kk * 33 + (lane & 31)] = W[(size_t)(k0 + kk) * ldn + col_off + n0 + (lane & 31)]; }
    LDS_WAIT(); asm volatile("" ::: "memory");
    const int c = lane & 7;
#pragma unroll
    for (int j = 0; j < 4; ++j) { const int n = (lane >> 3) + 8 * j; const LAS float* s = scr + (8 * c) * 33 + n;
        v4u o; o.x = pk2(s[0 * 33], s[1 * 33]); o.y = pk2(s[2 * 33], s[3 * 33]); o.z = pk2(s[4 * 33], s[5 * 33]); o.w = pk2(s[6 * 33], s[7 * 33]);
        *(GAS v4u*)(WT + (size_t)(row_off + n0 + n) * K + k0 + 8 * c) = o; }
    LDS_WAIT(); asm volatile("" ::: "memory");
}
__device__ __forceinline__ void p0_mod_item(Frame& F, LAS float* scr, int item) {
    const int cg = item % 96, ks = item / 96; const int e = cg * 64 + F.lane, k0 = ks * 128;
#pragma unroll 4
    for (int i = 0; i < 64; ++i) { const int idx = i * 64 + F.lane; const int kk = idx >> 5, b = idx & 31; const float cv = F.c[b * D + k0 + kk]; scr[idx] = cv / (1.f + expf(-cv)); }
    LDS_WAIT(); asm volatile("" ::: "memory");
    float acc[32];
#pragma unroll
    for (int b = 0; b < 32; ++b) acc[b] = 0.f;
#pragma unroll 4
    for (int kk = 0; kk < 128; ++kk) { const float w = F.w_ada[(size_t)(k0 + kk) * NMOD + e];
#pragma unroll
        for (int b4 = 0; b4 < 8; ++b4) { const f32x4 s = *(const LAS f32x4*)(scr + kk * 32 + 4 * b4);
            acc[4 * b4 + 0] += s.x * w; acc[4 * b4 + 1] += s.y * w; acc[4 * b4 + 2] += s.z * w; acc[4 * b4 + 3] += s.w * w; } }
    const float bias = (ks == 0) ? F.b_ada[e] : 0.f;
#pragma unroll
    for (int b = 0; b < 32; ++b) atomicAdd(&F.mod[b * NMOD + e], acc[b] + bias);
    LDS_WAIT(); asm volatile("" ::: "memory");
}
__device__ __forceinline__ void p0_rope_item(Frame& F, int s) {
    const int j = F.lane;
    double f = 1.0, p = 0.86596432336006535; int e = j;
#pragma unroll
    for (int bit = 0; bit < 6; ++bit) { if (e & 1) f *= p; p *= p; e >>= 1; }
    const double ang = (double)s * f;
    const double kq = rint(ang * 0.63661977236758134);
    const double r = fma(-kq, 1.5707963267948966, ang) - kq * 6.123233995736766e-17;
    const double r2 = r * r;
    const double sn = r * (1.0 + r2 * (-1.0 / 6.0 + r2 * (1.0 / 120.0 + r2 * (-1.0 / 5040.0 + r2 * (1.0 / 362880.0 + r2 * (-1.0 / 39916800.0 + r2 * (1.0 / 6227020800.0)))))));
    const double cs = 1.0 + r2 * (-0.5 + r2 * (1.0 / 24.0 + r2 * (-1.0 / 720.0 + r2 * (1.0 / 40320.0 + r2 * (-1.0 / 3628800.0 + r2 * (1.0 / 479001600.0 + r2 * (-1.0 / 87178291200.0)))))));
    const int q = ((int)kq) & 3;
    const double S = (q == 0) ? sn : (q == 1) ? cs : (q == 2) ? -sn : -cs;
    const double C = (q == 0) ? cs : (q == 1) ? -sn : (q == 2) ? -cs : sn;
    F.rope[s * 128 + j] = (float)C; F.rope[s * 128 + 64 + j] = (float)S;
}
__device__ __forceinline__ void p0_prologue(Frame& F) {
    LAS float* scr = (LAS float*)(F.lds + RING_OFF + F.wave * 16384);
    const int gw = F.vcu * NWAVES + F.wave, NGW = F.G * NWAVES;
    constexpr int I_INA = (D / 64) * (2048 / 32), I_INB = I_INA, I_O = (D / 64) * (D / 32), I_1 = (D / 64) * (FF / 32), I_2 = (FF / 64) * (D / 32);
    constexpr int I_MOD = 96 * 8, I_ROPE = SEQ, I_WF = 8;
    constexpr int NITEMS = I_MOD + I_INA + I_INB + I_O + I_1 + I_2 + I_ROPE + I_WF;
    for (int it = gw; it < NITEMS; it += NGW) {
        int r = it;
        if (r < I_MOD) { p0_mod_item(F, scr, r); continue; } r -= I_MOD;
        if (r < I_INA) { p0_transpose_item(F.w_in, D, IN_COLS, 0, 2048 / 32, F.Win_t, 0, scr, r, F.lane); continue; } r -= I_INA;
        if (r < I_INB) { p0_transpose_item(F.w_in, D, IN_COLS, 2056, 2048 / 32, F.Win_t, 2048, scr, r, F.lane); continue; } r -= I_INB;
        if (r < I_O) { p0_transpose_item(F.w_out, D, D, 0, D / 32, F.Wout_t, 0, scr, r, F.lane); continue; } r -= I_O;
        if (r < I_1) { p0_transpose_item(F.w1, D, FF, 0, FF / 32, F.W1_t, 0, scr, r, F.lane); continue; } r -= I_1;
        if (r < I_2) { p0_transpose_item(F.w2, FF, D, 0, D / 32, F.W2_t, 0, scr, r, F.lane); continue; } r -= I_2;
        if (r < I_ROPE) { p0_rope_item(F, r); continue; } r -= I_ROPE;
        { for (int k = F.lane; k < D; k += 64) F.wf[r * D + k] = F.w_in[(size_t)k * IN_COLS + 2048 + r]; }
    }
}

__device__ __forceinline__ float wave_sum(float v) {
#pragma unroll
    for (int o = 1; o < 64; o <<= 1) v += __shfl_xor(v, o);
    return v;
}
__device__ __forceinline__ float reduce8(const float* p, int lane) {
    const bool b0 = lane & 1, b1 = lane & 2, b2 = lane & 4;
    float q[4], r[2];
#pragma unroll
    for (int i = 0; i < 4; ++i) { const float send = b0 ? p[i] : p[i + 4], keep = b0 ? p[i + 4] : p[i]; q[i] = keep + __shfl_xor(send, 1); }
#pragma unroll
    for (int i = 0; i < 2; ++i) { const float send = b1 ? q[i] : q[i + 2], keep = b1 ? q[i + 2] : q[i]; r[i] = keep + __shfl_xor(send, 2); }
    const float send = b2 ? r[0] : r[1], keep = b2 ? r[1] : r[0];
    float s = keep + __shfl_xor(send, 4);
    s += __shfl_xor(s, 8); s += __shfl_xor(s, 16); s += __shfl_xor(s, 32);
    return s;
}
template <bool FORGET> __device__ __forceinline__ void norm_phase(Frame& F, const float* xin, int mod_scale, int mod_shift) {
    LAS float* sc = (LAS float*)F.lds; LAS float* sh = sc + 1024; LAS float* wfl = sh + 1024; LAS float* bfl = wfl + 8192;
    for (int chunk = F.vcu; chunk < M / 256; chunk += F.G) {
        const int b = chunk >> 3;
        __syncthreads();
        for (int i = F.tid; i < 1024; i += NWAVES * 64) { sc[i] = 1.f + F.mod[b * NMOD + mod_scale + i]; sh[i] = F.mod[b * NMOD + mod_shift + i]; }
        if (FORGET) { for (int i = F.tid; i < 8192; i += NWAVES * 64) wfl[i] = F.wf[i]; if (F.tid < 8) bfl[F.tid] = F.b_forget[F.tid]; }
        __syncthreads();
        for (int rp = 0; rp < 32; ++rp) {
            const int row = chunk * 256 + F.wave * 32 + rp;
            const GAS f32x4* xr = (const GAS f32x4*)(xin + (size_t)row * D) + F.lane;
            f32x4 v[4]; float ss = 0.f;
#pragma unroll
            for (int j = 0; j < 4; ++j) { v[j] = xr[64 * j]; ss += (v[j].x * v[j].x + v[j].y * v[j].y) + (v[j].z * v[j].z + v[j].w * v[j].w); }
            const float rstd = rsqrtf(wave_sum(ss) * (1.f / D) + EPS);
            GAS unsigned long long* o8 = (GAS unsigned long long*)(F.H + (size_t)row * D) + F.lane;
#pragma unroll
            for (int j = 0; j < 4; ++j) { const f32x4 s4 = *(const LAS f32x4*)(sc + 4 * F.lane + 256 * j), h4 = *(const LAS f32x4*)(sh + 4 * F.lane + 256 * j);
                v[j] = v[j] * rstd * s4 + h4;
                o8[64 * j] = (unsigned long long)pk2(v[j].x, v[j].y) | ((unsigned long long)pk2(v[j].z, v[j].w) << 32); }
            if (FORGET) {
                float p[8];
#pragma unroll
                for (int hh = 0; hh < 8; ++hh) { float a = 0.f;
#pragma unroll
                    for (int j = 0; j < 4; ++j) { const f32x4 w4 = *(const LAS f32x4*)(wfl + hh * 1024 + 4 * F.lane + 256 * j); a += (v[j].x * w4.x + v[j].y * w4.y) + (v[j].z * w4.z + v[j].w * w4.w); }
                    p[hh] = a; }
                const float tot = reduce8(p, F.lane);
                if (F.lane < 8) { const int hs = 4 * (F.lane & 1) + 2 * ((F.lane >> 1) & 1) + ((F.lane >> 2) & 1);
                    const float z = tot + bfl[hs];
                    const float lf = fminf(z, 0.f) - log1pf(expf(-fabsf(z)));
                    F.logf[((size_t)(b * 8 + hs)) * SEQ + (row & (SEQ - 1))] = lf; }
            }
        }
    }
}
__device__ __forceinline__ void cumsum_seq(Frame& F, int seq) {
    const float* src = F.logf + (size_t)seq * SEQ + 32 * F.lane; float* dst = F.cum + (size_t)seq * SEQ + 32 * F.lane;
    double run = 0.0; float v[32];
#pragma unroll
    for (int i = 0; i < 8; ++i) { const f32x4 t = *(const f32x4*)(src + 4 * i); v[4 * i] = t.x; v[4 * i + 1] = t.y; v[4 * i + 2] = t.z; v[4 * i + 3] = t.w; }
#pragma unroll
    for (int i = 0; i < 32; ++i) run += (double)v[i];
    double t = run;
#pragma unroll
    for (int o = 1; o < 64; o <<= 1) { const double n = __shfl_up(t, o); if (F.lane >= o) t += n; }
    double acc = t - run;
#pragma unroll
    for (int i = 0; i < 8; ++i) { f32x4 o4; acc += (double)v[4 * i]; o4.x = (float)(acc * 1.4426950408889634); acc += (double)v[4 * i + 1]; o4.y = (float)(acc * 1.4426950408889634);
        acc += (double)v[4 * i + 2]; o4.z = (float)(acc * 1.4426950408889634); acc += (double)v[4 * i + 3]; o4.w = (float)(acc * 1.4426950408889634); *(f32x4*)(dst + 4 * i) = o4; }
}

__device__ __forceinline__ void post_row(Frame& F, size_t row) {
    bf16* p = F.PROJ + row * NPROJ; const int lane = F.lane; const int s = (int)(row & (SEQ - 1));
    {
        const int hd = lane >> 2, sl = lane & 3; bf16* a = p + hd * 64 + sl * 16;
        float v[16]; unpack8(*(const v4u*)a, v); unpack8(*(const v4u*)(a + 8), v + 8);
        float ss = 0.f;
#pragma unroll
        for (int i = 0; i < 16; ++i) ss += v[i] * v[i];
        ss += __shfl_xor(ss, 1); ss += __shfl_xor(ss, 2);
        const float rstd = rsqrtf(ss * (1.f / 64.f) + EPS);
        const float* g = ((hd < 8) ? F.qg : F.kg) + sl * 16; const float scl = (hd < 8) ? C2 * rstd : rstd;
#pragma unroll
        for (int i = 0; i < 16; ++i) v[i] = v[i] * scl * g[i];
        *(v4u*)a = pack8(v); *(v4u*)(a + 8) = pack8(v + 8);
    }
    {
        const int hh = lane >> 3, i0 = (lane & 7) * 8; bf16* a = p + C_RQ + hh * 128 + i0;
        float x1[8], x2[8]; unpack8(*(const v4u*)a, x1); unpack8(*(const v4u*)(a + 64), x2);
        const float* ct = F.rope + s * 128 + i0; const float* st = ct + 64;
        const float scl = (hh >= 4) ? 0.08838834764831845f : 1.f;
        float y1[8], y2[8];
#pragma unroll
        for (int i = 0; i < 8; ++i) { const float c = ct[i], sn = st[i]; y1[i] = (x1[i] * c - x2[i] * sn) * scl; y2[i] = (x1[i] * sn + x2[i] * c) * scl; }
        *(v4u*)a = pack8(y1); *(v4u*)(a + 64) = pack8(y2);
    }
}

__device__ __forceinline__ void fox_naive_unit(Frame& F, int b, int h, int qb) {
    LAS float* Ks = (LAS float*)F.lds; LAS float* Vs = Ks + 4096; LAS float* ck = Vs + 4096;
    const int t = F.tid, qi = t >> 2, sl = t & 3; const int tq = 128 * qb + qi; const size_t row = (size_t)b * SEQ + tq;
    const bf16* P = F.PROJ;
    float q[16]; unpack8(*(const v4u*)(P + row * NPROJ + C_FQ + h * 64 + sl * 16), q); unpack8(*(const v4u*)(P + row * NPROJ + C_FQ + h * 64 + sl * 16 + 8), q + 8);
    const float* cum = F.cum + (size_t)(b * 8 + h) * SEQ; const float cq = cum[tq];
    float m = -INFINITY, l = 0.f; float o[16];
#pragma unroll
    for (int i = 0; i < 16; ++i) o[i] = 0.f;
    const int nkt = 2 * (qb + 1);
    for (int kt = 0; kt < nkt; ++kt) {
        __syncthreads();
        { const size_t krow = (size_t)b * SEQ + 64 * kt + (t >> 3); float f[8];
          unpack8(*(const v4u*)(P + krow * NPROJ + C_FK + h * 64 + (t & 7) * 8), f);
          *(LAS f32x4*)(Ks + (t >> 3) * 64 + (t & 7) * 8) = (f32x4){f[0], f[1], f[2], f[3]}; *(LAS f32x4*)(Ks + (t >> 3) * 64 + (t & 7) * 8 + 4) = (f32x4){f[4], f[5], f[6], f[7]};
          unpack8(*(const v4u*)(P + krow * NPROJ + C_FV + h * 64 + (t & 7) * 8), f);
          *(LAS f32x4*)(Vs + (t >> 3) * 64 + (t & 7) * 8) = (f32x4){f[0], f[1], f[2], f[3]}; *(LAS f32x4*)(Vs + (t >> 3) * 64 + (t & 7) * 8 + 4) = (f32x4){f[4], f[5], f[6], f[7]};
          if (t < 64) ck[t] = cum[64 * kt + t]; }
        __syncthreads();
#pragma unroll 2
        for (int kk = 0; kk < 64; ++kk) {
            const LAS float* kr = Ks + kk * 64 + sl * 16; float part = 0.f;
#pragma unroll
            for (int i4 = 0; i4 < 4; ++i4) { const f32x4 k4 = *(const LAS f32x4*)(kr + 4 * i4); part += (q[4 * i4] * k4.x + q[4 * i4 + 1] * k4.y) + (q[4 * i4 + 2] * k4.z + q[4 * i4 + 3] * k4.w); }
            part += __shfl_xor(part, 1); part += __shfl_xor(part, 2);
            float lg = part + (cq - ck[kk]); if (64 * kt + kk > tq) lg = -INFINITY;
            const float mn = fmaxf(m, lg); const float al = exp2f(m - mn), pp = exp2f(lg - mn);
            l = l * al + pp; m = mn;
            const LAS float* vr = Vs + kk * 64 + sl * 16;
#pragma unroll
            for (int i4 = 0; i4 < 4; ++i4) { const f32x4 v4 = *(const LAS f32x4*)(vr + 4 * i4);
                o[4 * i4] = o[4 * i4] * al + pp * v4.x; o[4 * i4 + 1] = o[4 * i4 + 1] * al + pp * v4.y; o[4 * i4 + 2] = o[4 * i4 + 2] * al + pp * v4.z; o[4 * i4 + 3] = o[4 * i4 + 3] * al + pp * v4.w; }
        }
    }
    const float il = 1.f / l; float ss = 0.f;
#pragma unroll
    for (int i = 0; i < 16; ++i) { o[i] *= il; ss += o[i] * o[i]; }
    ss += __shfl_xor(ss, 1); ss += __shfl_xor(ss, 2);
    const float rstd = rsqrtf(ss * (1.f / 64.f) + EPS);
    float g[16]; unpack8(*(const v4u*)(P + row * NPROJ + C_FOG + h * 64 + sl * 16), g); unpack8(*(const v4u*)(P + row * NPROJ + C_FOG + h * 64 + sl * 16 + 8), g + 8);
    const float* gn = F.fog + h * 64 + sl * 16;
#pragma unroll
    for (int i = 0; i < 16; ++i) o[i] = o[i] * rstd * gn[i] * (1.f / (1.f + expf(-g[i])));
    bf16* dst = F.MIXB + row * D + h * 64 + sl * 16;
    *(v4u*)dst = pack8(o); *(v4u*)(dst + 8) = pack8(o + 8);
}
__device__ __forceinline__ void ret_naive_unit(Frame& F, int b, int h, int qb) {
    LAS float* Ks = (LAS float*)F.lds; LAS float* Vs = Ks + 8192;
    const int t = F.tid, qi = t >> 2, sl = t & 3; const int tq = 128 * qb + qi; const size_t row = (size_t)b * SEQ + tq;
    const bf16* P = F.PROJ;
    float q[32];
#pragma unroll
    for (int i = 0; i < 4; ++i) unpack8(*(const v4u*)(P + row * NPROJ + C_RQ + h * 128 + sl * 32 + 8 * i), q + 8 * i);
    const float lg2 = (h == 0) ? -0.04580368961312479f : (h == 1) ? -0.02272007650008353f : (h == 2) ? -0.011315313227834146f : -0.005646563141142063f;
    float o[32];
#pragma unroll
    for (int i = 0; i < 32; ++i) o[i] = 0.f;
    const int nkt = 2 * (qb + 1);
    for (int kt = 0; kt < nkt; ++kt) {
        __syncthreads();
#pragma unroll
        for (int rep = 0; rep < 2; ++rep) { const int id = t + rep * 512; const int kr = id >> 4, ch = id & 15; const size_t krow = (size_t)b * SEQ + 64 * kt + kr; float f[8];
            unpack8(*(const v4u*)(P + krow * NPROJ + C_RK + h * 128 + ch * 8), f);
            *(LAS f32x4*)(Ks + kr * 128 + ch * 8) = (f32x4){f[0], f[1], f[2], f[3]}; *(LAS f32x4*)(Ks + kr * 128 + ch * 8 + 4) = (f32x4){f[4], f[5], f[6], f[7]};
            unpack8(*(const v4u*)(P + krow * NPROJ + C_RV + h * 128 + ch * 8), f);
            *(LAS f32x4*)(Vs + kr * 128 + ch * 8) = (f32x4){f[0], f[1], f[2], f[3]}; *(LAS f32x4*)(Vs + kr * 128 + ch * 8 + 4) = (f32x4){f[4], f[5], f[6], f[7]}; }
        __syncthreads();
#pragma unroll 2
        for (int kk = 0; kk < 64; ++kk) {
            const LAS float* kr = Ks + kk * 128 + sl * 32; float part = 0.f;
#pragma unroll
            for (int i4 = 0; i4 < 8; ++i4) { const f32x4 k4 = *(const LAS f32x4*)(kr + 4 * i4); part += (q[4 * i4] * k4.x + q[4 * i4 + 1] * k4.y) + (q[4 * i4 + 2] * k4.z + q[4 * i4 + 3] * k4.w); }
            part += __shfl_xor(part, 1); part += __shfl_xor(part, 2);
            const int dist = tq - (64 * kt + kk);
            const float w = (dist >= 0) ? part * exp2f((float)dist * lg2) : 0.f;
            const LAS float* vr = Vs + kk * 128 + sl * 32;
#pragma unroll
            for (int i4 = 0; i4 < 8; ++i4) { const f32x4 v4 = *(const LAS f32x4*)(vr + 4 * i4);
                o[4 * i4] += w * v4.x; o[4 * i4 + 1] += w * v4.y; o[4 * i4 + 2] += w * v4.z; o[4 * i4 + 3] += w * v4.w; }
        }
    }
    float ss = 0.f;
#pragma unroll
    for (int i = 0; i < 32; ++i) ss += o[i] * o[i];
    ss += __shfl_xor(ss, 1); ss += __shfl_xor(ss, 2);
    const float rstd = rsqrtf(ss * (1.f / 128.f) + EPS);
    const float* gn = F.rog + h * 128 + sl * 32;
    bf16* dst = F.MIXB + row * D + 512 + h * 128 + sl * 32;
#pragma unroll
    for (int i = 0; i < 4; ++i) { float g[8]; unpack8(*(const v4u*)(P + row * NPROJ + C_RG + h * 128 + sl * 32 + 8 * i), g); float r[8];
#pragma unroll
        for (int e = 0; e < 8; ++e) { const float z = g[e]; r[e] = o[8 * i + e] * rstd * gn[8 * i + e] * (z / (1.f + expf(-z))); }
        *(v4u*)(dst + 8 * i) = pack8(r); }
}
__device__ __forceinline__ void mixer_naive_phase(Frame& F, unsigned char* lds_generic) {
    static_assert(attn_body::ATTN_LDS_BYTES <= RING_BYTES, "attention LDS");
    for (int bh = F.vcu; bh < BATCH * 8; bh += F.G) for (int qb = 7; qb >= 0; --qb)
        attn_body::attn_unit<8>(bh >> 3, bh & 7, qb, (const attn_body::bf16*)(F.PROJ + C_FQ), (const attn_body::bf16*)(F.PROJ + C_FK), (const attn_body::bf16*)(F.PROJ + C_FV),
                                (const attn_body::bf16*)(F.PROJ + C_FOG), F.cum, F.fog, (attn_body::bf16*)F.MIXB, (char*)lds_generic + RING_OFF);
    for (int id = F.vcu; id < BATCH * 4 * 2; id += F.G) { const int bh = id >> 1, par = id & 1;
        for (int i = 0; i < 8; ++i) { const int qb = (i & 1) ? 15 - (i - 1) - par : i + par; ret_naive_unit(F, bh >> 2, bh & 3, qb); } }
    __syncthreads();
}

struct Args { const float* in[13]; float* out; unsigned char* ws; int ph_lo, ph_hi, li, pad; };
__global__ void __launch_bounds__(NWAVES * 64, 2) skel_fwd(Args args) {
    extern __shared__ __attribute__((aligned(16))) unsigned char lds[];
    Frame F;
    F.lds = (LAS unsigned char*)lds;
    F.MISC = (volatile LAS unsigned*)(F.lds + MISC_OFF);
    F.tid = threadIdx.x; F.lane = F.tid & 63; F.wave = __builtin_amdgcn_readfirstlane(F.tid >> 6);
    F.G = gridDim.x; { const int bx = blockIdx.x; F.vcu = (F.G % 8 == 0) ? (bx % 8) * (F.G / 8) + bx / 8 : bx; }
    unsigned char* ws = args.ws;
    F.ctl = (gu32*)(ws + WS_CTL);
    F.x = args.in[0]; F.c = args.in[1]; F.w_ada = args.in[2]; F.b_ada = args.in[3]; F.w_in = args.in[4]; F.b_forget = args.in[5]; F.qg = args.in[6]; F.kg = args.in[7];
    F.fog = args.in[8]; F.rog = args.in[9]; F.w_out = args.in[10]; F.w1 = args.in[11]; F.w2 = args.in[12]; F.out = args.out;
    F.Win_t = (bf16*)(ws + WS_WIN); F.Wout_t = (bf16*)(ws + WS_WOUT); F.W1_t = (bf16*)(ws + WS_W1); F.W2_t = (bf16*)(ws + WS_W2);
    F.wf = (float*)(ws + WS_WF); F.rope = (float*)(ws + WS_ROPE); F.logf = (float*)(ws + WS_LOGF); F.cum = (float*)(ws + WS_CUM); F.mod = (float*)(ws + WS_MOD);
    F.H = (bf16*)(ws + WS_H); F.MIXB = (bf16*)(ws + WS_MIX); F.PROJ = (bf16*)(ws + WS_PROJ); F.U = (bf16*)(ws + WS_U);
    for (int u = F.tid; u < (LDS_BYTES - LDSCTL_OFF) / 4; u += NWAVES * 64) ((LAS unsigned*)(F.lds + LDSCTL_OFF))[u] = 0u;
    __syncthreads();
    XcdBarrier bar; bar.bar = (unsigned*)(F.ctl + CW_BAR); bar.x = 0; bar.st = nullptr;
    if (N_LAUNCHES != PER_PHASE) bar = xcd_barrier_post((unsigned*)(F.ctl + CW_BAR), F.MISC + 8);
#define GRID_BAR() do { if (N_LAUNCHES != PER_PHASE) xcd_barrier(bar); } while (0)
    const int lo = args.ph_lo, hi = args.ph_hi;
#define IN(k) (lo <= (k) && (k) < hi)
#define BOTH(k) (IN(k) && IN((k) + 1))
    if (IN(0)) { p0_prologue(F); if (BOTH(0)) GRID_BAR(); }
    if (IN(1)) { norm_phase<true>(F, F.x, MOD_SCALE_M, MOD_SHIFT_M); if (BOTH(1)) GRID_BAR(); }
    if (IN(2)) {
        for (int seq = F.vcu; seq < BATCH * 8; seq += F.G) if (F.wave == 0) cumsum_seq(F, seq);
        pg8::Gemm g{F.H, F.Win_t, M, NPROJ, D}; pg8::StaticOrder S; S.init(M, NPROJ, F.G, (int)blockIdx.x);
        pg8::EpiBf16<0> E{F.PROJ, NPROJ};
        pg8::gemm_phase<pg8::EpiBf16<0>, pg8::StaticOrder, PG8_ALIGN, PG8_SP2>(F.lds + RING_OFF, g, S, E);
        if (BOTH(2)) GRID_BAR();
    }
    if (IN(3)) { const int gw = F.vcu * NWAVES + F.wave, NGW = F.G * NWAVES; for (int r = gw; r < M; r += NGW) post_row(F, (size_t)r); if (BOTH(3)) GRID_BAR(); }
    if (IN(4)) { mixer_naive_phase(F, lds); if (BOTH(4)) GRID_BAR(); }
    if (IN(5)) {
        pg8::Gemm g{F.MIXB, F.Wout_t, M, D, D}; pg8::StaticOrder S; S.init(M, D, F.G, (int)blockIdx.x);
        pg8::EpiResGate E{F.x, F.out, D, F.mod + MOD_GATE_M, NMOD, SEQ / 256};
        pg8::gemm_phase<pg8::EpiResGate, pg8::StaticOrder, PG8_ALIGN, PG8_SP2>(F.lds + RING_OFF, g, S, E);
        if (BOTH(5)) GRID_BAR();
    }
    if (IN(6)) { norm_phase<false>(F, F.out, MOD_SCALE_F, MOD_SHIFT_F); if (BOTH(6)) GRID_BAR(); }
    if (IN(7)) {
        pg8::Gemm g{F.H, F.W1_t, M, FF, D}; pg8::StaticOrder S; S.init(M, FF, F.G, (int)blockIdx.x);
        pg8::EpiBf16<2> E{F.U, FF};
        pg8::gemm_phase<pg8::EpiBf16<2>, pg8::StaticOrder, PG8_ALIGN, PG8_SP2>(F.lds + RING_OFF, g, S, E);
        if (BOTH(7)) GRID_BAR();
    }
    if (IN(8)) {
        pg8::Gemm g{F.U, F.W2_t, M, D, FF}; pg8::StaticOrder S; S.init(M, D, F.G, (int)blockIdx.x);
        pg8::EpiResGate E{F.out, F.out, D, F.mod + MOD_GATE_F, NMOD, SEQ / 256};
        pg8::gemm_phase<pg8::EpiResGate, pg8::StaticOrder, PG8_ALIGN, PG8_SP2>(F.lds + RING_OFF, g, S, E);
    }
#undef IN
#undef BOTH
}

extern "C" void kernel_launch(void* const* d_in, const int* in_sizes, int n_in, void* d_out, int out_size, void* d_ws, size_t ws_size, hipStream_t stream) {
    static int grid = 0;
    if (grid == 0) {
        if (n_in != 13 || in_sizes[0] != M * D || out_size != M * D || ws_size < WS_END) { fprintf(stderr, "kernel_launch: unexpected shapes/workspace (n_in %d, in0 %d, out %d, ws %zu); nothing launched\n", n_in, n_in > 0 ? in_sizes[0] : -1, out_size, ws_size); grid = -1; return; }
        int dev = 0, cus = 0, per_cu = 0;
        if (hipGetDevice(&dev) != hipSuccess || hipDeviceGetAttribute(&cus, hipDeviceAttributeMultiprocessorCount, dev) != hipSuccess) { fprintf(stderr, "kernel_launch: device query failed\n"); grid = -1; return; }
        if (hipFuncSetAttribute((const void*)skel_fwd, hipFuncAttributeMaxDynamicSharedMemorySize, LDS_BYTES) != hipSuccess) { fprintf(stderr, "kernel_launch: hipFuncSetAttribute failed\n"); grid = -1; return; }
        if (hipOccupancyMaxActiveBlocksPerMultiprocessor(&per_cu, (const void*)skel_fwd, NWAVES * 64, LDS_BYTES) != hipSuccess || per_cu < 1) { fprintf(stderr, "kernel_launch: occupancy query reports %d workgroups per CU; nothing launched\n", per_cu); (void)hipGetLastError(); grid = -1; return; }
        grid = cus;
    }
    if (grid < 0) return;
    if (hipMemsetAsync((char*)d_ws + WS_CTL, 0, CTL_ZERO_BYTES, stream) != hipSuccess) { fprintf(stderr, "kernel_launch: hipMemsetAsync failed\n"); return; }
    Args a{};
    for (int i = 0; i < 13; ++i) a.in[i] = (const float*)d_in[i];
    a.out = (float*)d_out; a.ws = (unsigned char*)d_ws;
    for (int li = 0; li < N_LAUNCHES; ++li) {
        a.ph_lo = (N_LAUNCHES == PER_PHASE) ? li : 0; a.ph_hi = (N_LAUNCHES == PER_PHASE) ? li + 1 : PER_PHASE; a.li = li;
        hipLaunchKernelGGL(skel_fwd, dim3(grid), dim3(NWAVES * 64), LDS_BYTES, stream, a);
        const hipError_t le = hipPeekAtLastError();
        if (le != hipSuccess) { fprintf(stderr, "kernel_launch: launch %d failed: %s\n", li, hipGetErrorName(le)); break; }
    }
}
```

```cpp
#include <hip/hip_runtime.h>
#include <cstdio>
#include <cstdint>
#include <cmath>
namespace pg8 {
#define PG8_LAS __attribute__((address_space(3)))
typedef unsigned short bf16_t;
typedef short bf16x8 __attribute__((ext_vector_type(8)));
typedef float f32x4 __attribute__((ext_vector_type(4)));
typedef unsigned u32x4 __attribute__((ext_vector_type(4)));
constexpr int BM = 256, BK = 64, HALF = 128, HTB = HALF * BK * 2  , STAGE_BYTES = 8 * HTB, NXCD = 8, WGM = 8;

__host__ __device__ __forceinline__ int lds_byte(int r, int c) { const int st = (r >> 4) * 2 + (c >> 5), rr = r & 15, cc = c & 31, ob = rr * 64 + cc * 2; return st * 1024 + (ob ^ (((ob >> 9) & 1) << 5)); }
__host__ __device__ __forceinline__ void stage_rc(int b, int& R, int& C) { const int st = b / 1024, sb = b % 1024, swz = sb ^ (((sb >> 9) & 1) << 5); R = (st >> 1) * 16 + swz / 64; C = (st & 1) * 32 + (swz % 64) / 2; }
__host__ __device__ __forceinline__ int perm32(int rho) { const int n = rho >> 4, i = rho & 15; return 8 * (i >> 2) + 4 * n + (i & 3); }

struct Unit { int pm, pn; };
struct Gemm { const bf16_t* A; const bf16_t* Bt; int M, N, K; };

struct StaticOrder {
    int nM, nN, nwg, G, c;
    __host__ __device__ void init(int M, int N, int G_, int c_) { nM = M / BM; nN = N / BM; nwg = nM * nN; G = G_; c = c_; }
    __host__ __device__ bool next(int i, Unit& u) const {
        const long L = (long)i * G + c; if (L >= nwg) return false;
        int wgid = (int)L; { const int q = nwg / NXCD, r = nwg % NXCD, xcd = wgid % NXCD, off = wgid / NXCD; wgid = (xcd < r ? xcd * (q + 1) : r * (q + 1) + (xcd - r) * q) + off; }
        const int nig = WGM * nN, gid = wgid / nig, fm = gid * WGM, gsz = (nM - fm) < WGM ? (nM - fm) : WGM;
        u.pm = fm + ((wgid % nig) % gsz); u.pn = (wgid % nig) / gsz; return true;
    }
    __device__ __forceinline__ void a_ready(const Unit&) const {}
    __device__ __forceinline__ void done(const Unit&) const {}
};

__device__ __forceinline__ unsigned cvt_pk_bf16(float lo, float hi) { unsigned r; asm volatile("v_cvt_pk_bf16_f32 %0, %1, %2" : "=v"(r) : "v"(lo), "v"(hi)); return r; }

template <int ACT> struct EpiBf16 {
    static constexpr bool PERM = true, AFTER_DRAIN = false;
    bf16_t* O; int ldc;
    __device__ __forceinline__ void operator()(const f32x4 (&acc)[2][2][4][2], const Unit& u, int wr, int wc, int fr, int fq) const {
        const int row0 = u.pm * BM + wr * 64 + fr; const int col0 = u.pn * BM + wc * 32 + 8 * fq;
#pragma unroll
        for (int ai = 0; ai < 2; ++ai)
#pragma unroll
            for (int m = 0; m < 4; ++m) { bf16_t* rowp = O + (size_t)(row0 + ai * HALF + m * 16) * ldc + col0;
#pragma unroll
                for (int bj = 0; bj < 2; ++bj) { f32x4 v0 = acc[ai][bj][m][0], v1 = acc[ai][bj][m][1];
                    if (ACT == 2) {
#pragma unroll
                        for (int e = 0; e < 4; ++e) { const float a = fmaxf(v0[e], 0.f), b = fmaxf(v1[e], 0.f); v0[e] = a * a; v1[e] = b * b; } }
                    u32x4 w; w.x = cvt_pk_bf16(v0[0], v0[1]); w.y = cvt_pk_bf16(v0[2], v0[3]); w.z = cvt_pk_bf16(v1[0], v1[1]); w.w = cvt_pk_bf16(v1[2], v1[3]);
                    *(u32x4*)(rowp + bj * HALF) = w; } }
    }
};

struct EpiResGate {
    static constexpr bool PERM = false, AFTER_DRAIN = false;
    const float* base; float* out; int ldc; const float* gate; int gate_stride; int tiles_per_batch;
    __device__ __forceinline__ void operator()(const f32x4 (&acc)[2][2][4][2], const Unit& u, int wr, int wc, int fr, int fq) const {
        const int col0 = u.pn * BM + wc * 32 + 4 * fq;
        const float* g = gate + (size_t)(u.pm / tiles_per_batch) * gate_stride + col0;
        f32x4 gv[2][2];
#pragma unroll
        for (int bj = 0; bj < 2; ++bj)
#pragma unroll
            for (int n = 0; n < 2; ++n) gv[bj][n] = *(const f32x4*)(g + bj * HALF + n * 16);
#pragma unroll
        for (int ai = 0; ai < 2; ++ai)
#pragma unroll
            for (int m = 0; m < 4; ++m) { const size_t off = (size_t)(u.pm * BM + ai * HALF + wr * 64 + m * 16 + fr) * ldc + col0;
#pragma unroll
                for (int bj = 0; bj < 2; ++bj)
#pragma unroll
                    for (int n = 0; n < 2; ++n) { const f32x4 bs = *(const f32x4*)(base + off + bj * HALF + n * 16); const f32x4 o = bs + gv[bj][n] * acc[ai][bj][m][n];
                        *(f32x4*)(out + off + bj * HALF + n * 16) = o; }
                if (m & 1) asm volatile("" ::: "memory"); }
    }
};
template <class Epi, class Sched, bool ALIGN_EPI = false, bool SP2 = false>
__device__ __forceinline__ void gemm_phase(PG8_LAS unsigned char* lds, const Gemm g, const Sched& S, const Epi& E) {
    const int tid = threadIdx.x, wid = __builtin_amdgcn_readfirstlane(tid >> 6), lane = tid & 63, wr = wid >> 2, wc = wid & 3, fr = lane & 15, fq = lane >> 4;
    const int K = g.K, nt = K / BK;
    unsigned voffA[2], voffB[2];
#pragma unroll
    for (int i = 0; i < 2; ++i) { int R, C; stage_rc(tid * 16 + i * 8192, R, C); const int Rb = Epi::PERM ? ((R & ~31) + perm32(R & 31)) : R;
        voffA[i] = (unsigned)(R * K + C) * 2u; voffB[i] = (unsigned)(Rb * K + C) * 2u; }
    const size_t kstep = (size_t)(BK * 2);
    const size_t hstep = (size_t)HALF * K * 2;
    const size_t tstep = 2 * hstep;
    const unsigned ldsw = (unsigned)wid * 1024u;
    const int aoff = lds_byte(wr * 64 + fr, fq * 8), boff = lds_byte(wc * 32 + fr, fq * 8);
#define PG8_SA(b, h) (((b) * 2 + (h)) * HTB)
#define PG8_SB(b, h) ((4 + (b) * 2 + (h)) * HTB)
#define PG8_STAGE(bufoff, gbase, voff) do { _Pragma("unroll") for (int _i = 0; _i < 2; ++_i) \
        __builtin_amdgcn_global_load_lds((const unsigned*)((const char*)(gbase) + (voff)[_i]), (PG8_LAS unsigned*)(lds + (bufoff) + ldsw + _i * 8192), 16, 0, 0); } while (0)
#define PG8_LDA(dst, b, h) do { _Pragma("unroll") for (int m = 0; m < 4; ++m) _Pragma("unroll") for (int k = 0; k < 2; ++k) dst[m][k] = *(const PG8_LAS bf16x8*)(lds + PG8_SA(b, h) + aoff + m * 2048 + k * 1024); } while (0)
#define PG8_LDB(dst, b, h) do { _Pragma("unroll") for (int n = 0; n < 2; ++n) _Pragma("unroll") for (int k = 0; k < 2; ++k) dst[n][k] = *(const PG8_LAS bf16x8*)(lds + PG8_SB(b, h) + boff + n * 2048 + k * 1024); } while (0)
#define PG8_MMA(ai, bj, At, Bt) do { __builtin_amdgcn_s_setprio(1); _Pragma("unroll") for (int m = 0; m < 4; ++m) _Pragma("unroll") for (int n = 0; n < 2; ++n) _Pragma("unroll") for (int k = 0; k < 2; ++k) \
        acc[ai][bj][m][n] = __builtin_amdgcn_mfma_f32_16x16x32_bf16(Bt[n][k], At[m][k], acc[ai][bj][m][n], 0, 0, 0); __builtin_amdgcn_s_setprio(0); } while (0)
#define PG8_WAIT_V(n) asm volatile("s_waitcnt vmcnt(" #n ")" ::: "memory")
#define PG8_WAIT_L(n) asm volatile("s_waitcnt lgkmcnt(" #n ")" ::: "memory")
#define PG8_BAR __builtin_amdgcn_s_barrier()
#define PG8_SCHED __builtin_amdgcn_sched_barrier(0)
    Unit cur, nxt; int ui = 0;
    if (!S.next(0, cur)) return;
    f32x4 acc[2][2][4][2];
#pragma unroll
    for (int a = 0; a < 2; ++a)
#pragma unroll
        for (int b = 0; b < 2; ++b)
#pragma unroll
            for (int m = 0; m < 4; ++m)
#pragma unroll
                for (int n = 0; n < 2; ++n) acc[a][b][m][n] = (f32x4){0.f, 0.f, 0.f, 0.f};
    bf16x8 At[4][2], B0[2][2], B1[2][2];
    const char* cA = (const char*)g.A + (size_t)cur.pm * tstep; const char* cB = (const char*)g.Bt + (size_t)cur.pn * tstep;
    S.a_ready(cur);
    if constexpr (SP2) {
        PG8_STAGE(PG8_SB(0, 0), cB, voffB); PG8_STAGE(PG8_SB(0, 1), cB + hstep, voffB); PG8_STAGE(PG8_SA(0, 0), cA, voffA); PG8_STAGE(PG8_SA(0, 1), cA + hstep, voffA);
        if (wr == 1) PG8_BAR;
        PG8_WAIT_V(2); PG8_BAR;
        PG8_STAGE(PG8_SB(1, 0), cB + kstep, voffB); PG8_STAGE(PG8_SA(1, 0), cA + kstep, voffA); PG8_STAGE(PG8_SB(1, 1), cB + hstep + kstep, voffB);
        PG8_WAIT_V(6); PG8_BAR;
    } else {
        PG8_STAGE(PG8_SB(0, 0), cB, voffB); PG8_STAGE(PG8_SA(0, 0), cA, voffA); PG8_STAGE(PG8_SB(0, 1), cB + hstep, voffB); PG8_STAGE(PG8_SA(0, 1), cA + hstep, voffA);
        if (wr == 1) PG8_BAR;
        PG8_WAIT_V(4); PG8_BAR;
        PG8_STAGE(PG8_SB(1, 0), cB + kstep, voffB); PG8_STAGE(PG8_SA(1, 0), cA + kstep, voffA); PG8_STAGE(PG8_SB(1, 1), cB + hstep + kstep, voffB);
        PG8_WAIT_V(6); PG8_BAR;
    }
    for (;;) {
        const bool has_next = S.next(ui + 1, nxt);
        const char* nA = has_next ? (const char*)g.A + (size_t)nxt.pm * tstep : cA; const char* nB = has_next ? (const char*)g.Bt + (size_t)nxt.pn * tstep : cB;
        for (int t = 0; t < nt; t += 2) {
            const bool last = (t == nt - 2);
            const char* a1 = cA + (size_t)(t + 1) * kstep;
            const char* a2 = last ? nA : cA + (size_t)(t + 2) * kstep; const char* b2 = last ? nB : cB + (size_t)(t + 2) * kstep;
            const char* a3 = a2 + kstep; const char* b3 = b2 + kstep;
            if (last && has_next) S.a_ready(nxt);
            if constexpr (SP2) {
            PG8_LDB(B0, 0, 0); PG8_LDB(B1, 0, 1); PG8_SCHED; PG8_LDA(At, 0, 0); PG8_STAGE(PG8_SA(1, 1), a1 + hstep, voffA);
            PG8_WAIT_V(8); PG8_WAIT_L(0); PG8_BAR; PG8_MMA(0, 0, At, B0); PG8_MMA(0, 1, At, B1); PG8_BAR; PG8_SCHED;
            PG8_LDA(At, 0, 1); PG8_STAGE(PG8_SB(0, 0), b2, voffB); PG8_STAGE(PG8_SB(0, 1), b2 + hstep, voffB); PG8_STAGE(PG8_SA(0, 0), a2, voffA);
            PG8_WAIT_V(8); PG8_WAIT_L(0); PG8_BAR; PG8_MMA(1, 0, At, B0); PG8_MMA(1, 1, At, B1); PG8_BAR; PG8_SCHED;
            PG8_LDB(B0, 1, 0); PG8_LDB(B1, 1, 1); PG8_SCHED; PG8_LDA(At, 1, 0); PG8_STAGE(PG8_SA(0, 1), a2 + hstep, voffA);
            PG8_WAIT_V(8); PG8_WAIT_L(0); PG8_BAR; PG8_MMA(0, 0, At, B0); PG8_MMA(0, 1, At, B1); PG8_BAR; PG8_SCHED;
            PG8_LDA(At, 1, 1); PG8_STAGE(PG8_SB(1, 0), b3, voffB); PG8_STAGE(PG8_SB(1, 1), b3 + hstep, voffB); PG8_STAGE(PG8_SA(1, 0), a3, voffA);
            PG8_WAIT_V(8); PG8_WAIT_L(0); PG8_BAR; PG8_MMA(1, 0, At, B0); PG8_MMA(1, 1, At, B1); PG8_BAR; PG8_SCHED;
            } else {
            PG8_LDB(B0, 0, 0); PG8_SCHED; PG8_LDA(At, 0, 0); PG8_STAGE(PG8_SA(1, 1), a1 + hstep, voffA);
            PG8_WAIT_L(8); PG8_BAR; PG8_WAIT_L(0); PG8_MMA(0, 0, At, B0); PG8_BAR; PG8_SCHED;
            PG8_LDB(B1, 0, 1); PG8_STAGE(PG8_SB(0, 0), b2, voffB);
            PG8_BAR; PG8_WAIT_L(0); PG8_MMA(0, 1, At, B1); PG8_BAR;
            PG8_LDA(At, 0, 1); PG8_STAGE(PG8_SA(0, 0), a2, voffA);
            PG8_BAR; PG8_WAIT_L(0); PG8_MMA(1, 0, At, B0); PG8_BAR; PG8_SCHED;
            PG8_STAGE(PG8_SB(0, 1), b2 + hstep, voffB);
            PG8_WAIT_V(6); PG8_BAR; PG8_MMA(1, 1, At, B1); PG8_BAR;
            PG8_LDB(B0, 1, 0); PG8_SCHED; PG8_LDA(At, 1, 0); PG8_STAGE(PG8_SA(0, 1), a2 + hstep, voffA);
            PG8_WAIT_L(8); PG8_BAR; PG8_WAIT_L(0); PG8_MMA(0, 0, At, B0); PG8_BAR; PG8_SCHED;
            PG8_LDB(B1, 1, 1); PG8_STAGE(PG8_SB(1, 0), b3, voffB);
            PG8_BAR; PG8_WAIT_L(0); PG8_MMA(0, 1, At, B1); PG8_BAR;
            PG8_LDA(At, 1, 1); PG8_STAGE(PG8_SA(1, 0), a3, voffA);
            PG8_BAR; PG8_WAIT_L(0); PG8_MMA(1, 0, At, B0); PG8_BAR; PG8_SCHED;
            PG8_STAGE(PG8_SB(1, 1), b3 + hstep, voffB);
            PG8_WAIT_V(6); PG8_BAR; PG8_MMA(1, 1, At, B1); PG8_BAR;
            }
        }
        if constexpr (ALIGN_EPI) { if (wr == 0) PG8_BAR; }
        if constexpr (!Epi::AFTER_DRAIN) { E(acc, cur, wr, wc, fr, fq); S.done(cur); }
        if (!has_next) break;
#pragma unroll
        for (int a = 0; a < 2; ++a)
#pragma unroll
            for (int b = 0; b < 2; ++b)
#pragma unroll
                for (int m = 0; m < 4; ++m)
#pragma unroll
                    for (int n = 0; n < 2; ++n) acc[a][b][m][n] = (f32x4){0.f, 0.f, 0.f, 0.f};
        cur = nxt; cA = nA; cB = nB; ++ui;
        if constexpr (ALIGN_EPI) { if (wr == 1) PG8_BAR; }
    }
    PG8_WAIT_V(0);
    if constexpr (!ALIGN_EPI) { if (wr == 0) PG8_BAR; }
    PG8_BAR;
    if constexpr (Epi::AFTER_DRAIN) { E.fused(acc, cur, wr, wc, fr, fq, lds, wid, lane); S.done(cur); }
#undef PG8_SA
#undef PG8_SB
#undef PG8_STAGE
#undef PG8_LDA
#undef PG8_LDB
#undef PG8_MMA
#undef PG8_WAIT_V
#undef PG8_WAIT_L
#undef PG8_BAR
#undef PG8_SCHED
}
}
#ifndef PG8_SP2
#define PG8_SP2 true
#endif
#ifndef PG8_ALIGN
#define PG8_ALIGN true
#endif
#include <hip/hip_bf16.h>
#include <cmath>
namespace attn_body {
using bf16=__hip_bfloat16;
using bf16x8=__attribute__((ext_vector_type(8)))short;
using s16x4=__attribute__((ext_vector_type(4)))short;
using f32x16=__attribute__((ext_vector_type(16)))float;
using u32x4=__attribute__((ext_vector_type(4)))unsigned;
using f32x4=__attribute__((ext_vector_type(4)))float;
constexpr int BATCH=32,NHEAD=8,SEQ=2048,D=64,DM=4096,ODM=1024;
constexpr int NW=8,QBLK=32,QB=QBLK*NW,KVBLK=64,NQB=SEQ/QB;
constexpr int ATTN_UNIT_ROWS=QB;
__device__ __forceinline__ int crow(int r,int hi){return (r&3)+8*(r>>2)+4*hi;}
#define SBAR() __builtin_amdgcn_sched_barrier(0)
__device__ __forceinline__ void cmask(f32x16&p0,f32x16&p1,int jb,int qrel,int hi){
  const float NEG=-INFINITY; int kb=64*jb+4*hi;
  #pragma unroll
  for(int r=0;r<16;++r){int kv=kb+(r&3)+8*(r>>2); if(kv>qrel)p0[r]=NEG; if(kv+32>qrel)p1[r]=NEG;}
}

constexpr int NSLOT=3, SLOTB=8192;
constexpr int LDS_K=0, LDS_V=NSLOT*SLOTB, LDS_WS=2*NSLOT*SLOTB, LDS_OST=LDS_WS+NW*64*4, LDS_CK=LDS_OST+NW*8192, LDS_BYTES=LDS_CK+SEQ*4;
constexpr float C2=0.125f*1.4426950408889634f;
__device__ __forceinline__ void glds16(const void*gsrc,unsigned lds_dst){unsigned keep;
  asm volatile("s_mov_b32 %0, m0\n\ts_mov_b32 m0, %2\n\ts_nop 0\n\tglobal_load_lds_dwordx4 %1, off\n\ts_mov_b32 m0, %0":"=&s"(keep):"v"(gsrc),"s"(lds_dst):"memory");}
__device__ __forceinline__ float max3f(float a,float b,float c){float r;asm("v_max3_f32 %0, %1, %2, %3":"=v"(r):"v"(a),"v"(b),"v"(c));return r;}
__device__ __forceinline__ float max2f(float a,float b){float r;asm("v_max_f32_e32 %0, %1, %2":"=v"(r):"v"(a),"v"(b));return r;}
__device__ __forceinline__ float fadd_s(float a,float b){float r;asm("v_add_f32_e32 %0, %1, %2":"=v"(r):"v"(a),"v"(b));return r;}
__device__ __forceinline__ float fsub_s(float a,float b){float r;asm("v_sub_f32_e32 %0, %1, %2":"=v"(r):"v"(a),"v"(b));return r;}
typedef float f32x2_t __attribute__((ext_vector_type(2))); typedef __bf16 bf16x2_t __attribute__((ext_vector_type(2)));
__device__ __forceinline__ unsigned cvtpk_s(float lo,float hi){f32x2_t v={lo,hi};bf16x2_t b=__builtin_convertvector(v,bf16x2_t);return __builtin_bit_cast(unsigned,b);}
#define WAIT_BAR(N) asm volatile("s_waitcnt vmcnt(" #N ") lgkmcnt(0)\n\ts_barrier":::"memory")

__device__ __forceinline__ void qkt(f32x16&p0,f32x16&p1,const char*Kslot,const bf16x8*qr,int r32,int hi){
  const char*kb=Kslot+hi*1024+r32*16;
  #pragma unroll
  for(int d0=0;d0<4;++d0){
    const bf16x8 b0=*reinterpret_cast<const bf16x8*>(kb+d0*2048);
    const bf16x8 b1=*reinterpret_cast<const bf16x8*>(kb+d0*2048+512);
    p0=__builtin_amdgcn_mfma_f32_32x32x16_bf16(b0,qr[d0],p0,0,0,0);p1=__builtin_amdgcn_mfma_f32_32x32x16_bf16(b1,qr[d0],p1,0,0,0);}
}
typedef __attribute__((address_space(3))) const char* lds_cptr;
typedef __attribute__((address_space(3))) char* lds_wptr;
typedef __attribute__((address_space(3))) const f32x4* lds_f4c;
typedef __attribute__((address_space(3))) f32x4* lds_f4w;
typedef __attribute__((address_space(3))) float* lds_fw;
typedef short v4i16_t __attribute__((ext_vector_type(4)));
__device__ __forceinline__ void kload8(bf16x8*kf,lds_cptr kp){
  kf[0]=*(const __attribute__((address_space(3))) bf16x8*)(kp);      kf[1]=*(const __attribute__((address_space(3))) bf16x8*)(kp+512);
  kf[2]=*(const __attribute__((address_space(3))) bf16x8*)(kp+2048); kf[3]=*(const __attribute__((address_space(3))) bf16x8*)(kp+2560);
  kf[4]=*(const __attribute__((address_space(3))) bf16x8*)(kp+4096); kf[5]=*(const __attribute__((address_space(3))) bf16x8*)(kp+4608);
  kf[6]=*(const __attribute__((address_space(3))) bf16x8*)(kp+6144); kf[7]=*(const __attribute__((address_space(3))) bf16x8*)(kp+6656);
}
__device__ __forceinline__ void kload2(bf16x8*kf,lds_cptr kp,int j){ kf[2*j]=*(const __attribute__((address_space(3))) bf16x8*)(kp+j*2048); kf[2*j+1]=*(const __attribute__((address_space(3))) bf16x8*)(kp+j*2048+512); }
__device__ __forceinline__ s16x4 vtr(lds_cptr p){ return __builtin_bit_cast(s16x4,__builtin_amdgcn_ds_read_tr16_b64_v4i16((__attribute__((address_space(3))) v4i16_t*)p)); }
__device__ __forceinline__ float rowmax(const f32x16&p0,const f32x16&p1){
  float a=max3f(p0[0],p0[1],p1[0]),b=max3f(p0[2],p0[3],p1[1]);a=max3f(a,p1[2],p1[3]);
  #pragma unroll
  for(int r=4;r<16;r+=4){a=max3f(a,p0[r],p0[r+1]);b=max3f(b,p0[r+2],p0[r+3]);a=max3f(a,p1[r],p1[r+1]);b=max3f(b,p1[r+2],p1[r+3]);}
  const float m=max2f(a,b);
  auto rr=__builtin_amdgcn_permlane32_swap(__float_as_uint(m),__float_as_uint(m),false,false);
  return max2f(__uint_as_float(rr[0]),__uint_as_float(rr[1]));
}
__device__ __forceinline__ void pv(f32x16*o,int vb,bf16x8 pa0,bf16x8 pa1,bf16x8 pa2,bf16x8 pa3){
  #pragma unroll
  for(int d0=0;d0<2;++d0){s16x4 lo[4],hi[4];
    #pragma unroll
    for(int ks=0;ks<4;++ks){
      asm volatile("ds_read_b64_tr_b16 %0,%1 offset:%c2":"=&v"(lo[ks]):"v"(vb),"i"(d0*4096+ks*1024):"memory");
      asm volatile("ds_read_b64_tr_b16 %0,%1 offset:%c2":"=&v"(hi[ks]):"v"(vb),"i"(d0*4096+ks*1024+512):"memory");}
    asm volatile("s_waitcnt lgkmcnt(0)":::"memory");SBAR();
    #define PK(k) (bf16x8){lo[k][0],lo[k][1],lo[k][2],lo[k][3],hi[k][0],hi[k][1],hi[k][2],hi[k][3]}
    o[d0]=__builtin_amdgcn_mfma_f32_32x32x16_bf16(pa0,PK(0),o[d0],0,0,0);
    o[d0]=__builtin_amdgcn_mfma_f32_32x32x16_bf16(pa1,PK(1),o[d0],0,0,0);
    o[d0]=__builtin_amdgcn_mfma_f32_32x32x16_bf16(pa2,PK(2),o[d0],0,0,0);
    o[d0]=__builtin_amdgcn_mfma_f32_32x32x16_bf16(pa3,PK(3),o[d0],0,0,0);
    #undef PK
  }
}

#ifndef ATTN_STORE16
#define ATTN_STORE16(p,v) (*(u32x4*)(p)=(v))
#endif
template<int THRL> __device__ __forceinline__ void attn_unit(int b,int h,int qb,const bf16*Q,const bf16*__restrict__ K,const bf16*__restrict__ V,const bf16*__restrict__ G,const float*__restrict__ cum2,const float*__restrict__ gain,bf16*O,char*shm){
  int tid_=threadIdx.x; asm volatile("":"+v"(tid_));
  const int tid=tid_,lane=tid&63,r32=lane&31,hi=lane>>5; const int wid=__builtin_amdgcn_readfirstlane(tid>>6);
  const long rowbase=(long)b*SEQ; const int q0=qb*QB;
  const bf16*Qw=Q+(rowbase+q0+wid*QBLK)*DM+h*D;
  const bf16*Kh=K+rowbase*DM+h*D,*Vh=V+rowbase*DM+h*D;
  const unsigned lds0=(unsigned)(uintptr_t)shm;
  float*wsf=(float*)(shm+LDS_WS)+wid*64;
  const bf16*ksrc=Kh+(long)lane*DM+wid*8;
  const bf16*vsrc=Vh+(long)(16*(wid&3)+(lane>>2))*DM+(wid>>2)*32+(lane&3)*8;
  const unsigned kdst=lds0+LDS_K+wid*1024, vdst=lds0+LDS_V+wid*1024;
  #define DMA_K(t,slot) glds16(ksrc+(long)(t)*KVBLK*DM,(unsigned)__builtin_amdgcn_readfirstlane(kdst+(slot)))
  #define DMA_V(t,slot) glds16(vsrc+(long)(t)*KVBLK*DM,(unsigned)__builtin_amdgcn_readfirstlane(vdst+(slot)))
  const int vb0=(int)(lds0+LDS_V)+((lane>>4)&1)*32+(lane&3)*8+(4*hi+((lane&15)>>2))*64;
  const char*Kbase=shm+LDS_K; bf16x8 kf[8];
  const lds_cptr shm3=(lds_cptr)shm; const lds_wptr shm3w=(lds_wptr)shm; const lds_f4c ckb=(lds_f4c)(shm3+LDS_CK)+hi; const lds_cptr kp0=shm3+LDS_K+hi*1024+r32*16; const lds_cptr vp0=shm3+LDS_V+((lane>>4)&1)*32+(lane&3)*8+(4*hi+((lane&15)>>2))*64;
  const int NT=(q0+QB)/KVBLK;
  DMA_K(0,0);DMA_V(0,0);DMA_K(1,SLOTB);
  { const float*cs=cum2+((long)(b*NHEAD+h))*SEQ; if(tid*4<q0+QB){ const f32x4 v_=*(const f32x4*)(cs+tid*4); *(lds_f4w)(shm3w+LDS_CK+tid*16)=(f32x4){-v_.x,-v_.y,-v_.z,-v_.w}; } }
  bf16x8 qr[4];
  #pragma unroll
  for(int d0=0;d0<4;++d0)qr[d0]=*reinterpret_cast<const bf16x8*>(&Qw[(long)r32*DM+d0*16+hi*8]);
  float mhat=0.f,l_reg=0.f;f32x16 o[2];o[0]=f32x16{};o[1]=f32x16{};
  const int qrel=wid*QBLK+r32;
  #define CMASK(P0,P1,t) do{int jb_=(t)-(NT-4); if(jb_>=0)cmask(P0,P1,jb_,qrel,hi);}while(0)
  bool resc=false;
  #define START(P0,P1) do{ const float rm=rowmax(P0,P1); resc=false; \
    { const float dl=rm; mhat=fadd_s(mhat,dl); \
      _Pragma("unroll") for(int r=0;r<16;++r){P0[r]=fsub_s(P0[r],dl);P1[r]=fsub_s(P1[r],dl);} \
      } \
    _Pragma("unroll") for(int r=0;r<16;++r)P0[r]=__builtin_amdgcn_exp2f(P0[r]); }while(0)
  #define RESC() do{ if(resc){ asm volatile("s_waitcnt lgkmcnt(0)":::"memory"); \
      _Pragma("unroll") for(int d_=0;d_<2;++d_) _Pragma("unroll") for(int r=0;r<16;++r)o[d_][r]*=wsf[crow(r,hi)]; } }while(0)
  f32x16 pA0,pA1,pB0,pB1;
  #define CINIT(C0,C1,t) do{ const lds_f4c cb_=ckb+(t)*16; _Pragma("unroll") for(int g_=0;g_<4;++g_){ const f32x4 a_=cb_[2*g_],b_=cb_[2*g_+8]; \
      C0[4*g_]=a_.x-mhat;C0[4*g_+1]=a_.y-mhat;C0[4*g_+2]=a_.z-mhat;C0[4*g_+3]=a_.w-mhat; C1[4*g_]=b_.x-mhat;C1[4*g_+1]=b_.y-mhat;C1[4*g_+2]=b_.z-mhat;C1[4*g_+3]=b_.w-mhat; } }while(0)
  int sl_prev=0,sl_cur=0,sl_next=SLOTB;
  #define ROT() do{sl_prev=sl_cur;sl_cur=sl_next;sl_next=(sl_next==(NSLOT-1)*SLOTB)?0:sl_next+SLOTB;}while(0)
  DMA_K(2,2*SLOTB);
  WAIT_BAR(3);
  CINIT(pA0,pA1,0); qkt(pA0,pA1,Kbase,qr,r32,hi);asm volatile("s_nop 15\n\ts_nop 7":"+v"(pA0),"+v"(pA1));CMASK(pA0,pA1,0);
  START(pA0,pA1);
  _Pragma("unroll") for(int r=0;r<16;++r)pA1[r]=__builtin_amdgcn_exp2f(pA1[r]);
  CINIT(pB0,pB1,1);
  WAIT_BAR(0);
  DMA_K(3,0);DMA_V(1,SLOTB);
  ROT();
  kload8(kf,kp0+sl_cur);
  WAIT_BAR(2);
  s16x4 vlo[8],vhi[8]; u32x4 pw0,pw1,pw2,pw3;
  #define PKW(P,B) cvtpk_s(P[B],P[B+1])
  #define PAF(k) __builtin_bit_cast(bf16x8,pw##k)
  #define VFR(i) (bf16x8){vlo[i][0],vlo[i][1],vlo[i][2],vlo[i][3],vhi[i][0],vhi[i][1],vhi[i][2],vhi[i][3]}
  #define PIN(x) asm volatile("":"+v"(x))
  #define MX3(a,b,c) __builtin_fmaxf(__builtin_fmaxf((a),(b)),(c))
  #define GAPA(MF,A0,A1,A2,A3,W0,W1,PW) do{ MF; sacc+=A0; sacc+=A1; sacc+=A2; sacc+=A3; PIN(sacc); W0; W1; PIN(PW); SBAR(); }while(0)
  #define EX(v) __builtin_amdgcn_exp2f(v)
  #define GAPB(MF,X,B,NP,NG,NXI) do{ MF; X[B]=EX(X[B]); X[B+1]=EX(X[B+1]); X[B+2]=EX(X[B+2]); X[B+3]=EX(X[B+3]); PIN(X); \
      NP[4*(NG)]=nx_.x-mhat; NP[4*(NG)+1]=nx_.y-mhat; NP[4*(NG)+2]=nx_.z-mhat; NP[4*(NG)+3]=nx_.w-mhat; PIN(NP); nx_=cbn_[NXI]; SBAR(); }while(0)
  #define VRD(i) do{ vlo[i]=vtr(vp_+(((i)>>2)*4096+((i)&3)*1024)); vhi[i]=vtr(vp_+(((i)>>2)*4096+((i)&3)*1024+512)); }while(0)
  #define KRD(G,j) do{ if(G){ kload2(kf,kp0+sl_next,j); SBAR(); } }while(0)
  #define STEP(C0,C1,P0,P1,t,GK,GV,GL) do{ SBAR(); const lds_f4c cbn_=ckb+((t)+1)*16; \
    const lds_cptr vp_=vp0+sl_prev; \
    VRD(0); SBAR(); float sacc=(P0[0]+P0[1]); \
    GAPA(C0=__builtin_amdgcn_mfma_f32_32x32x16_bf16(kf[0],qr[0],C0,0,0,0), P0[2],P0[3],P0[4],P0[5],     pw0[0]=PKW(P0,0), pw0[1]=PKW(P0,2), pw0); \
    VRD(4); SBAR(); GAPA(C1=__builtin_amdgcn_mfma_f32_32x32x16_bf16(kf[1],qr[0],C1,0,0,0), P0[6],P0[7],P0[8],P0[9],     pw0[2]=PKW(P0,4), pw0[3]=PKW(P0,6), pw0); \
    VRD(1); SBAR(); GAPA(C0=__builtin_amdgcn_mfma_f32_32x32x16_bf16(kf[2],qr[1],C0,0,0,0),   P0[10],P0[11],P0[12],P0[13], pw1[0]=PKW(P0,8), pw1[1]=PKW(P0,10), pw1); \
    VRD(5); SBAR(); GAPA(C1=__builtin_amdgcn_mfma_f32_32x32x16_bf16(kf[3],qr[1],C1,0,0,0),   P0[14],P0[15],P1[0],P1[1],   pw1[2]=PKW(P0,12),pw1[3]=PKW(P0,14), pw1); \
    VRD(2); SBAR(); GAPA(C0=__builtin_amdgcn_mfma_f32_32x32x16_bf16(kf[4],qr[2],C0,0,0,0),   P1[2],P1[3],P1[4],P1[5],     pw2[0]=PKW(P1,0), pw2[1]=PKW(P1,2), pw2); \
    VRD(6); SBAR(); GAPA(C1=__builtin_amdgcn_mfma_f32_32x32x16_bf16(kf[5],qr[2],C1,0,0,0),   P1[6],P1[7],P1[8],P1[9],     pw2[2]=PKW(P1,4), pw2[3]=PKW(P1,6), pw2); \
    VRD(3); SBAR(); GAPA(C0=__builtin_amdgcn_mfma_f32_32x32x16_bf16(kf[6],qr[3],C0,0,0,0),   P1[10],P1[11],P1[12],P1[13], pw3[0]=PKW(P1,8), pw3[1]=PKW(P1,10), pw3); \
    VRD(7); SBAR(); GAPA(C1=__builtin_amdgcn_mfma_f32_32x32x16_bf16(kf[7],qr[3],C1,0,0,0),   P1[14],P1[15],0.f,0.f,       pw3[2]=PKW(P1,12),pw3[3]=PKW(P1,14), pw3); \
    l_reg+=sacc; \
    if(GK){DMA_K((t)+3,sl_cur);} if(GV){DMA_V((t)+1,sl_next);} \
    CMASK(C0,C1,t); \
    { float a=MX3(C0[0],C0[1],C1[0]),b=MX3(C0[2],C0[3],C1[1]); a=MX3(a,C1[2],C1[3]); \
      _Pragma("unroll") for(int r=4;r<16;r+=4){a=MX3(a,C0[r],C0[r+1]);b=MX3(b,C0[r+2],C0[r+3]);a=MX3(a,C1[r],C1[r+1]);b=MX3(b,C1[r+2],C1[r+3]);} \
      float rm=__builtin_fmaxf(a,b); { auto rr=__builtin_amdgcn_permlane32_swap(__float_as_uint(rm),__float_as_uint(rm),false,false); rm=__builtin_fmaxf(__uint_as_float(rr[0]),__uint_as_float(rr[1])); } \
      resc=false; \
      if(__builtin_expect(__any(rm>(float)THRL),1)){ const float dl=__builtin_fmaxf(rm,0.f); mhat+=dl; \
        _Pragma("unroll") for(int r=0;r<16;++r){C0[r]-=dl;C1[r]-=dl;} \
        const float f=__builtin_amdgcn_exp2f(-dl); l_reg*=f; if(hi==0)wsf[r32]=f; resc=true; } } \
    f32x4 nx_=cbn_[0]; SBAR(); \
    GAPB(o[0]=__builtin_amdgcn_mfma_f32_32x32x16_bf16(PAF(0),VFR(0),o[0],0,0,0), C0,0, P0,0,2); \
    GAPB(o[1]=__builtin_amdgcn_mfma_f32_32x32x16_bf16(PAF(0),VFR(4),o[1],0,0,0), C0,4, P0,1,4); \
    KRD(GL,0); GAPB(o[0]=__builtin_amdgcn_mfma_f32_32x32x16_bf16(PAF(1),VFR(1),o[0],0,0,0), C0,8, P0,2,6); \
    KRD(GL,1); GAPB(o[1]=__builtin_amdgcn_mfma_f32_32x32x16_bf16(PAF(1),VFR(5),o[1],0,0,0), C0,12, P0,3,8); \
    KRD(GL,2); GAPB(o[0]=__builtin_amdgcn_mfma_f32_32x32x16_bf16(PAF(2),VFR(2),o[0],0,0,0), C1,0, P1,0,10); \
    KRD(GL,3); GAPB(o[1]=__builtin_amdgcn_mfma_f32_32x32x16_bf16(PAF(2),VFR(6),o[1],0,0,0), C1,4, P1,1,12); \
    GAPB(o[0]=__builtin_amdgcn_mfma_f32_32x32x16_bf16(PAF(3),VFR(3),o[0],0,0,0), C1,8, P1,2,14); \
    GAPB(o[1]=__builtin_amdgcn_mfma_f32_32x32x16_bf16(PAF(3),VFR(7),o[1],0,0,0), C1,12, P1,3,14); \
    }while(0)
  int t=1;
  #undef CMASK
  #define CMASK(P0,P1,t) do{}while(0)
  for(;t+5<NT;t+=2){
    STEP(pB0,pB1,pA0,pA1,t,true,true,true);     WAIT_BAR(2); RESC(); ROT();
    STEP(pA0,pA1,pB0,pB1,t+1,true,true,true);   WAIT_BAR(2); RESC(); ROT();
  }
  #undef CMASK
  #define CMASK(P0,P1,t) do{int jb_=(t)-(NT-4); if(jb_>=0)cmask(P0,P1,jb_,qrel,hi);}while(0)
  #define ENDW(tt) do{ if((tt)+3<NT){WAIT_BAR(2);} else if((tt)+2<NT){WAIT_BAR(1);} else {WAIT_BAR(0);} }while(0)
  for(;t+1<NT;t+=2){
    STEP(pB0,pB1,pA0,pA1,t,(t+3<NT),(t+1<NT),(t+1<NT));       ENDW(t);   RESC(); ROT();
    STEP(pA0,pA1,pB0,pB1,t+1,(t+4<NT),(t+2<NT),(t+2<NT));     ENDW(t+1); RESC(); ROT();
  }
  STEP(pB0,pB1,pA0,pA1,NT-1,false,false,false); RESC();
  { float sacc=pB0[0]+pB0[1]; _Pragma("unroll") for(int r=2;r<16;++r)sacc+=pB0[r]; _Pragma("unroll") for(int r=0;r<16;++r)sacc+=pB1[r]; l_reg+=sacc;
    pw0=(u32x4){PKW(pB0,0),PKW(pB0,2),PKW(pB0,4),PKW(pB0,6)};pw1=(u32x4){PKW(pB0,8),PKW(pB0,10),PKW(pB0,12),PKW(pB0,14)};pw2=(u32x4){PKW(pB1,0),PKW(pB1,2),PKW(pB1,4),PKW(pB1,6)};pw3=(u32x4){PKW(pB1,8),PKW(pB1,10),PKW(pB1,12),PKW(pB1,14)};
    SBAR(); pv(o,vb0+sl_cur,PAF(0),PAF(1),PAF(2),PAF(3)); }
  #undef PKW
  #undef PAF
  #undef VFR
  #undef PIN
  #undef MX3
  #undef GAPA
  #undef GAPB
  #undef EX
  #undef VRD
  #undef KRD
  #undef STEP
  #undef ENDW
  {auto rr=__builtin_amdgcn_permlane32_swap(__float_as_uint(l_reg),__float_as_uint(l_reg),false,false);l_reg=__uint_as_float(rr[0])+__uint_as_float(rr[1]);}
  if(hi==0)wsf[32+r32]=l_reg;asm volatile("s_waitcnt lgkmcnt(0)":::"memory");
  float rli[16];
  #pragma unroll
  for(int r=0;r<16;++r)rli[r]=__builtin_amdgcn_rcpf(wsf[32+crow(r,hi)]);
  bf16*Ow=O+(rowbase+q0+wid*QBLK)*ODM+h*D; const bf16*Gw=G+(rowbase+q0+wid*QBLK)*DM+h*D;
  { const lds_fw stg=(lds_fw)(shm3w+LDS_OST)+wid*2048;
    #pragma unroll
    for(int r=0;r<16;++r){const int orow=crow(r,hi);
      #pragma unroll
      for(int d0=0;d0<2;++d0)stg[orow*64+d0*32+r32]=o[d0][r]*rli[r];}
    asm volatile("s_waitcnt lgkmcnt(0)":::"memory");
    int le=lane; asm volatile("":"+v"(le));
    const int ch=le&7; const f32x4 g0=*(const f32x4*)(gain+h*D+ch*8), g1=*(const f32x4*)(gain+h*D+ch*8+4);
    #pragma unroll
    for(int i=0;i<4;++i){const int row=i*8+(le>>3);
      const f32x4 a=*(lds_f4c)(stg+row*64+ch*8), c=*(lds_f4c)(stg+row*64+ch*8+4);
      const u32x4 gw=*(const u32x4*)(Gw+(long)row*DM+ch*8);
      float ss=(a.x*a.x+a.y*a.y)+(a.z*a.z+a.w*a.w)+(c.x*c.x+c.y*c.y)+(c.z*c.z+c.w*c.w);
      ss+=__shfl_xor(ss,1);ss+=__shfl_xor(ss,2);ss+=__shfl_xor(ss,4);
      const float rstd=__builtin_amdgcn_rsqf(ss*(1.f/64.f)+1e-6f);
      float gt[8];
      #pragma unroll
      for(int e=0;e<4;++e){ const unsigned w=gw[e]; const float lo=__uint_as_float(w<<16), hi_=__uint_as_float(w&0xffff0000u);
        gt[2*e]=__builtin_amdgcn_rcpf(1.f+__builtin_amdgcn_exp2f(-1.4426950408889634f*lo)); gt[2*e+1]=__builtin_amdgcn_rcpf(1.f+__builtin_amdgcn_exp2f(-1.4426950408889634f*hi_)); }
      u32x4 v; v.x=cvtpk_s(a.x*rstd*g0.x*gt[0],a.y*rstd*g0.y*gt[1]); v.y=cvtpk_s(a.z*rstd*g0.z*gt[2],a.w*rstd*g0.w*gt[3]);
      v.z=cvtpk_s(c.x*rstd*g1.x*gt[4],c.y*rstd*g1.y*gt[5]); v.w=cvtpk_s(c.z*rstd*g1.z*gt[6],c.w*rstd*g1.w*gt[7]);
      ATTN_STORE16(Ow+(long)row*ODM+ch*8,v);} }
  asm volatile("s_waitcnt lgkmcnt(0)\n\ts_barrier":::"memory");
  #undef DMA_K
  #undef DMA_V
  #undef CMASK
  #undef START
  #undef CINIT
  #undef RESC
  #undef ROT
}
constexpr int ATTN_LDS_BYTES=LDS_BYTES;
#undef SBAR
#undef WAIT_BAR
}

namespace ret_body {
#define RB_LAS __attribute__((address_space(3)))
typedef unsigned short bf16;
typedef short bf16x8 __attribute__((ext_vector_type(8)));
typedef short s16x4 __attribute__((ext_vector_type(4)));
typedef float f32x16 __attribute__((ext_vector_type(16)));
typedef float f32x4 __attribute__((ext_vector_type(4)));
typedef unsigned u32x4 __attribute__((ext_vector_type(4)));
typedef unsigned u32x2 __attribute__((ext_vector_type(2)));
typedef RB_LAS unsigned char* lptr;
constexpr int DM = 4096, ODM = 1024, SEQ = 2048, CH = 128;
constexpr int L_K = 0, L_V = 32768, L_T = 65536, L_STG = 98304, L_SSQ = 132096, RET_LDS_END = 133120;
__device__ __forceinline__ unsigned offb(unsigned row, unsigned ch) { return 2048u * (row >> 3) + 512u * (ch >> 2) + 64u * (row & 7u) + 16u * ((ch & 3u) ^ ((row >> 2) & 3u)); }
__device__ __forceinline__ int crow(int r, int hi) { return (r & 3) + 8 * (r >> 2) + 4 * hi; }
__device__ __forceinline__ s16x4 trr(lptr p) { typedef short v4i16_t __attribute__((ext_vector_type(4))); return __builtin_bit_cast(s16x4, __builtin_amdgcn_ds_read_tr16_b64_v4i16((RB_LAS v4i16_t*)p)); }
typedef float f32x2_t __attribute__((ext_vector_type(2))); typedef __bf16 bf16x2_t __attribute__((ext_vector_type(2)));
__device__ __forceinline__ unsigned cvtpk(float lo, float hi) { f32x2_t v = {lo, hi}; bf16x2_t b = __builtin_convertvector(v, bf16x2_t); return __builtin_bit_cast(unsigned, b); }
#define RB_MFMA(a, b, c) __builtin_amdgcn_mfma_f32_32x32x16_bf16((a), (b), (c), 0, 0, 0)
#define RB_BAR() asm volatile("s_waitcnt vmcnt(0) lgkmcnt(0)\n\ts_barrier" ::: "memory")

__device__ __forceinline__ void ret_unit(int b, const bf16* __restrict__ P, int cq, int ck, int cv, int cg, const float* __restrict__ gain, bf16* __restrict__ O, float lg2, unsigned char* lds_generic) {
    int tid_ = threadIdx.x; asm volatile("" : "+v"(tid_));
    const int tid = tid_, lane = tid & 63, r32 = lane & 31, hi = lane >> 5; const int wid = __builtin_amdgcn_readfirstlane(tid >> 6);
    const int qw = (wid < 4) ? wid : 7 - wid, dvh = wid >> 2, dkq = wid & 3;
    const lptr L = (lptr)lds_generic;
    const float gC = exp2f(128.f * lg2);
    const size_t rowbase = (size_t)b * SEQ;
    const unsigned blk = (lane >> 4) & 1, q4 = (lane & 15) >> 2, p4 = lane & 3;
    const unsigned Y = (r32 >> 2) & 3u, rbase = 2048u * (r32 >> 3) + 64u * (r32 & 7u);
    const unsigned rd_e = rbase + 16u * ((unsigned)hi ^ Y), rd_o = rbase + 16u * ((2u + hi) ^ Y);
    const unsigned xc = 2u * blk + (p4 >> 1);
    const unsigned tn0 = 2048u * hi + 64u * q4 + 16u * (xc ^ (2u * hi)) + 8u * (p4 & 1), tn1 = 2048u * hi + 256u + 64u * q4 + 16u * (xc ^ (2u * hi + 1u)) + 8u * (p4 & 1);
    const unsigned tp0 = 256u * hi + 64u * q4 + 16u * (xc ^ (unsigned)hi) + 8u * (p4 & 1), tp1 = 2048u + 256u * hi + 64u * q4 + 16u * (xc ^ (2u + hi)) + 8u * (p4 & 1);
    const unsigned aT_e = L_T + 16384u * dvh + rd_e, aT_o = L_T + 16384u * dvh + rd_o, aK_e = L_K + rd_e, aK_o = L_K + rd_o;
    const unsigned aVp0 = L_V + 1024u * dvh + tp0, aVp1 = L_V + 1024u * dvh + tp1, aVn0 = L_V + 1024u * dvh + tn0, aVn1 = L_V + 1024u * dvh + tn1, aKn0 = L_K + 512u * dkq + tn0, aKn1 = L_K + 512u * dkq + tn1;
    unsigned wg[4];
#pragma unroll
    for (int g = 0; g < 4; ++g) wg[g] = rbase + 16u * ((unsigned)g ^ Y) + 8u * hi;
    for (int i = tid; i < 2048; i += 512) *(RB_LAS u32x4*)(L + L_T + 16 * i) = (u32x4){0u, 0u, 0u, 0u};
    f32x16 t0, t1;
#pragma unroll
    for (int r = 0; r < 16; ++r) { t0[r] = 0.f; t1[r] = 0.f; }
    u32x4 kpre[4], vpre[4];
#define RB_LOADKV(c) do { _Pragma("unroll") for (int i_ = 0; i_ < 4; ++i_) { const int id_ = tid + 512 * i_; const size_t g_ = (rowbase + (size_t)(c) * CH + (id_ >> 4)) * DM + (id_ & 15) * 8; \
        kpre[i_] = *(const u32x4*)(P + g_ + ck); vpre[i_] = *(const u32x4*)(P + g_ + cv); } } while (0)
#define RB_STOREKV() do { _Pragma("unroll") for (int i_ = 0; i_ < 4; ++i_) { const int id_ = tid + 512 * i_; const unsigned o_ = offb(id_ >> 4, id_ & 15); \
        *(RB_LAS u32x4*)(L + L_K + o_) = kpre[i_]; *(RB_LAS u32x4*)(L + L_V + o_) = vpre[i_]; } } while (0)
    RB_LOADKV(0); RB_STOREKV();
    bf16x8 qf[8];
#define RB_LOADQ(c) do { const bf16* q_ = P + (rowbase + (size_t)(c) * CH + 32 * qw + r32) * DM + cq + 8 * hi; _Pragma("unroll") for (int s_ = 0; s_ < 8; ++s_) qf[s_] = *(const bf16x8*)(q_ + 16 * s_); } while (0)
    RB_LOADQ(0);
    RB_BAR();
    for (int c = 0; c < 16; ++c) {
        if (c + 1 < 16) RB_LOADKV(c + 1);
        u32x2 gt[2][4];
        { const bf16* g_ = P + (rowbase + (size_t)c * CH + 32 * qw + r32) * DM + cg + 64 * dvh + 4 * hi;
#pragma unroll
          for (int cc = 0; cc < 2; ++cc)
#pragma unroll
              for (int g = 0; g < 4; ++g) gt[cc][g] = *(const u32x2*)(g_ + 32 * cc + 8 * g); }
        f32x16 o0, o1;
#pragma unroll
        for (int r = 0; r < 16; ++r) { o0[r] = 0.f; o1[r] = 0.f; }
#pragma unroll
        for (int s = 0; s < 8; ++s) {
            const bf16x8 a0 = *(const RB_LAS bf16x8*)(L + ((s & 1) ? aT_o : aT_e) + 512 * (s >> 1));
            const bf16x8 a1 = *(const RB_LAS bf16x8*)(L + ((s & 1) ? aT_o : aT_e) + 8192 + 512 * (s >> 1));
            o0 = RB_MFMA(a0, qf[s], o0); o1 = RB_MFMA(a1, qf[s], o1);
        }
#pragma unroll
        for (int kb = 0; kb < 4; ++kb) if (kb <= qw) {
            f32x16 p;
#pragma unroll
            for (int r = 0; r < 16; ++r) p[r] = 0.f;
#pragma unroll
            for (int s = 0; s < 8; ++s) { const bf16x8 kf = *(const RB_LAS bf16x8*)(L + ((s & 1) ? aK_o : aK_e) + 8192 * kb + 512 * (s >> 1)); p = RB_MFMA(kf, qf[s], p); }
            if (kb == qw) {
#pragma unroll
                for (int r = 0; r < 16; ++r) if (crow(r, hi) > r32) p[r] = 0.f;
            }
            u32x4 pw0, pw1;
            pw0.x = cvtpk(p[0], p[1]); pw0.y = cvtpk(p[2], p[3]); pw0.z = cvtpk(p[4], p[5]); pw0.w = cvtpk(p[6], p[7]);
            pw1.x = cvtpk(p[8], p[9]); pw1.y = cvtpk(p[10], p[11]); pw1.z = cvtpk(p[12], p[13]); pw1.w = cvtpk(p[14], p[15]);
            const bf16x8 pf0 = __builtin_bit_cast(bf16x8, pw0), pf1 = __builtin_bit_cast(bf16x8, pw1);
#pragma unroll
            for (int s = 0; s < 2; ++s) {
#pragma unroll
                for (int cc = 0; cc < 2; ++cc) {
                    const s16x4 lo = trr(L + aVp0 + 4096 * (2 * kb + s) + 512 * cc), hh = trr(L + aVp1 + 4096 * (2 * kb + s) + 512 * cc);
                    const bf16x8 vf = (bf16x8){lo[0], lo[1], lo[2], lo[3], hh[0], hh[1], hh[2], hh[3]};
                    if (cc == 0) o0 = RB_MFMA(vf, s == 0 ? pf0 : pf1, o0); else o1 = RB_MFMA(vf, s == 0 ? pf0 : pf1, o1);
                }
            }
        }
        if (c + 1 < 16) RB_LOADQ(c + 1);
        { float ss = 0.f;
#pragma unroll
          for (int r = 0; r < 16; ++r) ss += o0[r] * o0[r] + o1[r] * o1[r];
          auto rr = __builtin_amdgcn_permlane32_swap(__float_as_uint(ss), __float_as_uint(ss), false, false);
          ss = __uint_as_float(rr[0]) + __uint_as_float(rr[1]);
          if (hi == 0) *(RB_LAS float*)(L + L_SSQ + 4 * (128 * dvh + 32 * qw + r32)) = ss; }
#pragma unroll
        for (int ks = 0; ks < 8; ++ks) {
            const s16x4 klo = trr(L + aKn0 + 4096 * ks), khh = trr(L + aKn1 + 4096 * ks);
            const bf16x8 kf = (bf16x8){klo[0], klo[1], klo[2], klo[3], khh[0], khh[1], khh[2], khh[3]};
#pragma unroll
            for (int cc = 0; cc < 2; ++cc) {
                const s16x4 lo = trr(L + aVn0 + 4096 * ks + 512 * cc), hh = trr(L + aVn1 + 4096 * ks + 512 * cc);
                const bf16x8 vf = (bf16x8){lo[0], lo[1], lo[2], lo[3], hh[0], hh[1], hh[2], hh[3]};
                if (cc == 0) t0 = RB_MFMA(kf, vf, t0); else t1 = RB_MFMA(kf, vf, t1);
            }
        }
#pragma unroll
        for (int r = 0; r < 16; ++r) { t0[r] *= gC; t1[r] *= gC; }
        RB_BAR();
        { const float ssum = *(const RB_LAS float*)(L + L_SSQ + 4 * (32 * qw + r32)) + *(const RB_LAS float*)(L + L_SSQ + 4 * (128 + 32 * qw + r32));
          const float gn = exp2f((float)(32 * qw + r32) * lg2);
          const float rs = gn * rsqrtf(gn * gn * ssum * (1.f / 128.f) + 1e-6f);
#pragma unroll
          for (int cc = 0; cc < 2; ++cc)
#pragma unroll
              for (int g = 0; g < 4; ++g) {
                  const int dv0 = 64 * dvh + 32 * cc + 8 * g + 4 * hi;
                  const f32x4 gn4 = *(const f32x4*)(gain + dv0);
                  const unsigned w0 = gt[cc][g].x, w1 = gt[cc][g].y;
                  const float z0 = __uint_as_float(w0 << 16), z1 = __uint_as_float(w0 & 0xffff0000u), z2 = __uint_as_float(w1 << 16), z3 = __uint_as_float(w1 & 0xffff0000u);
                  const float s0 = z0 * __builtin_amdgcn_rcpf(1.f + __builtin_amdgcn_exp2f(-1.4426950408889634f * z0)), s1 = z1 * __builtin_amdgcn_rcpf(1.f + __builtin_amdgcn_exp2f(-1.4426950408889634f * z1));
                  const float s2 = z2 * __builtin_amdgcn_rcpf(1.f + __builtin_amdgcn_exp2f(-1.4426950408889634f * z2)), s3 = z3 * __builtin_amdgcn_rcpf(1.f + __builtin_amdgcn_exp2f(-1.4426950408889634f * z3));
                  const f32x16& oo = cc == 0 ? o0 : o1;
                  u32x2 w; w.x = cvtpk(oo[4 * g] * rs * gn4.x * s0, oo[4 * g + 1] * rs * gn4.y * s1); w.y = cvtpk(oo[4 * g + 2] * rs * gn4.z * s2, oo[4 * g + 3] * rs * gn4.w * s3);
                  *(RB_LAS u32x2*)(L + L_STG + 8192 * qw + 1024 * dvh + 512 * cc + wg[g]) = w;
              } }
#pragma unroll
        for (int cc = 0; cc < 2; ++cc)
#pragma unroll
            for (int g = 0; g < 4; ++g) { const f32x16& tt = cc == 0 ? t0 : t1;
                u32x2 w; w.x = cvtpk(tt[4 * g], tt[4 * g + 1]); w.y = cvtpk(tt[4 * g + 2], tt[4 * g + 3]);
                *(RB_LAS u32x2*)(L + L_T + 16384 * dvh + 8192 * cc + 512 * dkq + wg[g]) = w; }
        if (c + 1 < 16) RB_STOREKV();
        RB_BAR();
#pragma unroll
        for (int i = 0; i < 4; ++i) { const int id = tid + 512 * i, row = id >> 4, ch = id & 15;
            const u32x4 v = *(const RB_LAS u32x4*)(L + L_STG + offb(row, ch));
            *(u32x4*)(O + (rowbase + (size_t)c * CH + row) * ODM + ch * 8) = v; }
    }
    RB_BAR();
#undef RB_LOADKV
#undef RB_STOREKV
#undef RB_LOADQ
}
#undef RB_MFMA
#undef RB_BAR
}

constexpr int NWAVES = 8;
#ifndef MK_N_LAUNCHES
#define MK_N_LAUNCHES 1
#endif
constexpr int PER_PHASE = 9;
constexpr int N_LAUNCHES = MK_N_LAUNCHES;

constexpr int BATCH = 32, SEQ = 2048, D = 1024, M = BATCH * SEQ, FF = 4096, NPROJ = 4096, IN_COLS = 4104, NMOD = 6 * D;
constexpr float EPS = 1e-6f;
constexpr float LOG2E = 1.4426950408889634f, C2 = 0.18033688011112042f;
constexpr int C_FQ = 0, C_FK = 512, C_FV = 1024, C_FOG = 1536, C_RQ = 2048, C_RK = 2560, C_RV = 3072, C_RG = 3584;
constexpr int MOD_SHIFT_M = 0, MOD_SCALE_M = 1024, MOD_GATE_M = 2048, MOD_SHIFT_F = 3072, MOD_SCALE_F = 4096, MOD_GATE_F = 5120;

constexpr size_t MiB = 1u << 20;
constexpr size_t WS_CTL = 0, CTL_ZERO_BYTES = 2 * MiB;
constexpr size_t WS_MOD = 1 * MiB;
constexpr size_t WS_WIN = 2 * MiB, WS_WOUT = 10 * MiB, WS_W1 = 12 * MiB, WS_W2 = 20 * MiB;
constexpr size_t WS_WF = 28 * MiB;
constexpr size_t WS_ROPE = 29 * MiB;
constexpr size_t WS_LOGF = 30 * MiB, WS_CUM = 32 * MiB;
constexpr size_t WS_H = 64 * MiB, WS_MIX = 192 * MiB, WS_PROJ = 320 * MiB, WS_U = 320 * MiB, WS_END = 832 * MiB;
constexpr int CW_BAR = 4096;

constexpr int RING_OFF = 0, RING_BYTES = 131072;
constexpr int LDSCTL_OFF = RING_BYTES, MISC_OFF = LDSCTL_OFF + 320;
constexpr int LDS_BYTES = 147456;
#define GAS __attribute__((address_space(1)))
#define LAS __attribute__((address_space(3)))
typedef unsigned short bf16;
typedef unsigned v4u __attribute__((ext_vector_type(4)));
typedef float f32x4 __attribute__((ext_vector_type(4)));
typedef short bf16x8 __attribute__((ext_vector_type(8)));
typedef GAS unsigned gu32;
typedef GAS unsigned long long gu64;
#define RLX_AGENT __ATOMIC_RELAXED, __HIP_MEMORY_SCOPE_AGENT
#define LDS_WAIT() asm volatile("s_waitcnt lgkmcnt(0)" ::: "memory")
#define VM_WAIT() asm volatile("s_waitcnt vmcnt(0)" ::: "memory")
__device__ __forceinline__ unsigned long long rt() { return __builtin_amdgcn_s_memrealtime(); }
__device__ __forceinline__ unsigned f2bf(float f) { unsigned u = __builtin_bit_cast(unsigned, f); return (u + 0x7fffu + ((u >> 16) & 1u)) >> 16; }
__device__ __forceinline__ unsigned pk2(float lo, float hi) { return f2bf(lo) | (f2bf(hi) << 16); }

#define XB_TMO      128
#define XB_XCNT(j)  (256  + 64 * (j))
#define XB_XSUB(j)  (1280 + 64 * (j))
#define XB_XGEN(j)  (2304 + 64 * (j))
#define XB_TOP      3328
#define XB_TOPGEN   3392
#define XCD_BAR_WORDS 3456
#define XB_SPIN_CAP (1u << 18)

__device__ __forceinline__ unsigned xb_ld(unsigned* p)              { return __hip_atomic_load(p, __ATOMIC_RELAXED, __HIP_MEMORY_SCOPE_AGENT); }
__device__ __forceinline__ unsigned xb_add(unsigned* p, unsigned v) { return __hip_atomic_fetch_add(p, v, __ATOMIC_RELAXED, __HIP_MEMORY_SCOPE_AGENT); }
__device__ __forceinline__ unsigned xb_xcc_id() { return (unsigned)__builtin_amdgcn_s_getreg((3 << 11) | 20) & 0xFu; }
#define XB_SPIN(cond, bar) do { unsigned _sp = 0; while (cond) { __builtin_amdgcn_s_sleep(1); \
    if ((++_sp & 255u) == 0u) { if (xb_ld(&(bar)[XB_TMO])) break; if (_sp > XB_SPIN_CAP) { atomicAdd(&(bar)[XB_TMO], 1u); break; } } } } while (0)

struct XcdBarrier {
    unsigned* bar; unsigned x;
    volatile LAS unsigned* st;
};

__device__ __forceinline__ XcdBarrier xcd_barrier_post(unsigned* bar, volatile LAS unsigned* st) {
    XcdBarrier b; b.bar = bar; b.x = xb_xcc_id(); b.st = st;
    if (threadIdx.x == 0) (void)xb_add(&bar[XB_XCNT(b.x)], 1u);
    return b;
}
__device__ __forceinline__ void xcd_barrier_complete(unsigned* bar, unsigned x, unsigned& nloc, unsigned& nx) {
    const unsigned G = gridDim.x * gridDim.y * gridDim.z;
    unsigned sum, cnt, mine, sp = 0u;
    for (;;) {
        sum = 0u; cnt = 0u; mine = 0u;
#pragma unroll
        for (unsigned j = 0; j < 16; ++j) { const unsigned c = xb_ld(&bar[XB_XCNT(j)]); sum += c; cnt += (c > 0u) ? 1u : 0u; mine = (j == x) ? c : mine; }
        if (sum == G) break;
        __builtin_amdgcn_s_sleep(1);
        if ((++sp & 255u) == 0u) { if (xb_ld(&bar[XB_TMO])) break; if (sp > XB_SPIN_CAP) { atomicAdd(&bar[XB_TMO], 1u); break; } }
    }
    nloc = mine > 0u ? mine : 1u; nx = cnt > 0u ? cnt : 1u;
}

__device__ __forceinline__ void xcd_barrier(const XcdBarrier& b) {
    asm volatile("s_waitcnt vmcnt(0)" ::: "memory");
    __syncthreads();
    if (threadIdx.x == 0) {
        unsigned* bar = b.bar;
        __builtin_amdgcn_s_waitcnt(0);
        unsigned nloc = b.st[0], nx = b.st[1];
        if (nloc == 0u) { xcd_barrier_complete(bar, b.x, nloc, nx); b.st[0] = nloc; b.st[1] = nx; }
        const unsigned old = xb_add(&bar[XB_XSUB(b.x)], 1u);
        const unsigned gen = old / nloc;
        if (old + 1u == (gen + 1u) * nloc) {
            __builtin_amdgcn_fence(__ATOMIC_RELEASE, "agent");
            asm volatile("s_waitcnt vmcnt(0)" ::: "memory");
            const unsigned og = xb_add(&bar[XB_TOP], 1u);
            const unsigned tg = og / nx;
            if (og + 1u == (tg + 1u) * nx) xb_add(&bar[XB_TOPGEN], 1u);
            else XB_SPIN(xb_ld(&bar[XB_TOPGEN]) == tg, bar);
            __builtin_amdgcn_fence(__ATOMIC_ACQUIRE, "agent");
            xb_add(&bar[XB_XGEN(b.x)], 1u);
            asm volatile("s_waitcnt vmcnt(0)" ::: "memory");
        } else {
            XB_SPIN(xb_ld(&bar[XB_XGEN(b.x)]) == gen, bar);
            __builtin_amdgcn_fence(__ATOMIC_ACQUIRE, "agent");
            asm volatile("s_waitcnt vmcnt(0)" ::: "memory");
        }
    }
    __syncthreads();
}

struct Frame {
    LAS unsigned char* lds;
    volatile LAS unsigned* MISC;
    gu32* ctl;
    int tid, lane, wave;
    int vcu, G;
    const float *x, *c, *w_ada, *b_ada, *w_in, *b_forget, *qg, *kg, *fog, *rog, *w_out, *w1, *w2; float* out;
    bf16 *Win_t, *Wout_t, *W1_t, *W2_t;
    float *wf, *rope, *logf, *cum, *mod;
    bf16 *H, *MIXB, *PROJ, *U;
};
__device__ __forceinline__ float bf2f(unsigned short v) { return __uint_as_float((unsigned)v << 16); }
__device__ __forceinline__ float bflo(unsigned w) { return __uint_as_float(w << 16); }
__device__ __forceinline__ float bfhi(unsigned w) { return __uint_as_float(w & 0xffff0000u); }
__device__ __forceinline__ void unpack8(const v4u w, float* f) { f[0] = bflo(w.x); f[1] = bfhi(w.x); f[2] = bflo(w.y); f[3] = bfhi(w.y); f[4] = bflo(w.z); f[5] = bfhi(w.z); f[6] = bflo(w.w); f[7] = bfhi(w.w); }
__device__ __forceinline__ v4u pack8(const float* f) { v4u w; w.x = pk2(f[0], f[1]); w.y = pk2(f[2], f[3]); w.z = pk2(f[4], f[5]); w.w = pk2(f[6], f[7]); return w; }

__device__ __forceinline__ void p0_transpose_item(const float* W, int K, int ldn, int col_off, int nblk, bf16* WT, int row_off, LAS float* scr, int item, int lane) {
    const int kb = item / nblk, nb = item % nblk, k0 = 64 * kb, n0 = 32 * nb;
#pragma unroll 8
    for (int i = 0; i < 32; ++i) { const int kk = 2 * i + (lane >> 5); scr[kk * 33 + (lane & 31)] = W[(size_t)(k0 + kk) * ldn + col_off + n0 + (lane & 31)]; }
    LDS_WAIT(); asm volatile("" ::: "memory");
    const int c = lane & 7;
#pragma unroll
    for (int j = 0; j < 4; ++j) { const int n = (lane >> 3) + 8 * j; const LAS float* s = scr + (8 * c) * 33 + n;
        v4u o; o.x = pk2(s[0 * 33], s[1 * 33]); o.y = pk2(s[2 * 33], s[3 * 33]); o.z = pk2(s[4 * 33], s[5 * 33]); o.w = pk2(s[6 * 33], s[7 * 33]);
        *(GAS v4u*)(WT + (size_t)(row_off + n0 + n) * K + k0 + 8 * c) = o; }
    LDS_WAIT(); asm volatile("" ::: "memory");
}
__device__ __forceinline__ void p0_mod_item(Frame& F, LAS float* scr, int item) {
    const int cg = item % 96, ks = item / 96; const int e = cg * 64 + F.lane, k0 = ks * 128;
#pragma unroll 4
    for (int i = 0; i < 64; ++i) { const int idx = i * 64 + F.lane; const int kk = idx >> 5, b = idx & 31; const float cv = F.c[b * D + k0 + kk]; scr[idx] = cv / (1.f + expf(-cv)); }
    LDS_WAIT(); asm volatile("" ::: "memory");
    float acc[32];
#pragma unroll
    for (int b = 0; b < 32; ++b) acc[b] = 0.f;
#pragma unroll 4
    for (int kk = 0; kk < 128; ++kk) { const float w = F.w_ada[(size_t)(k0 + kk) * NMOD + e];
#pragma unroll
        for (int b4 = 0; b4 < 8; ++b4) { const f32x4 s = *(const LAS f32x4*)(scr + kk * 32 + 4 * b4);
            acc[4 * b4 + 0] += s.x * w; acc[4 * b4 + 1] += s.y * w; acc[4 * b4 + 2] += s.z * w; acc[4 * b4 + 3] += s.w * w; } }
    const float bias = (ks == 0) ? F.b_ada[e] : 0.f;
#pragma unroll
    for (int b = 0; b < 32; ++b) atomicAdd(&F.mod[b * NMOD + e], acc[b] + bias);
    LDS_WAIT(); asm volatile("" ::: "memory");
}
__device__ __forceinline__ void p0_rope_item(Frame& F, int s) {
    const int j = F.lane;
    double f = 1.0, p = 0.86596432336006535; int e = j;
#pragma unroll
    for (int bit = 0; bit < 6; ++bit) { if (e & 1) f *= p; p *= p; e >>= 1; }
    const double ang = (double)s * f;
    const double kq = rint(ang * 0.63661977236758134);
    const double r = fma(-kq, 1.5707963267948966, ang) - kq * 6.123233995736766e-17;
    const double r2 = r * r;
    const double sn = r * (1.0 + r2 * (-1.0 / 6.0 + r2 * (1.0 / 120.0 + r2 * (-1.0 / 5040.0 + r2 * (1.0 / 362880.0 + r2 * (-1.0 / 39916800.0 + r2 * (1.0 / 6227020800.0)))))));
    const double cs = 1.0 + r2 * (-0.5 + r2 * (1.0 / 24.0 + r2 * (-1.0 / 720.0 + r2 * (1.0 / 40320.0 + r2 * (-1.0 / 3628800.0 + r2 * (1.0 / 479001600.0 + r2 * (-1.0 / 87178291200.0)))))));
    const int q = ((int)kq) & 3;
    const double S = (q == 0) ? sn : (q == 1) ? cs : (q == 2) ? -sn : -cs;
    const double C = (q == 0) ? cs : (q == 1) ? -sn : (q == 2) ? -cs : sn;
    F.rope[s * 128 + j] = (float)C; F.rope[s * 128 + 64 + j] = (float)S;
}
__device__ __forceinline__ void p0_prologue(Frame& F) {
    LAS float* scr = (LAS float*)(F.lds + RING_OFF + F.wave * 16384);
    const int gw = F.vcu * NWAVES + F.wave, NGW = F.G * NWAVES;
    constexpr int I_INA = (D / 64) * (2048 / 32), I_INB = I_INA, I_O = (D / 64) * (D / 32), I_1 = (D / 64) * (FF / 32), I_2 = (FF / 64) * (D / 32);
    constexpr int I_MOD = 96 * 8, I_ROPE = SEQ, I_WF = 8;
    constexpr int NITEMS = I_MOD + I_INA + I_INB + I_O + I_1 + I_2 + I_ROPE + I_WF;
    for (int it = gw; it < NITEMS; it += NGW) {
        int r = it;
        if (r < I_MOD) { p0_mod_item(F, scr, r); continue; } r -= I_MOD;
        if (r < I_INA) { p0_transpose_item(F.w_in, D, IN_COLS, 0, 2048 / 32, F.Win_t, 0, scr, r, F.lane); continue; } r -= I_INA;
        if (r < I_INB) { p0_transpose_item(F.w_in, D, IN_COLS, 2056, 2048 / 32, F.Win_t, 2048, scr, r, F.lane); continue; } r -= I_INB;
        if (r < I_O) { p0_transpose_item(F.w_out, D, D, 0, D / 32, F.Wout_t, 0, scr, r, F.lane); continue; } r -= I_O;
        if (r < I_1) { p0_transpose_item(F.w1, D, FF, 0, FF / 32, F.W1_t, 0, scr, r, F.lane); continue; } r -= I_1;
        if (r < I_2) { p0_transpose_item(F.w2, FF, D, 0, D / 32, F.W2_t, 0, scr, r, F.lane); continue; } r -= I_2;
        if (r < I_ROPE) { p0_rope_item(F, r); continue; } r -= I_ROPE;
        { for (int k = F.lane; k < D; k += 64) F.wf[r * D + k] = F.w_in[(size_t)k * IN_COLS + 2048 + r]; }
    }
}

__device__ __forceinline__ float wave_sum(float v) {
#pragma unroll
    for (int o = 1; o < 64; o <<= 1) v += __shfl_xor(v, o);
    return v;
}
__device__ __forceinline__ float reduce8(const float* p, int lane) {
    const bool b0 = lane & 1, b1 = lane & 2, b2 = lane & 4;
    float q[4], r[2];
#pragma unroll
    for (int i = 0; i < 4; ++i) { const float send = b0 ? p[i] : p[i + 4], keep = b0 ? p[i + 4] : p[i]; q[i] = keep + __shfl_xor(send, 1); }
#pragma unroll
    for (int i = 0; i < 2; ++i) { const float send = b1 ? q[i] : q[i + 2], keep = b1 ? q[i + 2] : q[i]; r[i] = keep + __shfl_xor(send, 2); }
    const float send = b2 ? r[0] : r[1], keep = b2 ? r[1] : r[0];
    float s = keep + __shfl_xor(send, 4);
    s += __shfl_xor(s, 8); s += __shfl_xor(s, 16); s += __shfl_xor(s, 32);
    return s;
}
template <bool FORGET> __device__ __forceinline__ void norm_phase(Frame& F, const float* xin, int mod_scale, int mod_shift) {
    LAS float* sc = (LAS float*)F.lds; LAS float* sh = sc + 1024; LAS float* wfl = sh + 1024; LAS float* bfl = wfl + 8192;
    for (int chunk = F.vcu; chunk < M / 256; chunk += F.G) {
        const int b = chunk >> 3;
        __syncthreads();
        for (int i = F.tid; i < 1024; i += NWAVES * 64) { sc[i] = 1.f + F.mod[b * NMOD + mod_scale + i]; sh[i] = F.mod[b * NMOD + mod_shift + i]; }
        if (FORGET) { for (int i = F.tid; i < 8192; i += NWAVES * 64) wfl[i] = F.wf[i]; if (F.tid < 8) bfl[F.tid] = F.b_forget[F.tid]; }
        __syncthreads();
        for (int rp = 0; rp < 32; ++rp) {
            const int row = chunk * 256 + F.wave * 32 + rp;
            const GAS f32x4* xr = (const GAS f32x4*)(xin + (size_t)row * D) + F.lane;
            f32x4 v[4]; float ss = 0.f;
#pragma unroll
            for (int j = 0; j < 4; ++j) { v[j] = xr[64 * j]; ss += (v[j].x * v[j].x + v[j].y * v[j].y) + (v[j].z * v[j].z + v[j].w * v[j].w); }
            const float rstd = rsqrtf(wave_sum(ss) * (1.f / D) + EPS);
            GAS unsigned long long* o8 = (GAS unsigned long long*)(F.H + (size_t)row * D) + F.lane;
#pragma unroll
            for (int j = 0; j < 4; ++j) { const f32x4 s4 = *(const LAS f32x4*)(sc + 4 * F.lane + 256 * j), h4 = *(const LAS f32x4*)(sh + 4 * F.lane + 256 * j);
                v[j] = v[j] * rstd * s4 + h4;
                o8[64 * j] = (unsigned long long)pk2(v[j].x, v[j].y) | ((unsigned long long)pk2(v[j].z, v[j].w) << 32); }
            if (FORGET) {
                float p[8];
#pragma unroll
                for (int hh = 0; hh < 8; ++hh) { float a = 0.f;
#pragma unroll
                    for (int j = 0; j < 4; ++j) { const f32x4 w4 = *(const LAS f32x4*)(wfl + hh * 1024 + 4 * F.lane + 256 * j); a += (v[j].x * w4.x + v[j].y * w4.y) + (v[j].z * w4.z + v[j].w * w4.w); }
                    p[hh] = a; }
                const float tot = reduce8(p, F.lane);
                if (F.lane < 8) { const int hs = 4 * (F.lane & 1) + 2 * ((F.lane >> 1) & 1) + ((F.lane >> 2) & 1);
                    const float z = tot + bfl[hs];
                    const float lf = fminf(z, 0.f) - log1pf(expf(-fabsf(z)));
                    F.logf[((size_t)(b * 8 + hs)) * SEQ + (row & (SEQ - 1))] = lf; }
            }
        }
    }
}
__device__ __forceinline__ void cumsum_seq(Frame& F, int seq) {
    const float* src = F.logf + (size_t)seq * SEQ + 32 * F.lane; float* dst = F.cum + (size_t)seq * SEQ + 32 * F.lane;
    double run = 0.0; float v[32];
#pragma unroll
    for (int i = 0; i < 8; ++i) { const f32x4 t = *(const f32x4*)(src + 4 * i); v[4 * i] = t.x; v[4 * i + 1] = t.y; v[4 * i + 2] = t.z; v[4 * i + 3] = t.w; }
#pragma unroll
    for (int i = 0; i < 32; ++i) run += (double)v[i];
    double t = run;
#pragma unroll
    for (int o = 1; o < 64; o <<= 1) { const double n = __shfl_up(t, o); if (F.lane >= o) t += n; }
    double acc = t - run;
#pragma unroll
    for (int i = 0; i < 8; ++i) { f32x4 o4; acc += (double)v[4 * i]; o4.x = (float)(acc * 1.4426950408889634); acc += (double)v[4 * i + 1]; o4.y = (float)(acc * 1.4426950408889634);
        acc += (double)v[4 * i + 2]; o4.z = (float)(acc * 1.4426950408889634); acc += (double)v[4 * i + 3]; o4.w = (float)(acc * 1.4426950408889634); *(f32x4*)(dst + 4 * i) = o4; }
}

__device__ __forceinline__ void post_row(Frame& F, size_t row) {
    bf16* p = F.PROJ + row * NPROJ; const int lane = F.lane; const int s = (int)(row & (SEQ - 1));
    {
        const int hd = lane >> 2, sl = lane & 3; bf16* a = p + hd * 64 + sl * 16;
        float v[16]; unpack8(*(const v4u*)a, v); unpack8(*(const v4u*)(a + 8), v + 8);
        float ss = 0.f;
#pragma unroll
        for (int i = 0; i < 16; ++i) ss += v[i] * v[i];
        ss += __shfl_xor(ss, 1); ss += __shfl_xor(ss, 2);
        const float rstd = rsqrtf(ss * (1.f / 64.f) + EPS);
        const float* g = ((hd < 8) ? F.qg : F.kg) + sl * 16; const float scl = (hd < 8) ? C2 * rstd : rstd;
#pragma unroll
        for (int i = 0; i < 16; ++i) v[i] = v[i] * scl * g[i];
        *(v4u*)a = pack8(v); *(v4u*)(a + 8) = pack8(v + 8);
    }
    {
        const int hh = lane >> 3, i0 = (lane & 7) * 8; bf16* a = p + C_RQ + hh * 128 + i0;
        float x1[8], x2[8]; unpack8(*(const v4u*)a, x1); unpack8(*(const v4u*)(a + 64), x2);
        const float* ct = F.rope + s * 128 + i0; const float* st = ct + 64;
        const int hk = hh & 3; const float lg2 = (hk == 0) ? -0.04580368961312479f : (hk == 1) ? -0.02272007650008353f : (hk == 2) ? -0.011315313227834146f : -0.005646563141142063f;
        const float scl = (hh >= 4) ? 0.08838834764831845f * exp2f(-lg2 * (float)(s & 127)) : 1.f;
        float y1[8], y2[8];
#pragma unroll
        for (int i = 0; i < 8; ++i) { const float c = ct[i], sn = st[i]; y1[i] = (x1[i] * c - x2[i] * sn) * scl; y2[i] = (x1[i] * sn + x2[i] * c) * scl; }
        *(v4u*)a = pack8(y1); *(v4u*)(a + 64) = pack8(y2);
    }
}

__device__ __forceinline__ void fox_item(Frame& F, unsigned char* lds_generic, int bh, int qb) {
    attn_body::attn_unit<8>(bh >> 3, bh & 7, qb, (const attn_body::bf16*)(F.PROJ + C_FQ), (const attn_body::bf16*)(F.PROJ + C_FK), (const attn_body::bf16*)(F.PROJ + C_FV),
                            (const attn_body::bf16*)(F.PROJ + C_FOG), F.cum, F.fog, (attn_body::bf16*)F.MIXB, (char*)lds_generic + RING_OFF);
}
__device__ __forceinline__ void ret_item(Frame& F, unsigned char* lds_generic, int bh) {
    const int b = bh >> 2, h = bh & 3;
    const float lg2 = (h == 0) ? -0.04580368961312479f : (h == 1) ? -0.02272007650008353f : (h == 2) ? -0.011315313227834146f : -0.005646563141142063f;
    ret_body::ret_unit(b, F.PROJ, C_RQ + h * 128, C_RK + h * 128, C_RV + h * 128, C_RG + h * 128, F.rog + h * 128, F.MIXB + 512 + h * 128, lg2, lds_generic + RING_OFF);
}
__device__ __forceinline__ void mixer_phase(Frame& F, unsigned char* lds_generic) {
    static_assert(attn_body::ATTN_LDS_BYTES <= RING_BYTES && ret_body::RET_LDS_END <= LDS_BYTES, "mixer LDS");
    if (F.G == 256) {
        const int j = F.vcu >> 1;
        if ((F.vcu & 1) == 0) {
            ret_item(F, lds_generic, j);
            const unsigned long long A = 0xAC5E7ull;
            for (int i = 0; i < 5; ++i) { const int it = (int)(A >> (4 * i)) & 15; fox_item(F, lds_generic, 2 * j + (it >> 3), it & 7); }
        } else {
            const unsigned long long B = 0x80912B34D6Full;
            for (int i = 0; i < 11; ++i) { const int it = (int)(B >> (4 * i)) & 15; fox_item(F, lds_generic, 2 * j + (it >> 3), it & 7); }
        }
    } else {
        for (int u = F.vcu; u < BATCH * 4; u += F.G) ret_item(F, lds_generic, u);
        for (int bh = F.vcu; bh < BATCH * 8; bh += F.G) for (int qb = 7; qb >= 0; --qb) fox_item(F, lds_generic, bh, qb);
    }
}

struct Args { const float* in[13]; float* out; unsigned char* ws; int ph_lo, ph_hi, li, pad; };
__global__ void __launch_bounds__(NWAVES * 64, 2) skel_fwd(Args args) {
    extern __shared__ __attribute__((aligned(16))) unsigned char lds[];
    Frame F;
    F.lds = (LAS unsigned char*)lds;
    F.MISC = (volatile LAS unsigned*)(F.lds + MISC_OFF);
    F.tid = threadIdx.x; F.lane = F.tid & 63; F.wave = __builtin_amdgcn_readfirstlane(F.tid >> 6);
    F.G = gridDim.x; { const int bx = blockIdx.x; F.vcu = (F.G % 8 == 0) ? (bx % 8) * (F.G / 8) + bx / 8 : bx; }
    unsigned char* ws = args.ws;
    F.ctl = (gu32*)(ws + WS_CTL);
    F.x = args.in[0]; F.c = args.in[1]; F.w_ada = args.in[2]; F.b_ada = args.in[3]; F.w_in = args.in[4]; F.b_forget = args.in[5]; F.qg = args.in[6]; F.kg = args.in[7];
    F.fog = args.in[8]; F.rog = args.in[9]; F.w_out = args.in[10]; F.w1 = args.in[11]; F.w2 = args.in[12]; F.out = args.out;
    F.Win_t = (bf16*)(ws + WS_WIN); F.Wout_t = (bf16*)(ws + WS_WOUT); F.W1_t = (bf16*)(ws + WS_W1); F.W2_t = (bf16*)(ws + WS_W2);
    F.wf = (float*)(ws + WS_WF); F.rope = (float*)(ws + WS_ROPE); F.logf = (float*)(ws + WS_LOGF); F.cum = (float*)(ws + WS_CUM); F.mod = (float*)(ws + WS_MOD);
    F.H = (bf16*)(ws + WS_H); F.MIXB = (bf16*)(ws + WS_MIX); F.PROJ = (bf16*)(ws + WS_PROJ); F.U = (bf16*)(ws + WS_U);
    for (int u = F.tid; u < (LDS_BYTES - LDSCTL_OFF) / 4; u += NWAVES * 64) ((LAS unsigned*)(F.lds + LDSCTL_OFF))[u] = 0u;
    __syncthreads();
    XcdBarrier bar; bar.bar = (unsigned*)(F.ctl + CW_BAR); bar.x = 0; bar.st = nullptr;
    if (N_LAUNCHES != PER_PHASE) bar = xcd_barrier_post((unsigned*)(F.ctl + CW_BAR), F.MISC + 8);
#define GRID_BAR() do { if (N_LAUNCHES != PER_PHASE) xcd_barrier(bar); } while (0)
    const int lo = args.ph_lo, hi = args.ph_hi;
#define IN(k) (lo <= (k) && (k) < hi)
#define BOTH(k) (IN(k) && IN((k) + 1))
    if (IN(0)) { p0_prologue(F); if (BOTH(0)) GRID_BAR(); }
    if (IN(1)) { norm_phase<true>(F, F.x, MOD_SCALE_M, MOD_SHIFT_M); if (BOTH(1)) GRID_BAR(); }
    if (IN(2)) {
        for (int seq = F.vcu; seq < BATCH * 8; seq += F.G) if (F.wave == 0) cumsum_seq(F, seq);
        pg8::Gemm g{F.H, F.Win_t, M, NPROJ, D}; pg8::StaticOrder S; S.init(M, NPROJ, F.G, (int)blockIdx.x);
        pg8::EpiBf16<0> E{F.PROJ, NPROJ};
        pg8::gemm_phase<pg8::EpiBf16<0>, pg8::StaticOrder, PG8_ALIGN, PG8_SP2>(F.lds + RING_OFF, g, S, E);
        if (BOTH(2)) GRID_BAR();
    }
    if (IN(3)) { const int gw = F.vcu * NWAVES + F.wave, NGW = F.G * NWAVES; for (int r = gw; r < M; r += NGW) post_row(F, (size_t)r); if (BOTH(3)) GRID_BAR(); }
    if (IN(4)) { mixer_phase(F, lds); if (BOTH(4)) GRID_BAR(); }
    if (IN(5)) {
        pg8::Gemm g{F.MIXB, F.Wout_t, M, D, D}; pg8::StaticOrder S; S.init(M, D, F.G, (int)blockIdx.x);
        pg8::EpiResGate E{F.x, F.out, D, F.mod + MOD_GATE_M, NMOD, SEQ / 256};
        pg8::gemm_phase<pg8::EpiResGate, pg8::StaticOrder, PG8_ALIGN, PG8_SP2>(F.lds + RING_OFF, g, S, E);
        if (BOTH(5)) GRID_BAR();
    }
    if (IN(6)) { norm_phase<false>(F, F.out, MOD_SCALE_F, MOD_SHIFT_F); if (BOTH(6)) GRID_BAR(); }
    if (IN(7)) {
        pg8::Gemm g{F.H, F.W1_t, M, FF, D}; pg8::StaticOrder S; S.init(M, FF, F.G, (int)blockIdx.x);
        pg8::EpiBf16<2> E{F.U, FF};
        pg8::gemm_phase<pg8::EpiBf16<2>, pg8::StaticOrder, PG8_ALIGN, PG8_SP2>(F.lds + RING_OFF, g, S, E);
        if (BOTH(7)) GRID_BAR();
    }
    if (IN(8)) {
        pg8::Gemm g{F.U, F.W2_t, M, D, FF}; pg8::StaticOrder S; S.init(M, D, F.G, (int)blockIdx.x);
        pg8::EpiResGate E{F.out, F.out, D, F.mod + MOD_GATE_F, NMOD, SEQ / 256};
        pg8::gemm_phase<pg8::EpiResGate, pg8::StaticOrder, PG8_ALIGN, PG8_SP2>(F.lds + RING_OFF, g, S, E);
    }
#undef IN
#undef BOTH
}

extern "C" void kernel_launch(void* const* d_in, const int* in_sizes, int n_in, void* d_out, int out_size, void* d_ws, size_t ws_size, hipStream_t stream) {
    static int grid = 0;
    if (grid == 0) {
        if (n_in != 13 || in_sizes[0] != M * D || out_size != M * D || ws_size < WS_END) { fprintf(stderr, "kernel_launch: unexpected shapes/workspace (n_in %d, in0 %d, out %d, ws %zu); nothing launched\n", n_in, n_in > 0 ? in_sizes[0] : -1, out_size, ws_size); grid = -1; return; }
        int dev = 0, cus = 0, per_cu = 0;
        if (hipGetDevice(&dev) != hipSuccess || hipDeviceGetAttribute(&cus, hipDeviceAttributeMultiprocessorCount, dev) != hipSuccess) { fprintf(stderr, "kernel_launch: device query failed\n"); grid = -1; return; }
        if (hipFuncSetAttribute((const void*)skel_fwd, hipFuncAttributeMaxDynamicSharedMemorySize, LDS_BYTES) != hipSuccess) { fprintf(stderr, "kernel_launch: hipFuncSetAttribute failed\n"); grid = -1; return; }
        if (hipOccupancyMaxActiveBlocksPerMultiprocessor(&per_cu, (const void*)skel_fwd, NWAVES * 64, LDS_BYTES) != hipSuccess || per_cu < 1) { fprintf(stderr, "kernel_launch: occupancy query reports %d workgroups per CU; nothing launched\n", per_cu); (void)hipGetLastError(); grid = -1; return; }
        grid = cus;
    }
    if (grid < 0) return;
    if (hipMemsetAsync((char*)d_ws + WS_CTL, 0, CTL_ZERO_BYTES, stream) != hipSuccess) { fprintf(stderr, "kernel_launch: hipMemsetAsync failed\n"); return; }
    Args a{};
    for (int i = 0; i < 13; ++i) a.in[i] = (const float*)d_in[i];
    a.out = (float*)d_out; a.ws = (unsigned char*)d_ws;
    for (int li = 0; li < N_LAUNCHES; ++li) {
        a.ph_lo = (N_LAUNCHES == PER_PHASE) ? li : 0; a.ph_hi = (N_LAUNCHES == PER_PHASE) ? li + 1 : PER_PHASE; a.li = li;
        hipLaunchKernelGGL(skel_fwd, dim3(grid), dim3(NWAVES * 64), LDS_BYTES, stream, a);
        const hipError_t le = hipPeekAtLastError();
        if (le != hipSuccess) { fprintf(stderr, "kernel_launch: launch %d failed: %s\n", li, hipGetErrorName(le)); break; }
    }
}
```

```cpp
#include <hip/hip_runtime.h>
#include <cstdio>
#include <cstdint>
#include <cmath>
namespace pg8 {
#define PG8_LAS __attribute__((address_space(3)))
typedef unsigned short bf16_t;
typedef short bf16x8 __attribute__((ext_vector_type(8)));
typedef float f32x4 __attribute__((ext_vector_type(4)));
typedef unsigned u32x4 __attribute__((ext_vector_type(4)));
constexpr int BM = 256, BK = 64, HALF = 128, HTB = HALF * BK * 2  , STAGE_BYTES = 8 * HTB, NXCD = 8, WGM = 8;

__host__ __device__ __forceinline__ int lds_byte(int r, int c) { const int st = (r >> 4) * 2 + (c >> 5), rr = r & 15, cc = c & 31, ob = rr * 64 + cc * 2; return st * 1024 + (ob ^ (((ob >> 9) & 1) << 5)); }
__host__ __device__ __forceinline__ void stage_rc(int b, int& R, int& C) { const int st = b / 1024, sb = b % 1024, swz = sb ^ (((sb >> 9) & 1) << 5); R = (st >> 1) * 16 + swz / 64; C = (st & 1) * 32 + (swz % 64) / 2; }
__host__ __device__ __forceinline__ int perm32(int rho) { const int n = rho >> 4, i = rho & 15; return 8 * (i >> 2) + 4 * n + (i & 3); }

struct Unit { int pm, pn; };
struct Gemm { const bf16_t* A; const bf16_t* Bt; int M, N, K; };

struct StaticOrder {
    int nM, nN, nwg, G, c;
    __host__ __device__ void init(int M, int N, int G_, int c_) { nM = M / BM; nN = N / BM; nwg = nM * nN; G = G_; c = c_; }
    __host__ __device__ bool next(int i, Unit& u) const {
        const long L = (long)i * G + c; if (L >= nwg) return false;
        int wgid = (int)L; { const int q = nwg / NXCD, r = nwg % NXCD, xcd = wgid % NXCD, off = wgid / NXCD; wgid = (xcd < r ? xcd * (q + 1) : r * (q + 1) + (xcd - r) * q) + off; }
        const int nig = WGM * nN, gid = wgid / nig, fm = gid * WGM, gsz = (nM - fm) < WGM ? (nM - fm) : WGM;
        u.pm = fm + ((wgid % nig) % gsz); u.pn = (wgid % nig) / gsz; return true;
    }
    __device__ __forceinline__ void a_ready(const Unit&) const {}
    __device__ __forceinline__ void done(const Unit&) const {}
};

__device__ __forceinline__ unsigned cvt_pk_bf16(float lo, float hi) { unsigned r; asm volatile("v_cvt_pk_bf16_f32 %0, %1, %2" : "=v"(r) : "v"(lo), "v"(hi)); return r; }
constexpr int EPI_SCR = (1 * 2 + 1) * HTB;

template <int ACT, bool STORE = true> struct EpiBf16 {
    static constexpr bool PERM = true, AFTER_DRAIN = false;
    bf16_t* O; int ldc;
    __device__ __forceinline__ void operator()(const f32x4 (&acc)[2][2][4][2], const Unit& u, int wr, int wc, int fr, int fq, PG8_LAS unsigned char* lds, int wid, int lane) const {
        PG8_LAS unsigned char* scr = lds + EPI_SCR + wid * 1024;
        const int wofs = (fr >> 3) * 8192 + (fr & 7) * 128, wx = fr & 7;
        const int r8 = lane >> 3, c8 = lane & 7; const int rofs = r8 * 128 + 16 * (c8 ^ r8);
        bf16_t* obase = O + (size_t)(u.pm * BM + wr * 64 + r8) * ldc + u.pn * BM + wc * 64 + 8 * c8;
#pragma unroll
        for (int ai = 0; ai < 2; ++ai)
#pragma unroll
            for (int m = 0; m < 4; ++m) {
#pragma unroll
                for (int bj = 0; bj < 2; ++bj) { f32x4 v0 = acc[ai][bj][m][0], v1 = acc[ai][bj][m][1];
                    if (ACT == 2) {
#pragma unroll
                        for (int e = 0; e < 4; ++e) { const float a = fmaxf(v0[e], 0.f), b = fmaxf(v1[e], 0.f); v0[e] = a * a; v1[e] = b * b; } }
                    u32x4 w; w.x = cvt_pk_bf16(v0[0], v0[1]); w.y = cvt_pk_bf16(v0[2], v0[3]); w.z = cvt_pk_bf16(v1[0], v1[1]); w.w = cvt_pk_bf16(v1[2], v1[3]);
                    *(PG8_LAS u32x4*)(scr + wofs + 16 * ((4 * bj + fq) ^ wx)) = w; }
                const u32x4 x0 = *(const PG8_LAS u32x4*)(scr + rofs), x1 = *(const PG8_LAS u32x4*)(scr + 8192 + rofs);
                bf16_t* rowp = obase + (size_t)(ai * HALF + m * 16) * ldc;
                if (STORE) { __builtin_nontemporal_store(x0, (u32x4*)rowp); __builtin_nontemporal_store(x1, (u32x4*)(rowp + (size_t)8 * ldc)); }
                else asm volatile("" :: "v"(x0), "v"(x1));
            }
    }
};

template <bool NT> struct EpiResGate {
    static constexpr bool PERM = false, AFTER_DRAIN = false;
    const float* base; float* out; int ldc; const float* gate; int gate_stride; int tiles_per_batch;
    __device__ __forceinline__ void operator()(const f32x4 (&acc)[2][2][4][2], const Unit& u, int wr, int wc, int fr, int fq, PG8_LAS unsigned char* lds, int wid, int lane) const {
        PG8_LAS unsigned char* scr = lds + EPI_SCR + wid * 1024;
        const int wofs = (fr >> 3) * 8192 + (fr & 7) * 128, wx = fr & 7;
        const int r8 = lane >> 3, c8 = lane & 7; const int rofs = r8 * 128 + 16 * (c8 ^ r8);
        const int col = u.pn * BM + wc * 32 + 4 * c8;
        const float* g = gate + (size_t)(u.pm / tiles_per_batch) * gate_stride + col;
        const f32x4 g0 = *(const f32x4*)g, g1 = *(const f32x4*)(g + HALF);
        const size_t off0 = (size_t)(u.pm * BM + wr * 64 + r8) * ldc + col;
#pragma unroll
        for (int ai = 0; ai < 2; ++ai)
#pragma unroll
            for (int m = 0; m < 4; ++m) { const size_t off = off0 + (size_t)(ai * HALF + m * 16) * ldc;
#pragma unroll
                for (int bj = 0; bj < 2; ++bj) {
                    const f32x4 b0 = *(const f32x4*)(base + off + bj * HALF), b1 = *(const f32x4*)(base + off + bj * HALF + (size_t)8 * ldc);
                    *(PG8_LAS f32x4*)(scr + wofs + 16 * ((fq) ^ wx)) = acc[ai][bj][m][0];
                    *(PG8_LAS f32x4*)(scr + wofs + 16 * ((4 + fq) ^ wx)) = acc[ai][bj][m][1];
                    const f32x4 a0 = *(const PG8_LAS f32x4*)(scr + rofs), a1 = *(const PG8_LAS f32x4*)(scr + 8192 + rofs);
                    const f32x4 gg = bj ? g1 : g0;
                    if (NT) { __builtin_nontemporal_store(b0 + gg * a0, (f32x4*)(out + off + bj * HALF)); __builtin_nontemporal_store(b1 + gg * a1, (f32x4*)(out + off + bj * HALF + (size_t)8 * ldc)); }
                    else { *(f32x4*)(out + off + bj * HALF) = b0 + gg * a0; *(f32x4*)(out + off + bj * HALF + (size_t)8 * ldc) = b1 + gg * a1; }
                }
                asm volatile("" ::: "memory"); }
    }
};
template <class Epi, class Sched, bool ALIGN_EPI = false, bool SP2 = false>
__device__ __forceinline__ void gemm_phase(PG8_LAS unsigned char* lds, const Gemm g, const Sched& S, const Epi& E) {
    const int tid = threadIdx.x, wid = __builtin_amdgcn_readfirstlane(tid >> 6), lane = tid & 63, wr = wid >> 2, wc = wid & 3, fr = lane & 15, fq = lane >> 4;
    const int K = g.K, nt = K / BK;
    unsigned voffA[2], voffB[2];
#pragma unroll
    for (int i = 0; i < 2; ++i) { int R, C; stage_rc(tid * 16 + i * 8192, R, C); const int Rb = Epi::PERM ? ((R & ~31) + perm32(R & 31)) : R;
        voffA[i] = (unsigned)(R * K + C) * 2u; voffB[i] = (unsigned)(Rb * K + C) * 2u; }
    const size_t kstep = (size_t)(BK * 2);
    const size_t hstep = (size_t)HALF * K * 2;
    const size_t tstep = 2 * hstep;
    const unsigned ldsw = (unsigned)wid * 1024u;
    const int aoff = lds_byte(wr * 64 + fr, fq * 8), boff = lds_byte(wc * 32 + fr, fq * 8);
#define PG8_SA(b, h) (((b) * 2 + (h)) * HTB)
#define PG8_SB(b, h) ((4 + (b) * 2 + (h)) * HTB)
#define PG8_STAGE(bufoff, gbase, voff) do { _Pragma("unroll") for (int _i = 0; _i < 2; ++_i) \
        __builtin_amdgcn_global_load_lds((const unsigned*)((const char*)(gbase) + (voff)[_i]), (PG8_LAS unsigned*)(lds + (bufoff) + ldsw + _i * 8192), 16, 0, 0); } while (0)
#define PG8_LDA(dst, b, h) do { _Pragma("unroll") for (int m = 0; m < 4; ++m) _Pragma("unroll") for (int k = 0; k < 2; ++k) dst[m][k] = *(const PG8_LAS bf16x8*)(lds + PG8_SA(b, h) + aoff + m * 2048 + k * 1024); } while (0)
#define PG8_LDB(dst, b, h) do { _Pragma("unroll") for (int n = 0; n < 2; ++n) _Pragma("unroll") for (int k = 0; k < 2; ++k) dst[n][k] = *(const PG8_LAS bf16x8*)(lds + PG8_SB(b, h) + boff + n * 2048 + k * 1024); } while (0)
#define PG8_MMA(ai, bj, At, Bt) do { __builtin_amdgcn_s_setprio(1); _Pragma("unroll") for (int m = 0; m < 4; ++m) _Pragma("unroll") for (int n = 0; n < 2; ++n) _Pragma("unroll") for (int k = 0; k < 2; ++k) \
        acc[ai][bj][m][n] = __builtin_amdgcn_mfma_f32_16x16x32_bf16(Bt[n][k], At[m][k], acc[ai][bj][m][n], 0, 0, 0); __builtin_amdgcn_s_setprio(0); } while (0)
#define PG8_WAIT_V(n) asm volatile("s_waitcnt vmcnt(" #n ")" ::: "memory")
#define PG8_WAIT_L(n) asm volatile("s_waitcnt lgkmcnt(" #n ")" ::: "memory")
#define PG8_BAR __builtin_amdgcn_s_barrier()
#define PG8_SCHED __builtin_amdgcn_sched_barrier(0)
    Unit cur, nxt; int ui = 0;
    if (!S.next(0, cur)) return;
    f32x4 acc[2][2][4][2];
#pragma unroll
    for (int a = 0; a < 2; ++a)
#pragma unroll
        for (int b = 0; b < 2; ++b)
#pragma unroll
            for (int m = 0; m < 4; ++m)
#pragma unroll
                for (int n = 0; n < 2; ++n) acc[a][b][m][n] = (f32x4){0.f, 0.f, 0.f, 0.f};
    bf16x8 At[4][2], B0[2][2], B1[2][2];
    const char* cA = (const char*)g.A + (size_t)cur.pm * tstep; const char* cB = (const char*)g.Bt + (size_t)cur.pn * tstep;
    S.a_ready(cur);
    if constexpr (SP2) {
        PG8_STAGE(PG8_SB(0, 0), cB, voffB); PG8_STAGE(PG8_SB(0, 1), cB + hstep, voffB); PG8_STAGE(PG8_SA(0, 0), cA, voffA); PG8_STAGE(PG8_SA(0, 1), cA + hstep, voffA);
        if (wr == 1) PG8_BAR;
        PG8_WAIT_V(2); PG8_BAR;
        PG8_STAGE(PG8_SB(1, 0), cB + kstep, voffB); PG8_STAGE(PG8_SA(1, 0), cA + kstep, voffA); PG8_STAGE(PG8_SB(1, 1), cB + hstep + kstep, voffB);
        PG8_WAIT_V(6); PG8_BAR;
    } else {
        PG8_STAGE(PG8_SB(0, 0), cB, voffB); PG8_STAGE(PG8_SA(0, 0), cA, voffA); PG8_STAGE(PG8_SB(0, 1), cB + hstep, voffB); PG8_STAGE(PG8_SA(0, 1), cA + hstep, voffA);
        if (wr == 1) PG8_BAR;
        PG8_WAIT_V(4); PG8_BAR;
        PG8_STAGE(PG8_SB(1, 0), cB + kstep, voffB); PG8_STAGE(PG8_SA(1, 0), cA + kstep, voffA); PG8_STAGE(PG8_SB(1, 1), cB + hstep + kstep, voffB);
        PG8_WAIT_V(6); PG8_BAR;
    }
    for (;;) {
        const bool has_next = S.next(ui + 1, nxt);
        const char* nA = has_next ? (const char*)g.A + (size_t)nxt.pm * tstep : cA; const char* nB = has_next ? (const char*)g.Bt + (size_t)nxt.pn * tstep : cB;
        for (int t = 0; t < nt; t += 2) {
            const bool last = (t == nt - 2);
            const char* a1 = cA + (size_t)(t + 1) * kstep;
            const char* a2 = last ? nA : cA + (size_t)(t + 2) * kstep; const char* b2 = last ? nB : cB + (size_t)(t + 2) * kstep;
            const char* a3 = a2 + kstep; const char* b3 = b2 + kstep;
            if (last && has_next) S.a_ready(nxt);
            if constexpr (SP2) {
            PG8_LDB(B0, 0, 0); PG8_LDB(B1, 0, 1); PG8_SCHED; PG8_LDA(At, 0, 0); PG8_STAGE(PG8_SA(1, 1), a1 + hstep, voffA);
            PG8_WAIT_V(8); PG8_WAIT_L(0); PG8_BAR; PG8_MMA(0, 0, At, B0); PG8_MMA(0, 1, At, B1); PG8_BAR; PG8_SCHED;
            PG8_LDA(At, 0, 1); PG8_STAGE(PG8_SB(0, 0), b2, voffB); PG8_STAGE(PG8_SB(0, 1), b2 + hstep, voffB); PG8_STAGE(PG8_SA(0, 0), a2, voffA);
            PG8_WAIT_V(8); PG8_WAIT_L(0); PG8_BAR; PG8_MMA(1, 0, At, B0); PG8_MMA(1, 1, At, B1); PG8_BAR; PG8_SCHED;
            PG8_LDB(B0, 1, 0); PG8_LDB(B1, 1, 1); PG8_SCHED; PG8_LDA(At, 1, 0); PG8_STAGE(PG8_SA(0, 1), a2 + hstep, voffA);
            PG8_WAIT_V(8); PG8_WAIT_L(0); PG8_BAR; PG8_MMA(0, 0, At, B0); PG8_MMA(0, 1, At, B1); PG8_BAR; PG8_SCHED;
            PG8_LDA(At, 1, 1); PG8_STAGE(PG8_SB(1, 0), b3, voffB); PG8_STAGE(PG8_SB(1, 1), b3 + hstep, voffB); PG8_STAGE(PG8_SA(1, 0), a3, voffA);
            PG8_WAIT_V(8); PG8_WAIT_L(0); PG8_BAR; PG8_MMA(1, 0, At, B0); PG8_MMA(1, 1, At, B1); PG8_BAR; PG8_SCHED;
            } else {
            PG8_LDB(B0, 0, 0); PG8_SCHED; PG8_LDA(At, 0, 0); PG8_STAGE(PG8_SA(1, 1), a1 + hstep, voffA);
            PG8_WAIT_L(8); PG8_BAR; PG8_WAIT_L(0); PG8_MMA(0, 0, At, B0); PG8_BAR; PG8_SCHED;
            PG8_LDB(B1, 0, 1); PG8_STAGE(PG8_SB(0, 0), b2, voffB);
            PG8_BAR; PG8_WAIT_L(0); PG8_MMA(0, 1, At, B1); PG8_BAR;
            PG8_LDA(At, 0, 1); PG8_STAGE(PG8_SA(0, 0), a2, voffA);
            PG8_BAR; PG8_WAIT_L(0); PG8_MMA(1, 0, At, B0); PG8_BAR; PG8_SCHED;
            PG8_STAGE(PG8_SB(0, 1), b2 + hstep, voffB);
            PG8_WAIT_V(6); PG8_BAR; PG8_MMA(1, 1, At, B1); PG8_BAR;
            PG8_LDB(B0, 1, 0); PG8_SCHED; PG8_LDA(At, 1, 0); PG8_STAGE(PG8_SA(0, 1), a2 + hstep, voffA);
            PG8_WAIT_L(8); PG8_BAR; PG8_WAIT_L(0); PG8_MMA(0, 0, At, B0); PG8_BAR; PG8_SCHED;
            PG8_LDB(B1, 1, 1); PG8_STAGE(PG8_SB(1, 0), b3, voffB);
            PG8_BAR; PG8_WAIT_L(0); PG8_MMA(0, 1, At, B1); PG8_BAR;
            PG8_LDA(At, 1, 1); PG8_STAGE(PG8_SA(1, 0), a3, voffA);
            PG8_BAR; PG8_WAIT_L(0); PG8_MMA(1, 0, At, B0); PG8_BAR; PG8_SCHED;
            PG8_STAGE(PG8_SB(1, 1), b3 + hstep, voffB);
            PG8_WAIT_V(6); PG8_BAR; PG8_MMA(1, 1, At, B1); PG8_BAR;
            }
        }
        if constexpr (ALIGN_EPI) { if (wr == 0) PG8_BAR; }
        if constexpr (!Epi::AFTER_DRAIN) { static_assert(ALIGN_EPI, "the epilogues use stage buffer As[1][1] as scratch: both halves must be past their last K-tile"); E(acc, cur, wr, wc, fr, fq, lds, wid, lane); S.done(cur); }
        if (!has_next) break;
#pragma unroll
        for (int a = 0; a < 2; ++a)
#pragma unroll
            for (int b = 0; b < 2; ++b)
#pragma unroll
                for (int m = 0; m < 4; ++m)
#pragma unroll
                    for (int n = 0; n < 2; ++n) acc[a][b][m][n] = (f32x4){0.f, 0.f, 0.f, 0.f};
        cur = nxt; cA = nA; cB = nB; ++ui;
        if constexpr (ALIGN_EPI) { if (wr == 1) PG8_BAR; }
    }
    PG8_WAIT_V(0);
    if constexpr (!ALIGN_EPI) { if (wr == 0) PG8_BAR; }
    PG8_BAR;
    if constexpr (Epi::AFTER_DRAIN) { E.fused(acc, cur, wr, wc, fr, fq, lds, wid, lane); S.done(cur); }
#undef PG8_SA
#undef PG8_SB
#undef PG8_STAGE
#undef PG8_LDA
#undef PG8_LDB
#undef PG8_MMA
#undef PG8_WAIT_V
#undef PG8_WAIT_L
#undef PG8_BAR
#undef PG8_SCHED
}
}
#ifndef PG8_SP2
#define PG8_SP2 true
#endif
#ifndef PG8_ALIGN
#define PG8_ALIGN true
#endif
#include <hip/hip_bf16.h>
#include <cmath>
namespace attn_body {
using bf16=__hip_bfloat16;
using bf16x8=__attribute__((ext_vector_type(8)))short;
using s16x4=__attribute__((ext_vector_type(4)))short;
using f32x16=__attribute__((ext_vector_type(16)))float;
using u32x4=__attribute__((ext_vector_type(4)))unsigned;
using f32x4=__attribute__((ext_vector_type(4)))float;
constexpr int BATCH=32,NHEAD=8,SEQ=2048,D=64,DM=4096,ODM=1024;
constexpr int NW=8,QBLK=32,QB=QBLK*NW,KVBLK=64,NQB=SEQ/QB;
constexpr int ATTN_UNIT_ROWS=QB;
__device__ __forceinline__ int crow(int r,int hi){return (r&3)+8*(r>>2)+4*hi;}
#define SBAR() __builtin_amdgcn_sched_barrier(0)
__device__ __forceinline__ void cmask(f32x16&p0,f32x16&p1,int jb,int qrel,int hi){
  const float NEG=-INFINITY; int kb=64*jb+4*hi;
  #pragma unroll
  for(int r=0;r<16;++r){int kv=kb+(r&3)+8*(r>>2); if(kv>qrel)p0[r]=NEG; if(kv+32>qrel)p1[r]=NEG;}
}

constexpr int NSLOT=3, SLOTB=8192;
constexpr int LDS_K=0, LDS_V=NSLOT*SLOTB, LDS_WS=2*NSLOT*SLOTB, LDS_OST=LDS_WS+NW*64*4, LDS_CK=LDS_OST+NW*8192, LDS_BYTES=LDS_CK+SEQ*4;
constexpr float C2=0.125f*1.4426950408889634f;
__device__ __forceinline__ void glds16(const void*gsrc,unsigned lds_dst){unsigned keep;
  asm volatile("s_mov_b32 %0, m0\n\ts_mov_b32 m0, %2\n\ts_nop 0\n\tglobal_load_lds_dwordx4 %1, off\n\ts_mov_b32 m0, %0":"=&s"(keep):"v"(gsrc),"s"(lds_dst):"memory");}
__device__ __forceinline__ float max3f(float a,float b,float c){float r;asm("v_max3_f32 %0, %1, %2, %3":"=v"(r):"v"(a),"v"(b),"v"(c));return r;}
__device__ __forceinline__ float max2f(float a,float b){float r;asm("v_max_f32_e32 %0, %1, %2":"=v"(r):"v"(a),"v"(b));return r;}
__device__ __forceinline__ float fadd_s(float a,float b){float r;asm("v_add_f32_e32 %0, %1, %2":"=v"(r):"v"(a),"v"(b));return r;}
__device__ __forceinline__ float fsub_s(float a,float b){float r;asm("v_sub_f32_e32 %0, %1, %2":"=v"(r):"v"(a),"v"(b));return r;}
typedef float f32x2_t __attribute__((ext_vector_type(2))); typedef __bf16 bf16x2_t __attribute__((ext_vector_type(2)));
__device__ __forceinline__ unsigned cvtpk_s(float lo,float hi){f32x2_t v={lo,hi};bf16x2_t b=__builtin_convertvector(v,bf16x2_t);return __builtin_bit_cast(unsigned,b);}
#define WAIT_BAR(N) asm volatile("s_waitcnt vmcnt(" #N ") lgkmcnt(0)\n\ts_barrier":::"memory")

__device__ __forceinline__ void qkt(f32x16&p0,f32x16&p1,const char*Kslot,const bf16x8*qr,int r32,int hi){
  const char*kb=Kslot+hi*1024+r32*16;
  #pragma unroll
  for(int d0=0;d0<4;++d0){
    const bf16x8 b0=*reinterpret_cast<const bf16x8*>(kb+d0*2048);
    const bf16x8 b1=*reinterpret_cast<const bf16x8*>(kb+d0*2048+512);
    p0=__builtin_amdgcn_mfma_f32_32x32x16_bf16(b0,qr[d0],p0,0,0,0);p1=__builtin_amdgcn_mfma_f32_32x32x16_bf16(b1,qr[d0],p1,0,0,0);}
}
typedef __attribute__((address_space(3))) const char* lds_cptr;
typedef __attribute__((address_space(3))) char* lds_wptr;
typedef __attribute__((address_space(3))) const f32x4* lds_f4c;
typedef __attribute__((address_space(3))) f32x4* lds_f4w;
typedef __attribute__((address_space(3))) float* lds_fw;
typedef short v4i16_t __attribute__((ext_vector_type(4)));
__device__ __forceinline__ void kload8(bf16x8*kf,lds_cptr kp){
  kf[0]=*(const __attribute__((address_space(3))) bf16x8*)(kp);      kf[1]=*(const __attribute__((address_space(3))) bf16x8*)(kp+512);
  kf[2]=*(const __attribute__((address_space(3))) bf16x8*)(kp+2048); kf[3]=*(const __attribute__((address_space(3))) bf16x8*)(kp+2560);
  kf[4]=*(const __attribute__((address_space(3))) bf16x8*)(kp+4096); kf[5]=*(const __attribute__((address_space(3))) bf16x8*)(kp+4608);
  kf[6]=*(const __attribute__((address_space(3))) bf16x8*)(kp+6144); kf[7]=*(const __attribute__((address_space(3))) bf16x8*)(kp+6656);
}
__device__ __forceinline__ void kload2(bf16x8*kf,lds_cptr kp,int j){ kf[2*j]=*(const __attribute__((address_space(3))) bf16x8*)(kp+j*2048); kf[2*j+1]=*(const __attribute__((address_space(3))) bf16x8*)(kp+j*2048+512); }
__device__ __forceinline__ s16x4 vtr(lds_cptr p){ return __builtin_bit_cast(s16x4,__builtin_amdgcn_ds_read_tr16_b64_v4i16((__attribute__((address_space(3))) v4i16_t*)p)); }
__device__ __forceinline__ float rowmax(const f32x16&p0,const f32x16&p1){
  float a=max3f(p0[0],p0[1],p1[0]),b=max3f(p0[2],p0[3],p1[1]);a=max3f(a,p1[2],p1[3]);
  #pragma unroll
  for(int r=4;r<16;r+=4){a=max3f(a,p0[r],p0[r+1]);b=max3f(b,p0[r+2],p0[r+3]);a=max3f(a,p1[r],p1[r+1]);b=max3f(b,p1[r+2],p1[r+3]);}
  const float m=max2f(a,b);
  auto rr=__builtin_amdgcn_permlane32_swap(__float_as_uint(m),__float_as_uint(m),false,false);
  return max2f(__uint_as_float(rr[0]),__uint_as_float(rr[1]));
}
__device__ __forceinline__ void pv(f32x16*o,int vb,bf16x8 pa0,bf16x8 pa1,bf16x8 pa2,bf16x8 pa3){
  #pragma unroll
  for(int d0=0;d0<2;++d0){s16x4 lo[4],hi[4];
    #pragma unroll
    for(int ks=0;ks<4;++ks){
      asm volatile("ds_read_b64_tr_b16 %0,%1 offset:%c2":"=&v"(lo[ks]):"v"(vb),"i"(d0*4096+ks*1024):"memory");
      asm volatile("ds_read_b64_tr_b16 %0,%1 offset:%c2":"=&v"(hi[ks]):"v"(vb),"i"(d0*4096+ks*1024+512):"memory");}
    asm volatile("s_waitcnt lgkmcnt(0)":::"memory");SBAR();
    #define PK(k) (bf16x8){lo[k][0],lo[k][1],lo[k][2],lo[k][3],hi[k][0],hi[k][1],hi[k][2],hi[k][3]}
    o[d0]=__builtin_amdgcn_mfma_f32_32x32x16_bf16(pa0,PK(0),o[d0],0,0,0);
    o[d0]=__builtin_amdgcn_mfma_f32_32x32x16_bf16(pa1,PK(1),o[d0],0,0,0);
    o[d0]=__builtin_amdgcn_mfma_f32_32x32x16_bf16(pa2,PK(2),o[d0],0,0,0);
    o[d0]=__builtin_amdgcn_mfma_f32_32x32x16_bf16(pa3,PK(3),o[d0],0,0,0);
    #undef PK
  }
}

#ifndef ATTN_STORE16
#define ATTN_STORE16(p,v) (*(u32x4*)(p)=(v))
#endif
template<int THRL> __device__ __forceinline__ void attn_unit(int b,int h,int qb,const bf16*Q,const bf16*__restrict__ K,const bf16*__restrict__ V,const bf16*__restrict__ G,const float*__restrict__ cum2,const float*__restrict__ gain,bf16*O,char*shm){
  int tid_=threadIdx.x; asm volatile("":"+v"(tid_));
  const int tid=tid_,lane=tid&63,r32=lane&31,hi=lane>>5; const int wid=__builtin_amdgcn_readfirstlane(tid>>6);
  const long rowbase=(long)b*SEQ; const int q0=qb*QB;
  const bf16*Qw=Q+(rowbase+q0+wid*QBLK)*DM+h*D;
  const bf16*Kh=K+rowbase*DM+h*D,*Vh=V+rowbase*DM+h*D;
  const unsigned lds0=(unsigned)(uintptr_t)shm;
  float*wsf=(float*)(shm+LDS_WS)+wid*64;
  const bf16*ksrc=Kh+(long)lane*DM+wid*8;
  const bf16*vsrc=Vh+(long)(16*(wid&3)+(lane>>2))*DM+(wid>>2)*32+(lane&3)*8;
  const unsigned kdst=lds0+LDS_K+wid*1024, vdst=lds0+LDS_V+wid*1024;
  #define DMA_K(t,slot) glds16(ksrc+(long)(t)*KVBLK*DM,(unsigned)__builtin_amdgcn_readfirstlane(kdst+(slot)))
  #define DMA_V(t,slot) glds16(vsrc+(long)(t)*KVBLK*DM,(unsigned)__builtin_amdgcn_readfirstlane(vdst+(slot)))
  const int vb0=(int)(lds0+LDS_V)+((lane>>4)&1)*32+(lane&3)*8+(4*hi+((lane&15)>>2))*64;
  const char*Kbase=shm+LDS_K; bf16x8 kf[8];
  const lds_cptr shm3=(lds_cptr)shm; const lds_wptr shm3w=(lds_wptr)shm; const lds_f4c ckb=(lds_f4c)(shm3+LDS_CK)+hi; const lds_cptr kp0=shm3+LDS_K+hi*1024+r32*16; const lds_cptr vp0=shm3+LDS_V+((lane>>4)&1)*32+(lane&3)*8+(4*hi+((lane&15)>>2))*64;
  const int NT=(q0+QB)/KVBLK;
  DMA_K(0,0);DMA_V(0,0);DMA_K(1,SLOTB);
  { const float*cs=cum2+((long)(b*NHEAD+h))*SEQ; if(tid*4<q0+QB){ const f32x4 v_=*(const f32x4*)(cs+tid*4); *(lds_f4w)(shm3w+LDS_CK+tid*16)=(f32x4){-v_.x,-v_.y,-v_.z,-v_.w}; } }
  bf16x8 qr[4];
  #pragma unroll
  for(int d0=0;d0<4;++d0)qr[d0]=*reinterpret_cast<const bf16x8*>(&Qw[(long)r32*DM+d0*16+hi*8]);
  float mhat=0.f,l_reg=0.f;f32x16 o[2];o[0]=f32x16{};o[1]=f32x16{};
  const int qrel=wid*QBLK+r32;
  #define CMASK(P0,P1,t) do{int jb_=(t)-(NT-4); if(jb_>=0)cmask(P0,P1,jb_,qrel,hi);}while(0)
  bool resc=false;
  #define START(P0,P1) do{ const float rm=rowmax(P0,P1); resc=false; \
    { const float dl=rm; mhat=fadd_s(mhat,dl); \
      _Pragma("unroll") for(int r=0;r<16;++r){P0[r]=fsub_s(P0[r],dl);P1[r]=fsub_s(P1[r],dl);} \
      } \
    _Pragma("unroll") for(int r=0;r<16;++r)P0[r]=__builtin_amdgcn_exp2f(P0[r]); }while(0)
  #define RESC() do{ if(resc){ asm volatile("s_waitcnt lgkmcnt(0)":::"memory"); \
      _Pragma("unroll") for(int d_=0;d_<2;++d_) _Pragma("unroll") for(int r=0;r<16;++r)o[d_][r]*=wsf[crow(r,hi)]; } }while(0)
  f32x16 pA0,pA1,pB0,pB1;
  #define CINIT(C0,C1,t) do{ const lds_f4c cb_=ckb+(t)*16; _Pragma("unroll") for(int g_=0;g_<4;++g_){ const f32x4 a_=cb_[2*g_],b_=cb_[2*g_+8]; \
      C0[4*g_]=a_.x-mhat;C0[4*g_+1]=a_.y-mhat;C0[4*g_+2]=a_.z-mhat;C0[4*g_+3]=a_.w-mhat; C1[4*g_]=b_.x-mhat;C1[4*g_+1]=b_.y-mhat;C1[4*g_+2]=b_.z-mhat;C1[4*g_+3]=b_.w-mhat; } }while(0)
  int sl_prev=0,sl_cur=0,sl_next=SLOTB;
  #define ROT() do{sl_prev=sl_cur;sl_cur=sl_next;sl_next=(sl_next==(NSLOT-1)*SLOTB)?0:sl_next+SLOTB;}while(0)
  DMA_K(2,2*SLOTB);
  WAIT_BAR(3);
  CINIT(pA0,pA1,0); qkt(pA0,pA1,Kbase,qr,r32,hi);asm volatile("s_nop 15\n\ts_nop 7":"+v"(pA0),"+v"(pA1));CMASK(pA0,pA1,0);
  START(pA0,pA1);
  _Pragma("unroll") for(int r=0;r<16;++r)pA1[r]=__builtin_amdgcn_exp2f(pA1[r]);
  CINIT(pB0,pB1,1);
  WAIT_BAR(0);
  DMA_K(3,0);DMA_V(1,SLOTB);
  ROT();
  kload8(kf,kp0+sl_cur);
  WAIT_BAR(2);
  s16x4 vlo[8],vhi[8]; u32x4 pw0,pw1,pw2,pw3;
  #define PKW(P,B) cvtpk_s(P[B],P[B+1])
  #define PAF(k) __builtin_bit_cast(bf16x8,pw##k)
  #define VFR(i) (bf16x8){vlo[i][0],vlo[i][1],vlo[i][2],vlo[i][3],vhi[i][0],vhi[i][1],vhi[i][2],vhi[i][3]}
  #define PIN(x) asm volatile("":"+v"(x))
  #define MX3(a,b,c) __builtin_fmaxf(__builtin_fmaxf((a),(b)),(c))
  #define GAPA(MF,A0,A1,A2,A3,W0,W1,PW) do{ MF; sacc+=A0; sacc+=A1; sacc+=A2; sacc+=A3; PIN(sacc); W0; W1; PIN(PW); SBAR(); }while(0)
  #define EX(v) __builtin_amdgcn_exp2f(v)
  #define GAPB(MF,X,B,NP,NG,NXI) do{ MF; X[B]=EX(X[B]); X[B+1]=EX(X[B+1]); X[B+2]=EX(X[B+2]); X[B+3]=EX(X[B+3]); PIN(X); \
      NP[4*(NG)]=nx_.x-mhat; NP[4*(NG)+1]=nx_.y-mhat; NP[4*(NG)+2]=nx_.z-mhat; NP[4*(NG)+3]=nx_.w-mhat; PIN(NP); nx_=cbn_[NXI]; SBAR(); }while(0)
  #define VRD(i) do{ vlo[i]=vtr(vp_+(((i)>>2)*4096+((i)&3)*1024)); vhi[i]=vtr(vp_+(((i)>>2)*4096+((i)&3)*1024+512)); }while(0)
  #define KRD(G,j) do{ if(G){ kload2(kf,kp0+sl_next,j); SBAR(); } }while(0)
  #define STEP(C0,C1,P0,P1,t,GK,GV,GL) do{ SBAR(); const lds_f4c cbn_=ckb+((t)+1)*16; \
    const lds_cptr vp_=vp0+sl_prev; \
    VRD(0); SBAR(); float sacc=(P0[0]+P0[1]); \
    GAPA(C0=__builtin_amdgcn_mfma_f32_32x32x16_bf16(kf[0],qr[0],C0,0,0,0), P0[2],P0[3],P0[4],P0[5],     pw0[0]=PKW(P0,0), pw0[1]=PKW(P0,2), pw0); \
    VRD(4); SBAR(); GAPA(C1=__builtin_amdgcn_mfma_f32_32x32x16_bf16(kf[1],qr[0],C1,0,0,0), P0[6],P0[7],P0[8],P0[9],     pw0[2]=PKW(P0,4), pw0[3]=PKW(P0,6), pw0); \
    VRD(1); SBAR(); GAPA(C0=__builtin_amdgcn_mfma_f32_32x32x16_bf16(kf[2],qr[1],C0,0,0,0),   P0[10],P0[11],P0[12],P0[13], pw1[0]=PKW(P0,8), pw1[1]=PKW(P0,10), pw1); \
    VRD(5); SBAR(); GAPA(C1=__builtin_amdgcn_mfma_f32_32x32x16_bf16(kf[3],qr[1],C1,0,0,0),   P0[14],P0[15],P1[0],P1[1],   pw1[2]=PKW(P0,12),pw1[3]=PKW(P0,14), pw1); \
    VRD(2); SBAR(); GAPA(C0=__builtin_amdgcn_mfma_f32_32x32x16_bf16(kf[4],qr[2],C0,0,0,0),   P1[2],P1[3],P1[4],P1[5],     pw2[0]=PKW(P1,0), pw2[1]=PKW(P1,2), pw2); \
    VRD(6); SBAR(); GAPA(C1=__builtin_amdgcn_mfma_f32_32x32x16_bf16(kf[5],qr[2],C1,0,0,0),   P1[6],P1[7],P1[8],P1[9],     pw2[2]=PKW(P1,4), pw2[3]=PKW(P1,6), pw2); \
    VRD(3); SBAR(); GAPA(C0=__builtin_amdgcn_mfma_f32_32x32x16_bf16(kf[6],qr[3],C0,0,0,0),   P1[10],P1[11],P1[12],P1[13], pw3[0]=PKW(P1,8), pw3[1]=PKW(P1,10), pw3); \
    VRD(7); SBAR(); GAPA(C1=__builtin_amdgcn_mfma_f32_32x32x16_bf16(kf[7],qr[3],C1,0,0,0),   P1[14],P1[15],0.f,0.f,       pw3[2]=PKW(P1,12),pw3[3]=PKW(P1,14), pw3); \
    l_reg+=sacc; \
    if(GK){DMA_K((t)+3,sl_cur);} if(GV){DMA_V((t)+1,sl_next);} \
    CMASK(C0,C1,t); \
    { float a=MX3(C0[0],C0[1],C1[0]),b=MX3(C0[2],C0[3],C1[1]); a=MX3(a,C1[2],C1[3]); \
      _Pragma("unroll") for(int r=4;r<16;r+=4){a=MX3(a,C0[r],C0[r+1]);b=MX3(b,C0[r+2],C0[r+3]);a=MX3(a,C1[r],C1[r+1]);b=MX3(b,C1[r+2],C1[r+3]);} \
      float rm=__builtin_fmaxf(a,b); { auto rr=__builtin_amdgcn_permlane32_swap(__float_as_uint(rm),__float_as_uint(rm),false,false); rm=__builtin_fmaxf(__uint_as_float(rr[0]),__uint_as_float(rr[1])); } \
      resc=false; \
      if(__builtin_expect(__any(rm>(float)THRL),1)){ const float dl=__builtin_fmaxf(rm,0.f); mhat+=dl; \
        _Pragma("unroll") for(int r=0;r<16;++r){C0[r]-=dl;C1[r]-=dl;} \
        const float f=__builtin_amdgcn_exp2f(-dl); l_reg*=f; if(hi==0)wsf[r32]=f; resc=true; } } \
    f32x4 nx_=cbn_[0]; SBAR(); \
    GAPB(o[0]=__builtin_amdgcn_mfma_f32_32x32x16_bf16(PAF(0),VFR(0),o[0],0,0,0), C0,0, P0,0,2); \
    GAPB(o[1]=__builtin_amdgcn_mfma_f32_32x32x16_bf16(PAF(0),VFR(4),o[1],0,0,0), C0,4, P0,1,4); \
    KRD(GL,0); GAPB(o[0]=__builtin_amdgcn_mfma_f32_32x32x16_bf16(PAF(1),VFR(1),o[0],0,0,0), C0,8, P0,2,6); \
    KRD(GL,1); GAPB(o[1]=__builtin_amdgcn_mfma_f32_32x32x16_bf16(PAF(1),VFR(5),o[1],0,0,0), C0,12, P0,3,8); \
    KRD(GL,2); GAPB(o[0]=__builtin_amdgcn_mfma_f32_32x32x16_bf16(PAF(2),VFR(2),o[0],0,0,0), C1,0, P1,0,10); \
    KRD(GL,3); GAPB(o[1]=__builtin_amdgcn_mfma_f32_32x32x16_bf16(PAF(2),VFR(6),o[1],0,0,0), C1,4, P1,1,12); \
    GAPB(o[0]=__builtin_amdgcn_mfma_f32_32x32x16_bf16(PAF(3),VFR(3),o[0],0,0,0), C1,8, P1,2,14); \
    GAPB(o[1]=__builtin_amdgcn_mfma_f32_32x32x16_bf16(PAF(3),VFR(7),o[1],0,0,0), C1,12, P1,3,14); \
    }while(0)
  int t=1;
  #undef CMASK
  #define CMASK(P0,P1,t) do{}while(0)
  for(;t+5<NT;t+=2){
    STEP(pB0,pB1,pA0,pA1,t,true,true,true);     WAIT_BAR(2); RESC(); ROT();
    STEP(pA0,pA1,pB0,pB1,t+1,true,true,true);   WAIT_BAR(2); RESC(); ROT();
  }
  #undef CMASK
  #define CMASK(P0,P1,t) do{int jb_=(t)-(NT-4); if(jb_>=0)cmask(P0,P1,jb_,qrel,hi);}while(0)
  #define ENDW(tt) do{ if((tt)+3<NT){WAIT_BAR(2);} else if((tt)+2<NT){WAIT_BAR(1);} else {WAIT_BAR(0);} }while(0)
  for(;t+1<NT;t+=2){
    STEP(pB0,pB1,pA0,pA1,t,(t+3<NT),(t+1<NT),(t+1<NT));       ENDW(t);   RESC(); ROT();
    STEP(pA0,pA1,pB0,pB1,t+1,(t+4<NT),(t+2<NT),(t+2<NT));     ENDW(t+1); RESC(); ROT();
  }
  STEP(pB0,pB1,pA0,pA1,NT-1,false,false,false); RESC();
  { float sacc=pB0[0]+pB0[1]; _Pragma("unroll") for(int r=2;r<16;++r)sacc+=pB0[r]; _Pragma("unroll") for(int r=0;r<16;++r)sacc+=pB1[r]; l_reg+=sacc;
    pw0=(u32x4){PKW(pB0,0),PKW(pB0,2),PKW(pB0,4),PKW(pB0,6)};pw1=(u32x4){PKW(pB0,8),PKW(pB0,10),PKW(pB0,12),PKW(pB0,14)};pw2=(u32x4){PKW(pB1,0),PKW(pB1,2),PKW(pB1,4),PKW(pB1,6)};pw3=(u32x4){PKW(pB1,8),PKW(pB1,10),PKW(pB1,12),PKW(pB1,14)};
    SBAR(); pv(o,vb0+sl_cur,PAF(0),PAF(1),PAF(2),PAF(3)); }
  #undef PKW
  #undef PAF
  #undef VFR
  #undef PIN
  #undef MX3
  #undef GAPA
  #undef GAPB
  #undef EX
  #undef VRD
  #undef KRD
  #undef STEP
  #undef ENDW
  {auto rr=__builtin_amdgcn_permlane32_swap(__float_as_uint(l_reg),__float_as_uint(l_reg),false,false);l_reg=__uint_as_float(rr[0])+__uint_as_float(rr[1]);}
  if(hi==0)wsf[32+r32]=l_reg;asm volatile("s_waitcnt lgkmcnt(0)":::"memory");
  float rli[16];
  #pragma unroll
  for(int r=0;r<16;++r)rli[r]=__builtin_amdgcn_rcpf(wsf[32+crow(r,hi)]);
  bf16*Ow=O+(rowbase+q0+wid*QBLK)*ODM+h*D; const bf16*Gw=G+(rowbase+q0+wid*QBLK)*DM+h*D;
  { const lds_fw stg=(lds_fw)(shm3w+LDS_OST)+wid*2048;
    #pragma unroll
    for(int r=0;r<16;++r){const int orow=crow(r,hi);
      #pragma unroll
      for(int d0=0;d0<2;++d0)stg[orow*64+d0*32+r32]=o[d0][r]*rli[r];}
    asm volatile("s_waitcnt lgkmcnt(0)":::"memory");
    int le=lane; asm volatile("":"+v"(le));
    const int ch=le&7; const f32x4 g0=*(const f32x4*)(gain+h*D+ch*8), g1=*(const f32x4*)(gain+h*D+ch*8+4);
    #pragma unroll
    for(int i=0;i<4;++i){const int row=i*8+(le>>3);
      const f32x4 a=*(lds_f4c)(stg+row*64+ch*8), c=*(lds_f4c)(stg+row*64+ch*8+4);
      const u32x4 gw=*(const u32x4*)(Gw+(long)row*DM+ch*8);
      float ss=(a.x*a.x+a.y*a.y)+(a.z*a.z+a.w*a.w)+(c.x*c.x+c.y*c.y)+(c.z*c.z+c.w*c.w);
      ss+=__shfl_xor(ss,1);ss+=__shfl_xor(ss,2);ss+=__shfl_xor(ss,4);
      const float rstd=__builtin_amdgcn_rsqf(ss*(1.f/64.f)+1e-6f);
      float gt[8];
      #pragma unroll
      for(int e=0;e<4;++e){ const unsigned w=gw[e]; const float lo=__uint_as_float(w<<16), hi_=__uint_as_float(w&0xffff0000u);
        gt[2*e]=__builtin_amdgcn_rcpf(1.f+__builtin_amdgcn_exp2f(-1.4426950408889634f*lo)); gt[2*e+1]=__builtin_amdgcn_rcpf(1.f+__builtin_amdgcn_exp2f(-1.4426950408889634f*hi_)); }
      u32x4 v; v.x=cvtpk_s(a.x*rstd*g0.x*gt[0],a.y*rstd*g0.y*gt[1]); v.y=cvtpk_s(a.z*rstd*g0.z*gt[2],a.w*rstd*g0.w*gt[3]);
      v.z=cvtpk_s(c.x*rstd*g1.x*gt[4],c.y*rstd*g1.y*gt[5]); v.w=cvtpk_s(c.z*rstd*g1.z*gt[6],c.w*rstd*g1.w*gt[7]);
      ATTN_STORE16(Ow+(long)row*ODM+ch*8,v);} }
  asm volatile("s_waitcnt lgkmcnt(0)\n\ts_barrier":::"memory");
  #undef DMA_K
  #undef DMA_V
  #undef CMASK
  #undef START
  #undef CINIT
  #undef RESC
  #undef ROT
}
constexpr int ATTN_LDS_BYTES=LDS_BYTES;
#undef SBAR
#undef WAIT_BAR
}

namespace ret_body {
#define RB_LAS __attribute__((address_space(3)))
typedef unsigned short bf16;
typedef short bf16x8 __attribute__((ext_vector_type(8)));
typedef short s16x4 __attribute__((ext_vector_type(4)));
typedef float f32x16 __attribute__((ext_vector_type(16)));
typedef float f32x4 __attribute__((ext_vector_type(4)));
typedef unsigned u32x4 __attribute__((ext_vector_type(4)));
typedef unsigned u32x2 __attribute__((ext_vector_type(2)));
typedef RB_LAS unsigned char* lptr;
constexpr int DM = 4096, ODM = 1024, SEQ = 2048, CH = 128;
constexpr int L_K = 0, L_V = 32768, L_T = 65536, L_STG = 98304, L_SSQ = 132096, RET_LDS_END = 133120;
__device__ __forceinline__ unsigned offb(unsigned row, unsigned ch) { return 2048u * (row >> 3) + 512u * (ch >> 2) + 64u * (row & 7u) + 16u * ((ch & 3u) ^ ((row >> 2) & 3u)); }
__device__ __forceinline__ int crow(int r, int hi) { return (r & 3) + 8 * (r >> 2) + 4 * hi; }
__device__ __forceinline__ s16x4 trr(lptr p) { typedef short v4i16_t __attribute__((ext_vector_type(4))); return __builtin_bit_cast(s16x4, __builtin_amdgcn_ds_read_tr16_b64_v4i16((RB_LAS v4i16_t*)p)); }
typedef float f32x2_t __attribute__((ext_vector_type(2))); typedef __bf16 bf16x2_t __attribute__((ext_vector_type(2)));
__device__ __forceinline__ unsigned cvtpk(float lo, float hi) { f32x2_t v = {lo, hi}; bf16x2_t b = __builtin_convertvector(v, bf16x2_t); return __builtin_bit_cast(unsigned, b); }
#define RB_MFMA(a, b, c) __builtin_amdgcn_mfma_f32_32x32x16_bf16((a), (b), (c), 0, 0, 0)
#define RB_BAR() asm volatile("s_waitcnt vmcnt(0) lgkmcnt(0)\n\ts_barrier" ::: "memory")

__device__ __forceinline__ void ret_unit(int b, const bf16* __restrict__ P, int cq, int ck, int cv, int cg, const float* __restrict__ gain, bf16* __restrict__ O, float lg2, unsigned char* lds_generic) {
    int tid_ = threadIdx.x; asm volatile("" : "+v"(tid_));
    const int tid = tid_, lane = tid & 63, r32 = lane & 31, hi = lane >> 5; const int wid = __builtin_amdgcn_readfirstlane(tid >> 6);
    const int qw = (wid < 4) ? wid : 7 - wid, dvh = wid >> 2, dkq = wid & 3;
    const lptr L = (lptr)lds_generic;
    const float gC = exp2f(128.f * lg2);
    const size_t rowbase = (size_t)b * SEQ;
    const unsigned blk = (lane >> 4) & 1, q4 = (lane & 15) >> 2, p4 = lane & 3;
    const unsigned Y = (r32 >> 2) & 3u, rbase = 2048u * (r32 >> 3) + 64u * (r32 & 7u);
    const unsigned rd_e = rbase + 16u * ((unsigned)hi ^ Y), rd_o = rbase + 16u * ((2u + hi) ^ Y);
    const unsigned xc = 2u * blk + (p4 >> 1);
    const unsigned tn0 = 2048u * hi + 64u * q4 + 16u * (xc ^ (2u * hi)) + 8u * (p4 & 1), tn1 = 2048u * hi + 256u + 64u * q4 + 16u * (xc ^ (2u * hi + 1u)) + 8u * (p4 & 1);
    const unsigned tp0 = 256u * hi + 64u * q4 + 16u * (xc ^ (unsigned)hi) + 8u * (p4 & 1), tp1 = 2048u + 256u * hi + 64u * q4 + 16u * (xc ^ (2u + hi)) + 8u * (p4 & 1);
    const unsigned aT_e = L_T + 16384u * dvh + rd_e, aT_o = L_T + 16384u * dvh + rd_o, aK_e = L_K + rd_e, aK_o = L_K + rd_o;
    const unsigned aVp0 = L_V + 1024u * dvh + tp0, aVp1 = L_V + 1024u * dvh + tp1, aVn0 = L_V + 1024u * dvh + tn0, aVn1 = L_V + 1024u * dvh + tn1, aKn0 = L_K + 512u * dkq + tn0, aKn1 = L_K + 512u * dkq + tn1;
    unsigned wg[4];
#pragma unroll
    for (int g = 0; g < 4; ++g) wg[g] = rbase + 16u * ((unsigned)g ^ Y) + 8u * hi;
    for (int i = tid; i < 2048; i += 512) *(RB_LAS u32x4*)(L + L_T + 16 * i) = (u32x4){0u, 0u, 0u, 0u};
    f32x16 t0, t1;
#pragma unroll
    for (int r = 0; r < 16; ++r) { t0[r] = 0.f; t1[r] = 0.f; }
    u32x4 kpre[4], vpre[4];
#define RB_LOADKV(c) do { _Pragma("unroll") for (int i_ = 0; i_ < 4; ++i_) { const int id_ = tid + 512 * i_; const size_t g_ = (rowbase + (size_t)(c) * CH + (id_ >> 4)) * DM + (id_ & 15) * 8; \
        kpre[i_] = *(const u32x4*)(P + g_ + ck); vpre[i_] = *(const u32x4*)(P + g_ + cv); } } while (0)
#define RB_STOREKV() do { _Pragma("unroll") for (int i_ = 0; i_ < 4; ++i_) { const int id_ = tid + 512 * i_; const unsigned o_ = offb(id_ >> 4, id_ & 15); \
        *(RB_LAS u32x4*)(L + L_K + o_) = kpre[i_]; *(RB_LAS u32x4*)(L + L_V + o_) = vpre[i_]; } } while (0)
    RB_LOADKV(0); RB_STOREKV();
    bf16x8 qf[8];
#define RB_LOADQ(c) do { const bf16* q_ = P + (rowbase + (size_t)(c) * CH + 32 * qw + r32) * DM + cq + 8 * hi; _Pragma("unroll") for (int s_ = 0; s_ < 8; ++s_) qf[s_] = *(const bf16x8*)(q_ + 16 * s_); } while (0)
    RB_LOADQ(0);
    RB_BAR();
    for (int c = 0; c < 16; ++c) {
        if (c + 1 < 16) RB_LOADKV(c + 1);
        u32x2 gt[2][4];
        { const bf16* g_ = P + (rowbase + (size_t)c * CH + 32 * qw + r32) * DM + cg + 64 * dvh + 4 * hi;
#pragma unroll
          for (int cc = 0; cc < 2; ++cc)
#pragma unroll
              for (int g = 0; g < 4; ++g) gt[cc][g] = *(const u32x2*)(g_ + 32 * cc + 8 * g); }
        f32x16 o0, o1;
#pragma unroll
        for (int r = 0; r < 16; ++r) { o0[r] = 0.f; o1[r] = 0.f; }
#pragma unroll
        for (int s = 0; s < 8; ++s) {
            const bf16x8 a0 = *(const RB_LAS bf16x8*)(L + ((s & 1) ? aT_o : aT_e) + 512 * (s >> 1));
            const bf16x8 a1 = *(const RB_LAS bf16x8*)(L + ((s & 1) ? aT_o : aT_e) + 8192 + 512 * (s >> 1));
            o0 = RB_MFMA(a0, qf[s], o0); o1 = RB_MFMA(a1, qf[s], o1);
        }
#pragma unroll
        for (int kb = 0; kb < 4; ++kb) if (kb <= qw) {
            f32x16 p;
#pragma unroll
            for (int r = 0; r < 16; ++r) p[r] = 0.f;
#pragma unroll
            for (int s = 0; s < 8; ++s) { const bf16x8 kf = *(const RB_LAS bf16x8*)(L + ((s & 1) ? aK_o : aK_e) + 8192 * kb + 512 * (s >> 1)); p = RB_MFMA(kf, qf[s], p); }
            if (kb == qw) {
#pragma unroll
                for (int r = 0; r < 16; ++r) if (crow(r, hi) > r32) p[r] = 0.f;
            }
            u32x4 pw0, pw1;
            pw0.x = cvtpk(p[0], p[1]); pw0.y = cvtpk(p[2], p[3]); pw0.z = cvtpk(p[4], p[5]); pw0.w = cvtpk(p[6], p[7]);
            pw1.x = cvtpk(p[8], p[9]); pw1.y = cvtpk(p[10], p[11]); pw1.z = cvtpk(p[12], p[13]); pw1.w = cvtpk(p[14], p[15]);
            const bf16x8 pf0 = __builtin_bit_cast(bf16x8, pw0), pf1 = __builtin_bit_cast(bf16x8, pw1);
#pragma unroll
            for (int s = 0; s < 2; ++s) {
#pragma unroll
                for (int cc = 0; cc < 2; ++cc) {
                    const s16x4 lo = trr(L + aVp0 + 4096 * (2 * kb + s) + 512 * cc), hh = trr(L + aVp1 + 4096 * (2 * kb + s) + 512 * cc);
                    const bf16x8 vf = (bf16x8){lo[0], lo[1], lo[2], lo[3], hh[0], hh[1], hh[2], hh[3]};
                    if (cc == 0) o0 = RB_MFMA(vf, s == 0 ? pf0 : pf1, o0); else o1 = RB_MFMA(vf, s == 0 ? pf0 : pf1, o1);
                }
            }
        }
        if (c + 1 < 16) RB_LOADQ(c + 1);
        { float ss = 0.f;
#pragma unroll
          for (int r = 0; r < 16; ++r) ss += o0[r] * o0[r] + o1[r] * o1[r];
          auto rr = __builtin_amdgcn_permlane32_swap(__float_as_uint(ss), __float_as_uint(ss), false, false);
          ss = __uint_as_float(rr[0]) + __uint_as_float(rr[1]);
          if (hi == 0) *(RB_LAS float*)(L + L_SSQ + 4 * (128 * dvh + 32 * qw + r32)) = ss; }
#pragma unroll
        for (int ks = 0; ks < 8; ++ks) {
            const s16x4 klo = trr(L + aKn0 + 4096 * ks), khh = trr(L + aKn1 + 4096 * ks);
            const bf16x8 kf = (bf16x8){klo[0], klo[1], klo[2], klo[3], khh[0], khh[1], khh[2], khh[3]};
#pragma unroll
            for (int cc = 0; cc < 2; ++cc) {
                const s16x4 lo = trr(L + aVn0 + 4096 * ks + 512 * cc), hh = trr(L + aVn1 + 4096 * ks + 512 * cc);
                const bf16x8 vf = (bf16x8){lo[0], lo[1], lo[2], lo[3], hh[0], hh[1], hh[2], hh[3]};
                if (cc == 0) t0 = RB_MFMA(kf, vf, t0); else t1 = RB_MFMA(kf, vf, t1);
            }
        }
#pragma unroll
        for (int r = 0; r < 16; ++r) { t0[r] *= gC; t1[r] *= gC; }
        RB_BAR();
        { const float ssum = *(const RB_LAS float*)(L + L_SSQ + 4 * (32 * qw + r32)) + *(const RB_LAS float*)(L + L_SSQ + 4 * (128 + 32 * qw + r32));
          const float gn = exp2f((float)(32 * qw + r32) * lg2);
          const float rs = gn * rsqrtf(gn * gn * ssum * (1.f / 128.f) + 1e-6f);
#pragma unroll
          for (int cc = 0; cc < 2; ++cc)
#pragma unroll
              for (int g = 0; g < 4; ++g) {
                  const int dv0 = 64 * dvh + 32 * cc + 8 * g + 4 * hi;
                  const f32x4 gn4 = *(const f32x4*)(gain + dv0);
                  const unsigned w0 = gt[cc][g].x, w1 = gt[cc][g].y;
                  const float z0 = __uint_as_float(w0 << 16), z1 = __uint_as_float(w0 & 0xffff0000u), z2 = __uint_as_float(w1 << 16), z3 = __uint_as_float(w1 & 0xffff0000u);
                  const float s0 = z0 * __builtin_amdgcn_rcpf(1.f + __builtin_amdgcn_exp2f(-1.4426950408889634f * z0)), s1 = z1 * __builtin_amdgcn_rcpf(1.f + __builtin_amdgcn_exp2f(-1.4426950408889634f * z1));
                  const float s2 = z2 * __builtin_amdgcn_rcpf(1.f + __builtin_amdgcn_exp2f(-1.4426950408889634f * z2)), s3 = z3 * __builtin_amdgcn_rcpf(1.f + __builtin_amdgcn_exp2f(-1.4426950408889634f * z3));
                  const f32x16& oo = cc == 0 ? o0 : o1;
                  u32x2 w; w.x = cvtpk(oo[4 * g] * rs * gn4.x * s0, oo[4 * g + 1] * rs * gn4.y * s1); w.y = cvtpk(oo[4 * g + 2] * rs * gn4.z * s2, oo[4 * g + 3] * rs * gn4.w * s3);
                  *(RB_LAS u32x2*)(L + L_STG + 8192 * qw + 1024 * dvh + 512 * cc + wg[g]) = w;
              } }
#pragma unroll
        for (int cc = 0; cc < 2; ++cc)
#pragma unroll
            for (int g = 0; g < 4; ++g) { const f32x16& tt = cc == 0 ? t0 : t1;
                u32x2 w; w.x = cvtpk(tt[4 * g], tt[4 * g + 1]); w.y = cvtpk(tt[4 * g + 2], tt[4 * g + 3]);
                *(RB_LAS u32x2*)(L + L_T + 16384 * dvh + 8192 * cc + 512 * dkq + wg[g]) = w; }
        if (c + 1 < 16) RB_STOREKV();
        RB_BAR();
#pragma unroll
        for (int i = 0; i < 4; ++i) { const int id = tid + 512 * i, row = id >> 4, ch = id & 15;
            const u32x4 v = *(const RB_LAS u32x4*)(L + L_STG + offb(row, ch));
            *(u32x4*)(O + (rowbase + (size_t)c * CH + row) * ODM + ch * 8) = v; }
    }
    RB_BAR();
#undef RB_LOADKV
#undef RB_STOREKV
#undef RB_LOADQ
}
#undef RB_MFMA
#undef RB_BAR
}

constexpr int NWAVES = 8;
#ifndef MK_N_LAUNCHES
#define MK_N_LAUNCHES 1
#endif
constexpr int PER_PHASE = 9;
constexpr int N_LAUNCHES = MK_N_LAUNCHES;

constexpr int BATCH = 32, SEQ = 2048, D = 1024, M = BATCH * SEQ, FF = 4096, NPROJ = 4096, IN_COLS = 4104, NMOD = 6 * D;
constexpr float EPS = 1e-6f;
constexpr float LOG2E = 1.4426950408889634f, C2 = 0.18033688011112042f;
constexpr int C_FQ = 0, C_FK = 512, C_FV = 1024, C_FOG = 1536, C_RQ = 2048, C_RK = 2560, C_RV = 3072, C_RG = 3584;
constexpr int MOD_SHIFT_M = 0, MOD_SCALE_M = 1024, MOD_GATE_M = 2048, MOD_SHIFT_F = 3072, MOD_SCALE_F = 4096, MOD_GATE_F = 5120;

constexpr size_t MiB = 1u << 20;
constexpr size_t WS_CTL = 0, CTL_ZERO_BYTES = 2 * MiB;
constexpr size_t WS_MOD = 1 * MiB;
constexpr size_t WS_WIN = 2 * MiB, WS_WOUT = 10 * MiB, WS_W1 = 12 * MiB, WS_W2 = 20 * MiB;
constexpr size_t WS_WF = 28 * MiB;
constexpr size_t WS_ROPE = 29 * MiB;
constexpr size_t WS_LOGF = 30 * MiB, WS_CUM = 32 * MiB;
constexpr size_t WS_H = 64 * MiB, WS_MIX = 192 * MiB, WS_PROJ = 320 * MiB, WS_U = 320 * MiB, WS_END = 832 * MiB;
constexpr int CW_BAR = 4096;

constexpr int RING_OFF = 0, RING_BYTES = 131072;
constexpr int LDSCTL_OFF = RING_BYTES, MISC_OFF = LDSCTL_OFF + 320;
constexpr int LDS_BYTES = 147456;
#define GAS __attribute__((address_space(1)))
#define LAS __attribute__((address_space(3)))
typedef unsigned short bf16;
typedef unsigned v4u __attribute__((ext_vector_type(4)));
typedef float f32x4 __attribute__((ext_vector_type(4)));
typedef short bf16x8 __attribute__((ext_vector_type(8)));
typedef GAS unsigned gu32;
typedef GAS unsigned long long gu64;
#define RLX_AGENT __ATOMIC_RELAXED, __HIP_MEMORY_SCOPE_AGENT
#define LDS_WAIT() asm volatile("s_waitcnt lgkmcnt(0)" ::: "memory")
#define VM_WAIT() asm volatile("s_waitcnt vmcnt(0)" ::: "memory")
__device__ __forceinline__ unsigned long long rt() { return __builtin_amdgcn_s_memrealtime(); }
__device__ __forceinline__ unsigned f2bf(float f) { unsigned u = __builtin_bit_cast(unsigned, f); return (u + 0x7fffu + ((u >> 16) & 1u)) >> 16; }
__device__ __forceinline__ unsigned pk2(float lo, float hi) { return f2bf(lo) | (f2bf(hi) << 16); }

#define XB_TMO      128
#define XB_XCNT(j)  (256  + 64 * (j))
#define XB_XSUB(j)  (1280 + 64 * (j))
#define XB_XGEN(j)  (2304 + 64 * (j))
#define XB_TOP      3328
#define XB_TOPGEN   3392
#define XCD_BAR_WORDS 3456
#define XB_SPIN_CAP (1u << 18)

__device__ __forceinline__ unsigned xb_ld(unsigned* p)              { return __hip_atomic_load(p, __ATOMIC_RELAXED, __HIP_MEMORY_SCOPE_AGENT); }
__device__ __forceinline__ unsigned xb_add(unsigned* p, unsigned v) { return __hip_atomic_fetch_add(p, v, __ATOMIC_RELAXED, __HIP_MEMORY_SCOPE_AGENT); }
__device__ __forceinline__ unsigned xb_xcc_id() { return (unsigned)__builtin_amdgcn_s_getreg((3 << 11) | 20) & 0xFu; }
#define XB_SPIN(cond, bar) do { unsigned _sp = 0; while (cond) { __builtin_amdgcn_s_sleep(1); \
    if ((++_sp & 255u) == 0u) { if (xb_ld(&(bar)[XB_TMO])) break; if (_sp > XB_SPIN_CAP) { atomicAdd(&(bar)[XB_TMO], 1u); break; } } } } while (0)

struct XcdBarrier {
    unsigned* bar; unsigned x;
    volatile LAS unsigned* st;
};

__device__ __forceinline__ XcdBarrier xcd_barrier_post(unsigned* bar, volatile LAS unsigned* st) {
    XcdBarrier b; b.bar = bar; b.x = xb_xcc_id(); b.st = st;
    if (threadIdx.x == 0) (void)xb_add(&bar[XB_XCNT(b.x)], 1u);
    return b;
}
__device__ __forceinline__ void xcd_barrier_complete(unsigned* bar, unsigned x, unsigned& nloc, unsigned& nx) {
    const unsigned G = gridDim.x * gridDim.y * gridDim.z;
    unsigned sum, cnt, mine, sp = 0u;
    for (;;) {
        sum = 0u; cnt = 0u; mine = 0u;
#pragma unroll
        for (unsigned j = 0; j < 16; ++j) { const unsigned c = xb_ld(&bar[XB_XCNT(j)]); sum += c; cnt += (c > 0u) ? 1u : 0u; mine = (j == x) ? c : mine; }
        if (sum == G) break;
        __builtin_amdgcn_s_sleep(1);
        if ((++sp & 255u) == 0u) { if (xb_ld(&bar[XB_TMO])) break; if (sp > XB_SPIN_CAP) { atomicAdd(&bar[XB_TMO], 1u); break; } }
    }
    nloc = mine > 0u ? mine : 1u; nx = cnt > 0u ? cnt : 1u;
}

__device__ __forceinline__ void xcd_barrier(const XcdBarrier& b) {
    asm volatile("s_waitcnt vmcnt(0)" ::: "memory");
    __syncthreads();
    if (threadIdx.x == 0) {
        unsigned* bar = b.bar;
        __builtin_amdgcn_s_waitcnt(0);
        unsigned nloc = b.st[0], nx = b.st[1];
        if (nloc == 0u) { xcd_barrier_complete(bar, b.x, nloc, nx); b.st[0] = nloc; b.st[1] = nx; }
        const unsigned old = xb_add(&bar[XB_XSUB(b.x)], 1u);
        const unsigned gen = old / nloc;
        if (old + 1u == (gen + 1u) * nloc) {
            __builtin_amdgcn_fence(__ATOMIC_RELEASE, "agent");
            asm volatile("s_waitcnt vmcnt(0)" ::: "memory");
            const unsigned og = xb_add(&bar[XB_TOP], 1u);
            const unsigned tg = og / nx;
            if (og + 1u == (tg + 1u) * nx) xb_add(&bar[XB_TOPGEN], 1u);
            else XB_SPIN(xb_ld(&bar[XB_TOPGEN]) == tg, bar);
            __builtin_amdgcn_fence(__ATOMIC_ACQUIRE, "agent");
            xb_add(&bar[XB_XGEN(b.x)], 1u);
            asm volatile("s_waitcnt vmcnt(0)" ::: "memory");
        } else {
            XB_SPIN(xb_ld(&bar[XB_XGEN(b.x)]) == gen, bar);
            __builtin_amdgcn_fence(__ATOMIC_ACQUIRE, "agent");
            asm volatile("s_waitcnt vmcnt(0)" ::: "memory");
        }
    }
    __syncthreads();
}

struct Frame {
    LAS unsigned char* lds;
    volatile LAS unsigned* MISC;
    gu32* ctl;
    int tid, lane, wave;
    int vcu, G;
    const float *x, *c, *w_ada, *b_ada, *w_in, *b_forget, *qg, *kg, *fog, *rog, *w_out, *w1, *w2; float* out;
    bf16 *Win_t, *Wout_t, *W1_t, *W2_t;
    float *wf, *rope, *logf, *cum, *mod;
    bf16 *H, *MIXB, *PROJ, *U;
};
__device__ __forceinline__ float bf2f(unsigned short v) { return __uint_as_float((unsigned)v << 16); }
__device__ __forceinline__ float bflo(unsigned w) { return __uint_as_float(w << 16); }
__device__ __forceinline__ float bfhi(unsigned w) { return __uint_as_float(w & 0xffff0000u); }
__device__ __forceinline__ void unpack8(const v4u w, float* f) { f[0] = bflo(w.x); f[1] = bfhi(w.x); f[2] = bflo(w.y); f[3] = bfhi(w.y); f[4] = bflo(w.z); f[5] = bfhi(w.z); f[6] = bflo(w.w); f[7] = bfhi(w.w); }
__device__ __forceinline__ v4u pack8(const float* f) { v4u w; w.x = pk2(f[0], f[1]); w.y = pk2(f[2], f[3]); w.z = pk2(f[4], f[5]); w.w = pk2(f[6], f[7]); return w; }

template <bool LINEMAP> __device__ __forceinline__ void p0_transpose_item(const float* W, int K, int ldn, int col_off, int nblk, bf16* WT, int row_off, LAS float* scr, int item, int lane) {
    const int kb = item / nblk, nb = item % nblk, k0 = 64 * kb, n0 = 32 * nb;
    const int c0 = row_off + n0; const int drow = LINEMAP ? (c0 & ~255) + 128 * ((c0 >> 5) & 1) + 32 * ((c0 & 255) >> 6) : c0;
#pragma unroll 8
    for (int i = 0; i < 32; ++i) { const int kk = 2 * i + (lane >> 5); scr[kk * 33 + (lane & 31)] = W[(size_t)(k0 + kk) * ldn + col_off + n0 + (lane & 31)]; }
    LDS_WAIT(); asm volatile("" ::: "memory");
    const int c = lane & 7;
#pragma unroll
    for (int j = 0; j < 4; ++j) { const int n = (lane >> 3) + 8 * j; const LAS float* s = scr + (8 * c) * 33 + n;
        v4u o; o.x = pk2(s[0 * 33], s[1 * 33]); o.y = pk2(s[2 * 33], s[3 * 33]); o.z = pk2(s[4 * 33], s[5 * 33]); o.w = pk2(s[6 * 33], s[7 * 33]);
        *(GAS v4u*)(WT + (size_t)(drow + n) * K + k0 + 8 * c) = o; }
    LDS_WAIT(); asm volatile("" ::: "memory");
}
__device__ __forceinline__ void p0_mod_item(Frame& F, LAS float* scr, int item) {
    const int cg = item % 96, ks = item / 96; const int e = cg * 64 + F.lane, k0 = ks * 128;
#pragma unroll 4
    for (int i = 0; i < 64; ++i) { const int idx = i * 64 + F.lane; const int kk = idx >> 5, b = idx & 31; const float cv = F.c[b * D + k0 + kk]; scr[idx] = cv / (1.f + expf(-cv)); }
    LDS_WAIT(); asm volatile("" ::: "memory");
    float acc[32];
#pragma unroll
    for (int b = 0; b < 32; ++b) acc[b] = 0.f;
#pragma unroll 4
    for (int kk = 0; kk < 128; ++kk) { const float w = F.w_ada[(size_t)(k0 + kk) * NMOD + e];
#pragma unroll
        for (int b4 = 0; b4 < 8; ++b4) { const f32x4 s = *(const LAS f32x4*)(scr + kk * 32 + 4 * b4);
            acc[4 * b4 + 0] += s.x * w; acc[4 * b4 + 1] += s.y * w; acc[4 * b4 + 2] += s.z * w; acc[4 * b4 + 3] += s.w * w; } }
    const float bias = (ks == 0) ? F.b_ada[e] : 0.f;
#pragma unroll
    for (int b = 0; b < 32; ++b) atomicAdd(&F.mod[b * NMOD + e], acc[b] + bias);
    LDS_WAIT(); asm volatile("" ::: "memory");
}
__device__ __forceinline__ void p0_rope_item(Frame& F, int s) {
    const int j = F.lane;
    double f = 1.0, p = 0.86596432336006535; int e = j;
#pragma unroll
    for (int bit = 0; bit < 6; ++bit) { if (e & 1) f *= p; p *= p; e >>= 1; }
    const double ang = (double)s * f;
    const double kq = rint(ang * 0.63661977236758134);
    const double r = fma(-kq, 1.5707963267948966, ang) - kq * 6.123233995736766e-17;
    const double r2 = r * r;
    const double sn = r * (1.0 + r2 * (-1.0 / 6.0 + r2 * (1.0 / 120.0 + r2 * (-1.0 / 5040.0 + r2 * (1.0 / 362880.0 + r2 * (-1.0 / 39916800.0 + r2 * (1.0 / 6227020800.0)))))));
    const double cs = 1.0 + r2 * (-0.5 + r2 * (1.0 / 24.0 + r2 * (-1.0 / 720.0 + r2 * (1.0 / 40320.0 + r2 * (-1.0 / 3628800.0 + r2 * (1.0 / 479001600.0 + r2 * (-1.0 / 87178291200.0)))))));
    const int q = ((int)kq) & 3;
    const double S = (q == 0) ? sn : (q == 1) ? cs : (q == 2) ? -sn : -cs;
    const double C = (q == 0) ? cs : (q == 1) ? -sn : (q == 2) ? -cs : sn;
    F.rope[s * 128 + j] = (float)C; F.rope[s * 128 + 64 + j] = (float)S;
}
__device__ __forceinline__ void p0_prologue(Frame& F) {
    LAS float* scr = (LAS float*)(F.lds + RING_OFF + F.wave * 16384);
    const int gw = F.vcu * NWAVES + F.wave, NGW = F.G * NWAVES;
    constexpr int I_INA = (D / 64) * (2048 / 32), I_INB = I_INA, I_O = (D / 64) * (D / 32), I_1 = (D / 64) * (FF / 32), I_2 = (FF / 64) * (D / 32);
    constexpr int I_MOD = 96 * 8, I_ROPE = SEQ, I_WF = 8;
    constexpr int NITEMS = I_MOD + I_INA + I_INB + I_O + I_1 + I_2 + I_ROPE + I_WF;
    for (int it = gw; it < NITEMS; it += NGW) {
        int r = it;
        if (r < I_MOD) { p0_mod_item(F, scr, r); continue; } r -= I_MOD;
        if (r < I_INA) { p0_transpose_item<true>(F.w_in, D, IN_COLS, 0, 2048 / 32, F.Win_t, 0, scr, r, F.lane); continue; } r -= I_INA;
        if (r < I_INB) { p0_transpose_item<true>(F.w_in, D, IN_COLS, 2056, 2048 / 32, F.Win_t, 2048, scr, r, F.lane); continue; } r -= I_INB;
        if (r < I_O) { p0_transpose_item<false>(F.w_out, D, D, 0, D / 32, F.Wout_t, 0, scr, r, F.lane); continue; } r -= I_O;
        if (r < I_1) { p0_transpose_item<true>(F.w1, D, FF, 0, FF / 32, F.W1_t, 0, scr, r, F.lane); continue; } r -= I_1;
        if (r < I_2) { p0_transpose_item<false>(F.w2, FF, D, 0, D / 32, F.W2_t, 0, scr, r, F.lane); continue; } r -= I_2;
        if (r < I_ROPE) { p0_rope_item(F, r); continue; } r -= I_ROPE;
        { for (int k = F.lane; k < D; k += 64) F.wf[r * D + k] = F.w_in[(size_t)k * IN_COLS + 2048 + r]; }
    }
}

__device__ __forceinline__ float wave_sum(float v) {
#pragma unroll
    for (int o = 1; o < 64; o <<= 1) v += __shfl_xor(v, o);
    return v;
}
__device__ __forceinline__ float reduce8(const float* p, int lane) {
    const bool b0 = lane & 1, b1 = lane & 2, b2 = lane & 4;
    float q[4], r[2];
#pragma unroll
    for (int i = 0; i < 4; ++i) { const float send = b0 ? p[i] : p[i + 4], keep = b0 ? p[i + 4] : p[i]; q[i] = keep + __shfl_xor(send, 1); }
#pragma unroll
    for (int i = 0; i < 2; ++i) { const float send = b1 ? q[i] : q[i + 2], keep = b1 ? q[i + 2] : q[i]; r[i] = keep + __shfl_xor(send, 2); }
    const float send = b2 ? r[0] : r[1], keep = b2 ? r[1] : r[0];
    float s = keep + __shfl_xor(send, 4);
    s += __shfl_xor(s, 8); s += __shfl_xor(s, 16); s += __shfl_xor(s, 32);
    return s;
}
template <bool FORGET> __device__ __forceinline__ void norm_phase(Frame& F, const float* xin, int mod_scale, int mod_shift) {
    LAS float* sc = (LAS float*)F.lds; LAS float* sh = sc + 1024; LAS float* wfl = sh + 1024; LAS float* bfl = wfl + 8192;
    for (int chunk = F.vcu; chunk < M / 256; chunk += F.G) {
        const int b = chunk >> 3;
        __syncthreads();
        for (int i = F.tid; i < 1024; i += NWAVES * 64) { sc[i] = 1.f + F.mod[b * NMOD + mod_scale + i]; sh[i] = F.mod[b * NMOD + mod_shift + i]; }
        if (FORGET) { for (int i = F.tid; i < 8192; i += NWAVES * 64) wfl[i] = F.wf[i]; if (F.tid < 8) bfl[F.tid] = F.b_forget[F.tid]; }
        __syncthreads();
        for (int rp = 0; rp < 32; ++rp) {
            const int row = chunk * 256 + F.wave * 32 + rp;
            const GAS f32x4* xr = (const GAS f32x4*)(xin + (size_t)row * D) + F.lane;
            f32x4 v[4]; float ss = 0.f;
#pragma unroll
            for (int j = 0; j < 4; ++j) { v[j] = xr[64 * j]; ss += (v[j].x * v[j].x + v[j].y * v[j].y) + (v[j].z * v[j].z + v[j].w * v[j].w); }
            const float rstd = rsqrtf(wave_sum(ss) * (1.f / D) + EPS);
            GAS unsigned long long* o8 = (GAS unsigned long long*)(F.H + (size_t)row * D) + F.lane;
#pragma unroll
            for (int j = 0; j < 4; ++j) { const f32x4 s4 = *(const LAS f32x4*)(sc + 4 * F.lane + 256 * j), h4 = *(const LAS f32x4*)(sh + 4 * F.lane + 256 * j);
                v[j] = v[j] * rstd * s4 + h4;
                o8[64 * j] = (unsigned long long)pk2(v[j].x, v[j].y) | ((unsigned long long)pk2(v[j].z, v[j].w) << 32); }
            if (FORGET) {
                float p[8];
#pragma unroll
                for (int hh = 0; hh < 8; ++hh) { float a = 0.f;
#pragma unroll
                    for (int j = 0; j < 4; ++j) { const f32x4 w4 = *(const LAS f32x4*)(wfl + hh * 1024 + 4 * F.lane + 256 * j); a += (v[j].x * w4.x + v[j].y * w4.y) + (v[j].z * w4.z + v[j].w * w4.w); }
                    p[hh] = a; }
                const float tot = reduce8(p, F.lane);
                if (F.lane < 8) { const int hs = 4 * (F.lane & 1) + 2 * ((F.lane >> 1) & 1) + ((F.lane >> 2) & 1);
                    const float z = tot + bfl[hs];
                    const float lf = fminf(z, 0.f) - log1pf(expf(-fabsf(z)));
                    F.logf[((size_t)(b * 8 + hs)) * SEQ + (row & (SEQ - 1))] = lf; }
            }
        }
    }
}
__device__ __forceinline__ void cumsum_seq(Frame& F, int seq) {
    const float* src = F.logf + (size_t)seq * SEQ + 32 * F.lane; float* dst = F.cum + (size_t)seq * SEQ + 32 * F.lane;
    double run = 0.0; float v[32];
#pragma unroll
    for (int i = 0; i < 8; ++i) { const f32x4 t = *(const f32x4*)(src + 4 * i); v[4 * i] = t.x; v[4 * i + 1] = t.y; v[4 * i + 2] = t.z; v[4 * i + 3] = t.w; }
#pragma unroll
    for (int i = 0; i < 32; ++i) run += (double)v[i];
    double t = run;
#pragma unroll
    for (int o = 1; o < 64; o <<= 1) { const double n = __shfl_up(t, o); if (F.lane >= o) t += n; }
    double acc = t - run;
#pragma unroll
    for (int i = 0; i < 8; ++i) { f32x4 o4; acc += (double)v[4 * i]; o4.x = (float)(acc * 1.4426950408889634); acc += (double)v[4 * i + 1]; o4.y = (float)(acc * 1.4426950408889634);
        acc += (double)v[4 * i + 2]; o4.z = (float)(acc * 1.4426950408889634); acc += (double)v[4 * i + 3]; o4.w = (float)(acc * 1.4426950408889634); *(f32x4*)(dst + 4 * i) = o4; }
}

__device__ __forceinline__ void post_row(Frame& F, size_t row) {
    bf16* p = F.PROJ + row * NPROJ; const int lane = F.lane; const int s = (int)(row & (SEQ - 1));
    {
        const int hd = lane >> 2, sl = lane & 3; bf16* a = p + hd * 64 + sl * 16;
        float v[16]; unpack8(*(const v4u*)a, v); unpack8(*(const v4u*)(a + 8), v + 8);
        float ss = 0.f;
#pragma unroll
        for (int i = 0; i < 16; ++i) ss += v[i] * v[i];
        ss += __shfl_xor(ss, 1); ss += __shfl_xor(ss, 2);
        const float rstd = rsqrtf(ss * (1.f / 64.f) + EPS);
        const float* g = ((hd < 8) ? F.qg : F.kg) + sl * 16; const float scl = (hd < 8) ? C2 * rstd : rstd;
#pragma unroll
        for (int i = 0; i < 16; ++i) v[i] = v[i] * scl * g[i];
        *(v4u*)a = pack8(v); *(v4u*)(a + 8) = pack8(v + 8);
    }
    {
        const int hh = lane >> 3, i0 = (lane & 7) * 8; bf16* a = p + C_RQ + hh * 128 + i0;
        float x1[8], x2[8]; unpack8(*(const v4u*)a, x1); unpack8(*(const v4u*)(a + 64), x2);
        const float* ct = F.rope + s * 128 + i0; const float* st = ct + 64;
        const int hk = hh & 3; const float lg2 = (hk == 0) ? -0.04580368961312479f : (hk == 1) ? -0.02272007650008353f : (hk == 2) ? -0.011315313227834146f : -0.005646563141142063f;
        const float scl = (hh >= 4) ? 0.08838834764831845f * exp2f(-lg2 * (float)(s & 127)) : 1.f;
        float y1[8], y2[8];
#pragma unroll
        for (int i = 0; i < 8; ++i) { const float c = ct[i], sn = st[i]; y1[i] = (x1[i] * c - x2[i] * sn) * scl; y2[i] = (x1[i] * sn + x2[i] * c) * scl; }
        *(v4u*)a = pack8(y1); *(v4u*)(a + 64) = pack8(y2);
    }
}

__device__ __forceinline__ void fox_item(Frame& F, unsigned char* lds_generic, int bh, int qb) {
    attn_body::attn_unit<8>(bh >> 3, bh & 7, qb, (const attn_body::bf16*)(F.PROJ + C_FQ), (const attn_body::bf16*)(F.PROJ + C_FK), (const attn_body::bf16*)(F.PROJ + C_FV),
                            (const attn_body::bf16*)(F.PROJ + C_FOG), F.cum, F.fog, (attn_body::bf16*)F.MIXB, (char*)lds_generic + RING_OFF);
}
__device__ __forceinline__ void ret_item(Frame& F, unsigned char* lds_generic, int bh) {
    const int b = bh >> 2, h = bh & 3;
    const float lg2 = (h == 0) ? -0.04580368961312479f : (h == 1) ? -0.02272007650008353f : (h == 2) ? -0.011315313227834146f : -0.005646563141142063f;
    ret_body::ret_unit(b, F.PROJ, C_RQ + h * 128, C_RK + h * 128, C_RV + h * 128, C_RG + h * 128, F.rog + h * 128, F.MIXB + 512 + h * 128, lg2, lds_generic + RING_OFF);
}
__device__ __forceinline__ void mixer_phase(Frame& F, unsigned char* lds_generic) {
    static_assert(attn_body::ATTN_LDS_BYTES <= RING_BYTES && ret_body::RET_LDS_END <= LDS_BYTES, "mixer LDS");
    if (F.G == 256) {
        const int j = F.vcu >> 1;
        if ((F.vcu & 1) == 0) {
            ret_item(F, lds_generic, j);
            const unsigned long long A = 0xAC5E7ull;
            for (int i = 0; i < 5; ++i) { const int it = (int)(A >> (4 * i)) & 15; fox_item(F, lds_generic, 2 * j + (it >> 3), it & 7); }
        } else {
            const unsigned long long B = 0x80912B34D6Full;
            for (int i = 0; i < 11; ++i) { const int it = (int)(B >> (4 * i)) & 15; fox_item(F, lds_generic, 2 * j + (it >> 3), it & 7); }
        }
    } else {
        for (int u = F.vcu; u < BATCH * 4; u += F.G) ret_item(F, lds_generic, u);
        for (int bh = F.vcu; bh < BATCH * 8; bh += F.G) for (int qb = 7; qb >= 0; --qb) fox_item(F, lds_generic, bh, qb);
    }
}

struct Args { const float* in[13]; float* out; unsigned char* ws; int ph_lo, ph_hi, li, pad; };
__global__ void __launch_bounds__(NWAVES * 64, 2) skel_fwd(Args args) {
    extern __shared__ __attribute__((aligned(16))) unsigned char lds[];
    Frame F;
    F.lds = (LAS unsigned char*)lds;
    F.MISC = (volatile LAS unsigned*)(F.lds + MISC_OFF);
    F.tid = threadIdx.x; F.lane = F.tid & 63; F.wave = __builtin_amdgcn_readfirstlane(F.tid >> 6);
    F.G = gridDim.x; { const int bx = blockIdx.x; F.vcu = (F.G % 8 == 0) ? (bx % 8) * (F.G / 8) + bx / 8 : bx; }
    unsigned char* ws = args.ws;
    F.ctl = (gu32*)(ws + WS_CTL);
    F.x = args.in[0]; F.c = args.in[1]; F.w_ada = args.in[2]; F.b_ada = args.in[3]; F.w_in = args.in[4]; F.b_forget = args.in[5]; F.qg = args.in[6]; F.kg = args.in[7];
    F.fog = args.in[8]; F.rog = args.in[9]; F.w_out = args.in[10]; F.w1 = args.in[11]; F.w2 = args.in[12]; F.out = args.out;
    F.Win_t = (bf16*)(ws + WS_WIN); F.Wout_t = (bf16*)(ws + WS_WOUT); F.W1_t = (bf16*)(ws + WS_W1); F.W2_t = (bf16*)(ws + WS_W2);
    F.wf = (float*)(ws + WS_WF); F.rope = (float*)(ws + WS_ROPE); F.logf = (float*)(ws + WS_LOGF); F.cum = (float*)(ws + WS_CUM); F.mod = (float*)(ws + WS_MOD);
    F.H = (bf16*)(ws + WS_H); F.MIXB = (bf16*)(ws + WS_MIX); F.PROJ = (bf16*)(ws + WS_PROJ); F.U = (bf16*)(ws + WS_U);
    for (int u = F.tid; u < (LDS_BYTES - LDSCTL_OFF) / 4; u += NWAVES * 64) ((LAS unsigned*)(F.lds + LDSCTL_OFF))[u] = 0u;
    __syncthreads();
    XcdBarrier bar; bar.bar = (unsigned*)(F.ctl + CW_BAR); bar.x = 0; bar.st = nullptr;
    if (N_LAUNCHES != PER_PHASE) bar = xcd_barrier_post((unsigned*)(F.ctl + CW_BAR), F.MISC + 8);
#define GRID_BAR() do { if (N_LAUNCHES != PER_PHASE) xcd_barrier(bar); } while (0)
    const int lo = args.ph_lo, hi = args.ph_hi;
#define IN(k) (lo <= (k) && (k) < hi)
#ifndef PROBE_DUP
#define PROBE_DUP 0
#endif
#define DUP(k) for (int rep_ = 0; rep_ < 1 + ((PROBE_DUP >> (k)) & 1); ++rep_)
#define BOTH(k) (IN(k) && IN((k) + 1))
    if (IN(0)) { p0_prologue(F); if (BOTH(0)) GRID_BAR(); }
    if (IN(1)) { DUP(1) norm_phase<true>(F, F.x, MOD_SCALE_M, MOD_SHIFT_M); if (BOTH(1)) GRID_BAR(); }
    if (IN(2)) {
        for (int seq = F.vcu; seq < BATCH * 8; seq += F.G) if (F.wave == 0) cumsum_seq(F, seq);
        pg8::Gemm g{F.H, F.Win_t, M, NPROJ, D}; pg8::StaticOrder S; S.init(M, NPROJ, F.G, (int)blockIdx.x);
        pg8::EpiBf16<0> E{F.PROJ, NPROJ};
        DUP(2) pg8::gemm_phase<pg8::EpiBf16<0>, pg8::StaticOrder, PG8_ALIGN, PG8_SP2>(F.lds + RING_OFF, g, S, E);
        if (BOTH(2)) GRID_BAR();
    }
    if (IN(3)) { const int gw = F.vcu * NWAVES + F.wave, NGW = F.G * NWAVES; for (int r = gw; r < M; r += NGW) post_row(F, (size_t)r); if (BOTH(3)) GRID_BAR(); }
    if (IN(4)) { DUP(4) mixer_phase(F, lds); if (BOTH(4)) GRID_BAR(); }
    if (IN(5)) {
        pg8::Gemm g{F.MIXB, F.Wout_t, M, D, D}; pg8::StaticOrder S; S.init(M, D, F.G, (int)blockIdx.x);
        pg8::EpiResGate<false> E{F.x, F.out, D, F.mod + MOD_GATE_M, NMOD, SEQ / 256};
        DUP(5) pg8::gemm_phase<pg8::EpiResGate<false>, pg8::StaticOrder, PG8_ALIGN, PG8_SP2>(F.lds + RING_OFF, g, S, E);
        if (BOTH(5)) GRID_BAR();
    }
    if (IN(6)) { DUP(6) norm_phase<false>(F, F.out, MOD_SCALE_F, MOD_SHIFT_F); if (BOTH(6)) GRID_BAR(); }
    if (IN(7)) {
        pg8::Gemm g{F.H, F.W1_t, M, FF, D}; pg8::StaticOrder S; S.init(M, FF, F.G, (int)blockIdx.x);
        pg8::EpiBf16<2> E{F.U, FF};
        DUP(7) pg8::gemm_phase<pg8::EpiBf16<2>, pg8::StaticOrder, PG8_ALIGN, PG8_SP2>(F.lds + RING_OFF, g, S, E);
        if (BOTH(7)) GRID_BAR();
    }
    if (IN(8)) {
        pg8::Gemm g{F.U, F.W2_t, M, D, FF}; pg8::StaticOrder S; S.init(M, D, F.G, (int)blockIdx.x);
        pg8::EpiResGate<true> E{F.out, F.out, D, F.mod + MOD_GATE_F, NMOD, SEQ / 256};
        pg8::gemm_phase<pg8::EpiResGate<true>, pg8::StaticOrder, PG8_ALIGN, PG8_SP2>(F.lds + RING_OFF, g, S, E);
    }
#undef IN
#undef BOTH
}

extern "C" void kernel_launch(void* const* d_in, const int* in_sizes, int n_in, void* d_out, int out_size, void* d_ws, size_t ws_size, hipStream_t stream) {
    static int grid = 0;
    if (grid == 0) {
        if (n_in != 13 || in_sizes[0] != M * D || out_size != M * D || ws_size < WS_END) { fprintf(stderr, "kernel_launch: unexpected shapes/workspace (n_in %d, in0 %d, out %d, ws %zu); nothing launched\n", n_in, n_in > 0 ? in_sizes[0] : -1, out_size, ws_size); grid = -1; return; }
        int dev = 0, cus = 0, per_cu = 0;
        if (hipGetDevice(&dev) != hipSuccess || hipDeviceGetAttribute(&cus, hipDeviceAttributeMultiprocessorCount, dev) != hipSuccess) { fprintf(stderr, "kernel_launch: device query failed\n"); grid = -1; return; }
        if (hipFuncSetAttribute((const void*)skel_fwd, hipFuncAttributeMaxDynamicSharedMemorySize, LDS_BYTES) != hipSuccess) { fprintf(stderr, "kernel_launch: hipFuncSetAttribute failed\n"); grid = -1; return; }
        if (hipOccupancyMaxActiveBlocksPerMultiprocessor(&per_cu, (const void*)skel_fwd, NWAVES * 64, LDS_BYTES) != hipSuccess || per_cu < 1) { fprintf(stderr, "kernel_launch: occupancy query reports %d workgroups per CU; nothing launched\n", per_cu); (void)hipGetLastError(); grid = -1; return; }
        grid = cus;
    }
    if (grid < 0) return;
    if (hipMemsetAsync((char*)d_ws + WS_CTL, 0, CTL_ZERO_BYTES, stream) != hipSuccess) { fprintf(stderr, "kernel_launch: hipMemsetAsync failed\n"); return; }
    Args a{};
    for (int i = 0; i < 13; ++i) a.in[i] = (const float*)d_in[i];
    a.out = (float*)d_out; a.ws = (unsigned char*)d_ws;
    for (int li = 0; li < N_LAUNCHES; ++li) {
        a.ph_lo = (N_LAUNCHES == PER_PHASE) ? li : 0; a.ph_hi = (N_LAUNCHES == PER_PHASE) ? li + 1 : PER_PHASE; a.li = li;
        hipLaunchKernelGGL(skel_fwd, dim3(grid), dim3(NWAVES * 64), LDS_BYTES, stream, a);
        const hipError_t le = hipPeekAtLastError();
        if (le != hipSuccess) { fprintf(stderr, "kernel_launch: launch %d failed: %s\n", li, hipGetErrorName(le)); break; }
    }
}
```

```cpp
#include <hip/hip_runtime.h>
#include <cstdio>
#include <cstdint>
#include <cmath>
namespace pg8 {
#define PG8_LAS __attribute__((address_space(3)))
typedef unsigned short bf16_t;
typedef short bf16x8 __attribute__((ext_vector_type(8)));
typedef float f32x4 __attribute__((ext_vector_type(4)));
typedef unsigned u32x4 __attribute__((ext_vector_type(4)));
constexpr int BM = 256, BK = 64, HALF = 128, HTB = HALF * BK * 2  , STAGE_BYTES = 8 * HTB, NXCD = 8, WGM = 8;

__host__ __device__ __forceinline__ int lds_byte(int r, int c) { const int st = (r >> 4) * 2 + (c >> 5), rr = r & 15, cc = c & 31, ob = rr * 64 + cc * 2; return st * 1024 + (ob ^ (((ob >> 9) & 1) << 5)); }
__host__ __device__ __forceinline__ void stage_rc(int b, int& R, int& C) { const int st = b / 1024, sb = b % 1024, swz = sb ^ (((sb >> 9) & 1) << 5); R = (st >> 1) * 16 + swz / 64; C = (st & 1) * 32 + (swz % 64) / 2; }
__host__ __device__ __forceinline__ int perm32(int rho) { const int n = rho >> 4, i = rho & 15; return 8 * (i >> 2) + 4 * n + (i & 3); }

struct Unit { int pm, pn; };
struct Gemm { const bf16_t* A; const bf16_t* Bt; int M, N, K; };

struct StaticOrder {
    int nM, nN, nwg, G, c;
    __host__ __device__ void init(int M, int N, int G_, int c_) { nM = M / BM; nN = N / BM; nwg = nM * nN; G = G_; c = c_; }
    __host__ __device__ bool next(int i, Unit& u) const {
        const long L = (long)i * G + c; if (L >= nwg) return false;
        int wgid = (int)L; { const int q = nwg / NXCD, r = nwg % NXCD, xcd = wgid % NXCD, off = wgid / NXCD; wgid = (xcd < r ? xcd * (q + 1) : r * (q + 1) + (xcd - r) * q) + off; }
        const int nig = WGM * nN, gid = wgid / nig, fm = gid * WGM, gsz = (nM - fm) < WGM ? (nM - fm) : WGM;
        u.pm = fm + ((wgid % nig) % gsz); u.pn = (wgid % nig) / gsz; return true;
    }
    __device__ __forceinline__ void a_ready(const Unit&) const {}
    __device__ __forceinline__ void done(const Unit&) const {}
};

__device__ __forceinline__ unsigned cvt_pk_bf16(float lo, float hi) { unsigned r; asm volatile("v_cvt_pk_bf16_f32 %0, %1, %2" : "=v"(r) : "v"(lo), "v"(hi)); return r; }
constexpr int EPI_SCR = (1 * 2 + 1) * HTB;

template <int ACT, bool STORE = true> struct EpiBf16 {
    static constexpr bool PERM = true, AFTER_DRAIN = false;
    bf16_t* O; int ldc;
    __device__ __forceinline__ void operator()(const f32x4 (&acc)[2][2][4][2], const Unit& u, int wr, int wc, int fr, int fq, PG8_LAS unsigned char* lds, int wid, int lane) const {
        PG8_LAS unsigned char* scr = lds + EPI_SCR + wid * 1024;
        const int wofs = (fr >> 3) * 8192 + (fr & 7) * 128, wx = fr & 7;
        const int r8 = lane >> 3, c8 = lane & 7; const int rofs = r8 * 128 + 16 * (c8 ^ r8);
        bf16_t* obase = O + (size_t)(u.pm * BM + wr * 64 + r8) * ldc + u.pn * BM + wc * 64 + 8 * c8;
#pragma unroll
        for (int ai = 0; ai < 2; ++ai)
#pragma unroll
            for (int m = 0; m < 4; ++m) {
#pragma unroll
                for (int bj = 0; bj < 2; ++bj) { f32x4 v0 = acc[ai][bj][m][0], v1 = acc[ai][bj][m][1];
                    if (ACT == 2) {
#pragma unroll
                        for (int e = 0; e < 4; ++e) { const float a = fmaxf(v0[e], 0.f), b = fmaxf(v1[e], 0.f); v0[e] = a * a; v1[e] = b * b; } }
                    u32x4 w; w.x = cvt_pk_bf16(v0[0], v0[1]); w.y = cvt_pk_bf16(v0[2], v0[3]); w.z = cvt_pk_bf16(v1[0], v1[1]); w.w = cvt_pk_bf16(v1[2], v1[3]);
                    *(PG8_LAS u32x4*)(scr + wofs + 16 * ((4 * bj + fq) ^ wx)) = w; }
                const u32x4 x0 = *(const PG8_LAS u32x4*)(scr + rofs), x1 = *(const PG8_LAS u32x4*)(scr + 8192 + rofs);
                bf16_t* rowp = obase + (size_t)(ai * HALF + m * 16) * ldc;
                if (STORE) { __builtin_nontemporal_store(x0, (u32x4*)rowp); __builtin_nontemporal_store(x1, (u32x4*)(rowp + (size_t)8 * ldc)); }
                else asm volatile("" :: "v"(x0), "v"(x1));
            }
    }
};

template <bool NT> struct EpiResGate {
    static constexpr bool PERM = false, AFTER_DRAIN = false;
    const float* base; float* out; int ldc; const float* gate; int gate_stride; int tiles_per_batch;
    __device__ __forceinline__ void operator()(const f32x4 (&acc)[2][2][4][2], const Unit& u, int wr, int wc, int fr, int fq, PG8_LAS unsigned char* lds, int wid, int lane) const {
        PG8_LAS unsigned char* scr = lds + EPI_SCR + wid * 1024;
        const int wofs = (fr >> 3) * 8192 + (fr & 7) * 128, wx = fr & 7;
        const int r8 = lane >> 3, c8 = lane & 7; const int rofs = r8 * 128 + 16 * (c8 ^ r8);
        const int col = u.pn * BM + wc * 32 + 4 * c8;
        const float* g = gate + (size_t)(u.pm / tiles_per_batch) * gate_stride + col;
        const f32x4 g0 = *(const f32x4*)g, g1 = *(const f32x4*)(g + HALF);
        const size_t off0 = (size_t)(u.pm * BM + wr * 64 + r8) * ldc + col;
#pragma unroll
        for (int ai = 0; ai < 2; ++ai)
#pragma unroll
            for (int m = 0; m < 4; ++m) { const size_t off = off0 + (size_t)(ai * HALF + m * 16) * ldc;
#pragma unroll
                for (int bj = 0; bj < 2; ++bj) {
                    const f32x4 b0 = *(const f32x4*)(base + off + bj * HALF), b1 = *(const f32x4*)(base + off + bj * HALF + (size_t)8 * ldc);
                    *(PG8_LAS f32x4*)(scr + wofs + 16 * ((fq) ^ wx)) = acc[ai][bj][m][0];
                    *(PG8_LAS f32x4*)(scr + wofs + 16 * ((4 + fq) ^ wx)) = acc[ai][bj][m][1];
                    const f32x4 a0 = *(const PG8_LAS f32x4*)(scr + rofs), a1 = *(const PG8_LAS f32x4*)(scr + 8192 + rofs);
                    const f32x4 gg = bj ? g1 : g0;
                    if (NT) { __builtin_nontemporal_store(b0 + gg * a0, (f32x4*)(out + off + bj * HALF)); __builtin_nontemporal_store(b1 + gg * a1, (f32x4*)(out + off + bj * HALF + (size_t)8 * ldc)); }
                    else { *(f32x4*)(out + off + bj * HALF) = b0 + gg * a0; *(f32x4*)(out + off + bj * HALF + (size_t)8 * ldc) = b1 + gg * a1; }
                }
                asm volatile("" ::: "memory"); }
    }
};

struct EpiProj {
    static constexpr bool PERM = true, AFTER_DRAIN = false;
    bf16_t* O; int ldc; const float* qg; const float* kg; const float* rope; float eps, c2;
    __device__ __forceinline__ void operator()(const f32x4 (&acc)[2][2][4][2], const Unit& u, int wr, int wc, int fr, int fq, PG8_LAS unsigned char* lds, int wid, int lane) const {
        PG8_LAS unsigned char* scr = lds + EPI_SCR + wid * 1024;
        const int wofs = (fr >> 3) * 8192 + (fr & 7) * 128, wx = fr & 7;
        const int r8 = lane >> 3, c8 = lane & 7; const int rofs = r8 * 128 + 16 * (c8 ^ r8);
        const int sec = u.pn >> 1;
        const bool m2 = (sec == 4) | (sec == 5);
        const int ocol = m2 ? (wc >> 1) * 128 + (c8 >> 2) * 64 + (wc & 1) * 32 + 8 * (c8 & 3) : wc * 64 + 8 * c8;
        bf16_t* obase = O + (size_t)(u.pm * BM + wr * 64 + r8) * ldc + u.pn * BM + ocol;
#define EP_PUT(ai_, m_, V) do { _Pragma("unroll") for (int bj_ = 0; bj_ < 2; ++bj_) { u32x4 w_; w_.x = cvt_pk_bf16(V[bj_][0][0], V[bj_][0][1]); w_.y = cvt_pk_bf16(V[bj_][0][2], V[bj_][0][3]); \
            w_.z = cvt_pk_bf16(V[bj_][1][0], V[bj_][1][1]); w_.w = cvt_pk_bf16(V[bj_][1][2], V[bj_][1][3]); *(PG8_LAS u32x4*)(scr + wofs + 16 * ((4 * bj_ + fq) ^ wx)) = w_; } \
        const u32x4 x0_ = *(const PG8_LAS u32x4*)(scr + rofs), x1_ = *(const PG8_LAS u32x4*)(scr + 8192 + rofs); bf16_t* rowp_ = obase + (size_t)((ai_) * HALF + (m_) * 16) * ldc; \
        __builtin_nontemporal_store(x0_, (u32x4*)rowp_); __builtin_nontemporal_store(x1_, (u32x4*)(rowp_ + (size_t)8 * ldc)); } while (0)
        if (sec <= 1) {
            const float* gp = (sec ? kg : qg) + 8 * fq; const float sc = sec ? 1.f : c2;
            f32x4 ga[2][2];
#pragma unroll
            for (int bj = 0; bj < 2; ++bj) { ga[bj][0] = *(const f32x4*)(gp + 32 * bj) * sc; ga[bj][1] = *(const f32x4*)(gp + 32 * bj + 4) * sc; }
#pragma unroll
            for (int ai = 0; ai < 2; ++ai)
#pragma unroll
                for (int m = 0; m < 4; ++m) { float ss = 0.f; f32x4 v[2][2];
#pragma unroll
                    for (int bj = 0; bj < 2; ++bj)
#pragma unroll
                        for (int n = 0; n < 2; ++n) { v[bj][n] = acc[ai][bj][m][n]; ss += (v[bj][n][0] * v[bj][n][0] + v[bj][n][1] * v[bj][n][1]) + (v[bj][n][2] * v[bj][n][2] + v[bj][n][3] * v[bj][n][3]); }
                    ss += __shfl_xor(ss, 16); ss += __shfl_xor(ss, 32);
                    const float rstd = __builtin_amdgcn_rsqf(ss * (1.f / 64.f) + eps);
#pragma unroll
                    for (int bj = 0; bj < 2; ++bj)
#pragma unroll
                        for (int n = 0; n < 2; ++n) v[bj][n] = v[bj][n] * rstd * ga[bj][n];
                    EP_PUT(ai, m, v); }
        } else if (m2) {
            const int hh = 2 * (u.pn & 1) + (wc >> 1);
            const float lg2 = (hh == 0) ? -0.04580368961312479f : (hh == 1) ? -0.02272007650008353f : (hh == 2) ? -0.011315313227834146f : -0.005646563141142063f;
            const float* rp = rope + 32 * (wc & 1) + 8 * fq;
#pragma unroll
            for (int ai = 0; ai < 2; ++ai)
#pragma unroll
                for (int m = 0; m < 4; ++m) { const int s = (u.pm * BM + ai * HALF + wr * 64 + m * 16 + fr) & 2047; const float* rr = rp + s * 128;
                    const float sc = (sec == 5) ? 0.08838834764831845f * __builtin_amdgcn_exp2f(-lg2 * (float)(s & 127)) : 1.f;
                    f32x4 v[2][2];
#pragma unroll
                    for (int n = 0; n < 2; ++n) { const f32x4 cs = *(const f32x4*)(rr + 4 * n) * sc, sn = *(const f32x4*)(rr + 64 + 4 * n) * sc; const f32x4 x1 = acc[ai][0][m][n], x2 = acc[ai][1][m][n];
                        v[0][n] = x1 * cs - x2 * sn; v[1][n] = x1 * sn + x2 * cs; }
                    EP_PUT(ai, m, v); }
        } else {
#pragma unroll
            for (int ai = 0; ai < 2; ++ai)
#pragma unroll
                for (int m = 0; m < 4; ++m) { f32x4 v[2][2];
#pragma unroll
                    for (int bj = 0; bj < 2; ++bj)
#pragma unroll
                        for (int n = 0; n < 2; ++n) v[bj][n] = acc[ai][bj][m][n];
                    EP_PUT(ai, m, v); }
        }
#undef EP_PUT
    }
};
template <class Epi, class Sched, bool ALIGN_EPI = false, bool SP2 = false>
__device__ __forceinline__ void gemm_phase(PG8_LAS unsigned char* lds, const Gemm g, const Sched& S, const Epi& E) {
    const int tid = threadIdx.x, wid = __builtin_amdgcn_readfirstlane(tid >> 6), lane = tid & 63, wr = wid >> 2, wc = wid & 3, fr = lane & 15, fq = lane >> 4;
    const int K = g.K, nt = K / BK;
    unsigned voffA[2], voffB[2];
#pragma unroll
    for (int i = 0; i < 2; ++i) { int R, C; stage_rc(tid * 16 + i * 8192, R, C); const int Rb = Epi::PERM ? ((R & ~31) + perm32(R & 31)) : R;
        voffA[i] = (unsigned)(R * K + C) * 2u; voffB[i] = (unsigned)(Rb * K + C) * 2u; }
    const size_t kstep = (size_t)(BK * 2);
    const size_t hstep = (size_t)HALF * K * 2;
    const size_t tstep = 2 * hstep;
    const unsigned ldsw = (unsigned)wid * 1024u;
    const int aoff = lds_byte(wr * 64 + fr, fq * 8), boff = lds_byte(wc * 32 + fr, fq * 8);
#define PG8_SA(b, h) (((b) * 2 + (h)) * HTB)
#define PG8_SB(b, h) ((4 + (b) * 2 + (h)) * HTB)
#define PG8_STAGE(bufoff, gbase, voff) do { _Pragma("unroll") for (int _i = 0; _i < 2; ++_i) \
        __builtin_amdgcn_global_load_lds((const unsigned*)((const char*)(gbase) + (voff)[_i]), (PG8_LAS unsigned*)(lds + (bufoff) + ldsw + _i * 8192), 16, 0, 0); } while (0)
#define PG8_LDA(dst, b, h) do { _Pragma("unroll") for (int m = 0; m < 4; ++m) _Pragma("unroll") for (int k = 0; k < 2; ++k) dst[m][k] = *(const PG8_LAS bf16x8*)(lds + PG8_SA(b, h) + aoff + m * 2048 + k * 1024); } while (0)
#define PG8_LDB(dst, b, h) do { _Pragma("unroll") for (int n = 0; n < 2; ++n) _Pragma("unroll") for (int k = 0; k < 2; ++k) dst[n][k] = *(const PG8_LAS bf16x8*)(lds + PG8_SB(b, h) + boff + n * 2048 + k * 1024); } while (0)
#define PG8_MMA(ai, bj, At, Bt) do { __builtin_amdgcn_s_setprio(1); _Pragma("unroll") for (int m = 0; m < 4; ++m) _Pragma("unroll") for (int n = 0; n < 2; ++n) _Pragma("unroll") for (int k = 0; k < 2; ++k) \
        acc[ai][bj][m][n] = __builtin_amdgcn_mfma_f32_16x16x32_bf16(Bt[n][k], At[m][k], acc[ai][bj][m][n], 0, 0, 0); __builtin_amdgcn_s_setprio(0); } while (0)
#define PG8_WAIT_V(n) asm volatile("s_waitcnt vmcnt(" #n ")" ::: "memory")
#define PG8_WAIT_L(n) asm volatile("s_waitcnt lgkmcnt(" #n ")" ::: "memory")
#define PG8_BAR __builtin_amdgcn_s_barrier()
#define PG8_SCHED __builtin_amdgcn_sched_barrier(0)
    Unit cur, nxt; int ui = 0;
    if (!S.next(0, cur)) return;
    f32x4 acc[2][2][4][2];
#pragma unroll
    for (int a = 0; a < 2; ++a)
#pragma unroll
        for (int b = 0; b < 2; ++b)
#pragma unroll
            for (int m = 0; m < 4; ++m)
#pragma unroll
                for (int n = 0; n < 2; ++n) acc[a][b][m][n] = (f32x4){0.f, 0.f, 0.f, 0.f};
    bf16x8 At[4][2], B0[2][2], B1[2][2];
    const char* cA = (const char*)g.A + (size_t)cur.pm * tstep; const char* cB = (const char*)g.Bt + (size_t)cur.pn * tstep;
    S.a_ready(cur);
    if constexpr (SP2) {
        PG8_STAGE(PG8_SB(0, 0), cB, voffB); PG8_STAGE(PG8_SB(0, 1), cB + hstep, voffB); PG8_STAGE(PG8_SA(0, 0), cA, voffA); PG8_STAGE(PG8_SA(0, 1), cA + hstep, voffA);
        if (wr == 1) PG8_BAR;
        PG8_WAIT_V(2); PG8_BAR;
        PG8_STAGE(PG8_SB(1, 0), cB + kstep, voffB); PG8_STAGE(PG8_SA(1, 0), cA + kstep, voffA); PG8_STAGE(PG8_SB(1, 1), cB + hstep + kstep, voffB);
        PG8_WAIT_V(6); PG8_BAR;
    } else {
        PG8_STAGE(PG8_SB(0, 0), cB, voffB); PG8_STAGE(PG8_SA(0, 0), cA, voffA); PG8_STAGE(PG8_SB(0, 1), cB + hstep, voffB); PG8_STAGE(PG8_SA(0, 1), cA + hstep, voffA);
        if (wr == 1) PG8_BAR;
        PG8_WAIT_V(4); PG8_BAR;
        PG8_STAGE(PG8_SB(1, 0), cB + kstep, voffB); PG8_STAGE(PG8_SA(1, 0), cA + kstep, voffA); PG8_STAGE(PG8_SB(1, 1), cB + hstep + kstep, voffB);
        PG8_WAIT_V(6); PG8_BAR;
    }
    for (;;) {
        const bool has_next = S.next(ui + 1, nxt);
        const char* nA = has_next ? (const char*)g.A + (size_t)nxt.pm * tstep : cA; const char* nB = has_next ? (const char*)g.Bt + (size_t)nxt.pn * tstep : cB;
        for (int t = 0; t < nt; t += 2) {
            const bool last = (t == nt - 2);
            const char* a1 = cA + (size_t)(t + 1) * kstep;
            const char* a2 = last ? nA : cA + (size_t)(t + 2) * kstep; const char* b2 = last ? nB : cB + (size_t)(t + 2) * kstep;
            const char* a3 = a2 + kstep; const char* b3 = b2 + kstep;
            if (last && has_next) S.a_ready(nxt);
            if constexpr (SP2) {
            PG8_LDB(B0, 0, 0); PG8_LDB(B1, 0, 1); PG8_SCHED; PG8_LDA(At, 0, 0); PG8_STAGE(PG8_SA(1, 1), a1 + hstep, voffA);
            PG8_WAIT_V(8); PG8_WAIT_L(0); PG8_BAR; PG8_MMA(0, 0, At, B0); PG8_MMA(0, 1, At, B1); PG8_BAR; PG8_SCHED;
            PG8_LDA(At, 0, 1); PG8_STAGE(PG8_SB(0, 0), b2, voffB); PG8_STAGE(PG8_SB(0, 1), b2 + hstep, voffB); PG8_STAGE(PG8_SA(0, 0), a2, voffA);
            PG8_WAIT_V(8); PG8_WAIT_L(0); PG8_BAR; PG8_MMA(1, 0, At, B0); PG8_MMA(1, 1, At, B1); PG8_BAR; PG8_SCHED;
            PG8_LDB(B0, 1, 0); PG8_LDB(B1, 1, 1); PG8_SCHED; PG8_LDA(At, 1, 0); PG8_STAGE(PG8_SA(0, 1), a2 + hstep, voffA);
            PG8_WAIT_V(8); PG8_WAIT_L(0); PG8_BAR; PG8_MMA(0, 0, At, B0); PG8_MMA(0, 1, At, B1); PG8_BAR; PG8_SCHED;
            PG8_LDA(At, 1, 1); PG8_STAGE(PG8_SB(1, 0), b3, voffB); PG8_STAGE(PG8_SB(1, 1), b3 + hstep, voffB); PG8_STAGE(PG8_SA(1, 0), a3, voffA);
            PG8_WAIT_V(8); PG8_WAIT_L(0); PG8_BAR; PG8_MMA(1, 0, At, B0); PG8_MMA(1, 1, At, B1); PG8_BAR; PG8_SCHED;
            } else {
            PG8_LDB(B0, 0, 0); PG8_SCHED; PG8_LDA(At, 0, 0); PG8_STAGE(PG8_SA(1, 1), a1 + hstep, voffA);
            PG8_WAIT_L(8); PG8_BAR; PG8_WAIT_L(0); PG8_MMA(0, 0, At, B0); PG8_BAR; PG8_SCHED;
            PG8_LDB(B1, 0, 1); PG8_STAGE(PG8_SB(0, 0), b2, voffB);
            PG8_BAR; PG8_WAIT_L(0); PG8_MMA(0, 1, At, B1); PG8_BAR;
            PG8_LDA(At, 0, 1); PG8_STAGE(PG8_SA(0, 0), a2, voffA);
            PG8_BAR; PG8_WAIT_L(0); PG8_MMA(1, 0, At, B0); PG8_BAR; PG8_SCHED;
            PG8_STAGE(PG8_SB(0, 1), b2 + hstep, voffB);
            PG8_WAIT_V(6); PG8_BAR; PG8_MMA(1, 1, At, B1); PG8_BAR;
            PG8_LDB(B0, 1, 0); PG8_SCHED; PG8_LDA(At, 1, 0); PG8_STAGE(PG8_SA(0, 1), a2 + hstep, voffA);
            PG8_WAIT_L(8); PG8_BAR; PG8_WAIT_L(0); PG8_MMA(0, 0, At, B0); PG8_BAR; PG8_SCHED;
            PG8_LDB(B1, 1, 1); PG8_STAGE(PG8_SB(1, 0), b3, voffB);
            PG8_BAR; PG8_WAIT_L(0); PG8_MMA(0, 1, At, B1); PG8_BAR;
            PG8_LDA(At, 1, 1); PG8_STAGE(PG8_SA(1, 0), a3, voffA);
            PG8_BAR; PG8_WAIT_L(0); PG8_MMA(1, 0, At, B0); PG8_BAR; PG8_SCHED;
            PG8_STAGE(PG8_SB(1, 1), b3 + hstep, voffB);
            PG8_WAIT_V(6); PG8_BAR; PG8_MMA(1, 1, At, B1); PG8_BAR;
            }
        }
        if constexpr (ALIGN_EPI) { if (wr == 0) PG8_BAR; }
        if constexpr (!Epi::AFTER_DRAIN) { static_assert(ALIGN_EPI, "the epilogues use stage buffer As[1][1] as scratch: both halves must be past their last K-tile"); E(acc, cur, wr, wc, fr, fq, lds, wid, lane); S.done(cur); }
        if (!has_next) break;
#pragma unroll
        for (int a = 0; a < 2; ++a)
#pragma unroll
            for (int b = 0; b < 2; ++b)
#pragma unroll
                for (int m = 0; m < 4; ++m)
#pragma unroll
                    for (int n = 0; n < 2; ++n) acc[a][b][m][n] = (f32x4){0.f, 0.f, 0.f, 0.f};
        cur = nxt; cA = nA; cB = nB; ++ui;
        if constexpr (ALIGN_EPI) { if (wr == 1) PG8_BAR; }
    }
    PG8_WAIT_V(0);
    if constexpr (!ALIGN_EPI) { if (wr == 0) PG8_BAR; }
    PG8_BAR;
    if constexpr (Epi::AFTER_DRAIN) { E.fused(acc, cur, wr, wc, fr, fq, lds, wid, lane); S.done(cur); }
#undef PG8_SA
#undef PG8_SB
#undef PG8_STAGE
#undef PG8_LDA
#undef PG8_LDB
#undef PG8_MMA
#undef PG8_WAIT_V
#undef PG8_WAIT_L
#undef PG8_BAR
#undef PG8_SCHED
}
}
#ifndef PG8_SP2
#define PG8_SP2 true
#endif
#ifndef PG8_ALIGN
#define PG8_ALIGN true
#endif
#include <hip/hip_bf16.h>
#include <cmath>
namespace attn_body {
using bf16=__hip_bfloat16;
using bf16x8=__attribute__((ext_vector_type(8)))short;
using s16x4=__attribute__((ext_vector_type(4)))short;
using f32x16=__attribute__((ext_vector_type(16)))float;
using u32x4=__attribute__((ext_vector_type(4)))unsigned;
using f32x4=__attribute__((ext_vector_type(4)))float;
constexpr int BATCH=32,NHEAD=8,SEQ=2048,D=64,DM=4096,ODM=1024;
constexpr int NW=8,QBLK=32,QB=QBLK*NW,KVBLK=64,NQB=SEQ/QB;
constexpr int ATTN_UNIT_ROWS=QB;
__device__ __forceinline__ int crow(int r,int hi){return (r&3)+8*(r>>2)+4*hi;}
#define SBAR() __builtin_amdgcn_sched_barrier(0)
__device__ __forceinline__ void cmask(f32x16&p0,f32x16&p1,int jb,int qrel,int hi){
  const float NEG=-INFINITY; int kb=64*jb+4*hi;
  #pragma unroll
  for(int r=0;r<16;++r){int kv=kb+(r&3)+8*(r>>2); if(kv>qrel)p0[r]=NEG; if(kv+32>qrel)p1[r]=NEG;}
}

constexpr int NSLOT=3, SLOTB=8192;
constexpr int LDS_K=0, LDS_V=NSLOT*SLOTB, LDS_WS=2*NSLOT*SLOTB, LDS_OST=LDS_WS+NW*64*4, LDS_CK=LDS_OST+NW*8192, LDS_BYTES=LDS_CK+SEQ*4;
constexpr float C2=0.125f*1.4426950408889634f;
__device__ __forceinline__ void glds16(const void*gsrc,unsigned lds_dst){unsigned keep;
  asm volatile("s_mov_b32 %0, m0\n\ts_mov_b32 m0, %2\n\ts_nop 0\n\tglobal_load_lds_dwordx4 %1, off\n\ts_mov_b32 m0, %0":"=&s"(keep):"v"(gsrc),"s"(lds_dst):"memory");}
__device__ __forceinline__ float max3f(float a,float b,float c){float r;asm("v_max3_f32 %0, %1, %2, %3":"=v"(r):"v"(a),"v"(b),"v"(c));return r;}
__device__ __forceinline__ float max2f(float a,float b){float r;asm("v_max_f32_e32 %0, %1, %2":"=v"(r):"v"(a),"v"(b));return r;}
__device__ __forceinline__ float fadd_s(float a,float b){float r;asm("v_add_f32_e32 %0, %1, %2":"=v"(r):"v"(a),"v"(b));return r;}
__device__ __forceinline__ float fsub_s(float a,float b){float r;asm("v_sub_f32_e32 %0, %1, %2":"=v"(r):"v"(a),"v"(b));return r;}
typedef float f32x2_t __attribute__((ext_vector_type(2))); typedef __bf16 bf16x2_t __attribute__((ext_vector_type(2)));
__device__ __forceinline__ unsigned cvtpk_s(float lo,float hi){f32x2_t v={lo,hi};bf16x2_t b=__builtin_convertvector(v,bf16x2_t);return __builtin_bit_cast(unsigned,b);}
#define WAIT_BAR(N) asm volatile("s_waitcnt vmcnt(" #N ") lgkmcnt(0)\n\ts_barrier":::"memory")

__device__ __forceinline__ void qkt(f32x16&p0,f32x16&p1,const char*Kslot,const bf16x8*qr,int r32,int hi){
  const char*kb=Kslot+hi*1024+r32*16;
  #pragma unroll
  for(int d0=0;d0<4;++d0){
    const bf16x8 b0=*reinterpret_cast<const bf16x8*>(kb+d0*2048);
    const bf16x8 b1=*reinterpret_cast<const bf16x8*>(kb+d0*2048+512);
    p0=__builtin_amdgcn_mfma_f32_32x32x16_bf16(b0,qr[d0],p0,0,0,0);p1=__builtin_amdgcn_mfma_f32_32x32x16_bf16(b1,qr[d0],p1,0,0,0);}
}
typedef __attribute__((address_space(3))) const char* lds_cptr;
typedef __attribute__((address_space(3))) char* lds_wptr;
typedef __attribute__((address_space(3))) const f32x4* lds_f4c;
typedef __attribute__((address_space(3))) f32x4* lds_f4w;
typedef __attribute__((address_space(3))) float* lds_fw;
typedef short v4i16_t __attribute__((ext_vector_type(4)));
__device__ __forceinline__ void kload8(bf16x8*kf,lds_cptr kp){
  kf[0]=*(const __attribute__((address_space(3))) bf16x8*)(kp);      kf[1]=*(const __attribute__((address_space(3))) bf16x8*)(kp+512);
  kf[2]=*(const __attribute__((address_space(3))) bf16x8*)(kp+2048); kf[3]=*(const __attribute__((address_space(3))) bf16x8*)(kp+2560);
  kf[4]=*(const __attribute__((address_space(3))) bf16x8*)(kp+4096); kf[5]=*(const __attribute__((address_space(3))) bf16x8*)(kp+4608);
  kf[6]=*(const __attribute__((address_space(3))) bf16x8*)(kp+6144); kf[7]=*(const __attribute__((address_space(3))) bf16x8*)(kp+6656);
}
__device__ __forceinline__ void kload2(bf16x8*kf,lds_cptr kp,int j){ kf[2*j]=*(const __attribute__((address_space(3))) bf16x8*)(kp+j*2048); kf[2*j+1]=*(const __attribute__((address_space(3))) bf16x8*)(kp+j*2048+512); }
__device__ __forceinline__ s16x4 vtr(lds_cptr p){ return __builtin_bit_cast(s16x4,__builtin_amdgcn_ds_read_tr16_b64_v4i16((__attribute__((address_space(3))) v4i16_t*)p)); }
__device__ __forceinline__ float rowmax(const f32x16&p0,const f32x16&p1){
  float a=max3f(p0[0],p0[1],p1[0]),b=max3f(p0[2],p0[3],p1[1]);a=max3f(a,p1[2],p1[3]);
  #pragma unroll
  for(int r=4;r<16;r+=4){a=max3f(a,p0[r],p0[r+1]);b=max3f(b,p0[r+2],p0[r+3]);a=max3f(a,p1[r],p1[r+1]);b=max3f(b,p1[r+2],p1[r+3]);}
  const float m=max2f(a,b);
  auto rr=__builtin_amdgcn_permlane32_swap(__float_as_uint(m),__float_as_uint(m),false,false);
  return max2f(__uint_as_float(rr[0]),__uint_as_float(rr[1]));
}
__device__ __forceinline__ void pv(f32x16*o,int vb,bf16x8 pa0,bf16x8 pa1,bf16x8 pa2,bf16x8 pa3){
  #pragma unroll
  for(int d0=0;d0<2;++d0){s16x4 lo[4],hi[4];
    #pragma unroll
    for(int ks=0;ks<4;++ks){
      asm volatile("ds_read_b64_tr_b16 %0,%1 offset:%c2":"=&v"(lo[ks]):"v"(vb),"i"(d0*4096+ks*1024):"memory");
      asm volatile("ds_read_b64_tr_b16 %0,%1 offset:%c2":"=&v"(hi[ks]):"v"(vb),"i"(d0*4096+ks*1024+512):"memory");}
    asm volatile("s_waitcnt lgkmcnt(0)":::"memory");SBAR();
    #define PK(k) (bf16x8){lo[k][0],lo[k][1],lo[k][2],lo[k][3],hi[k][0],hi[k][1],hi[k][2],hi[k][3]}
    o[d0]=__builtin_amdgcn_mfma_f32_32x32x16_bf16(pa0,PK(0),o[d0],0,0,0);
    o[d0]=__builtin_amdgcn_mfma_f32_32x32x16_bf16(pa1,PK(1),o[d0],0,0,0);
    o[d0]=__builtin_amdgcn_mfma_f32_32x32x16_bf16(pa2,PK(2),o[d0],0,0,0);
    o[d0]=__builtin_amdgcn_mfma_f32_32x32x16_bf16(pa3,PK(3),o[d0],0,0,0);
    #undef PK
  }
}

#ifndef ATTN_STORE16
#define ATTN_STORE16(p,v) (*(u32x4*)(p)=(v))
#endif
template<int THRL> __device__ __forceinline__ void attn_unit(int b,int h,int qb,const bf16*Q,const bf16*__restrict__ K,const bf16*__restrict__ V,const bf16*__restrict__ G,const float*__restrict__ cum2,const float*__restrict__ gain,bf16*O,char*shm){
  int tid_=threadIdx.x; asm volatile("":"+v"(tid_));
  const int tid=tid_,lane=tid&63,r32=lane&31,hi=lane>>5; const int wid=__builtin_amdgcn_readfirstlane(tid>>6);
  const long rowbase=(long)b*SEQ; const int q0=qb*QB;
  const bf16*Qw=Q+(rowbase+q0+wid*QBLK)*DM+h*D;
  const bf16*Kh=K+rowbase*DM+h*D,*Vh=V+rowbase*DM+h*D;
  const unsigned lds0=(unsigned)(uintptr_t)shm;
  float*wsf=(float*)(shm+LDS_WS)+wid*64;
  const bf16*ksrc=Kh+(long)lane*DM+wid*8;
  const bf16*vsrc=Vh+(long)(16*(wid&3)+(lane>>2))*DM+(wid>>2)*32+(lane&3)*8;
  const unsigned kdst=lds0+LDS_K+wid*1024, vdst=lds0+LDS_V+wid*1024;
  #define DMA_K(t,slot) glds16(ksrc+(long)(t)*KVBLK*DM,(unsigned)__builtin_amdgcn_readfirstlane(kdst+(slot)))
  #define DMA_V(t,slot) glds16(vsrc+(long)(t)*KVBLK*DM,(unsigned)__builtin_amdgcn_readfirstlane(vdst+(slot)))
  const int vb0=(int)(lds0+LDS_V)+((lane>>4)&1)*32+(lane&3)*8+(4*hi+((lane&15)>>2))*64;
  const char*Kbase=shm+LDS_K; bf16x8 kf[8];
  const lds_cptr shm3=(lds_cptr)shm; const lds_wptr shm3w=(lds_wptr)shm; const lds_f4c ckb=(lds_f4c)(shm3+LDS_CK)+hi; const lds_cptr kp0=shm3+LDS_K+hi*1024+r32*16; const lds_cptr vp0=shm3+LDS_V+((lane>>4)&1)*32+(lane&3)*8+(4*hi+((lane&15)>>2))*64;
  const int NT=(q0+QB)/KVBLK;
  DMA_K(0,0);DMA_V(0,0);DMA_K(1,SLOTB);
  { const float*cs=cum2+((long)(b*NHEAD+h))*SEQ; if(tid*4<q0+QB){ const f32x4 v_=*(const f32x4*)(cs+tid*4); *(lds_f4w)(shm3w+LDS_CK+tid*16)=(f32x4){-v_.x,-v_.y,-v_.z,-v_.w}; } }
  bf16x8 qr[4];
  #pragma unroll
  for(int d0=0;d0<4;++d0)qr[d0]=*reinterpret_cast<const bf16x8*>(&Qw[(long)r32*DM+d0*16+hi*8]);
  float mhat=0.f,l_reg=0.f;f32x16 o[2];o[0]=f32x16{};o[1]=f32x16{};
  const int qrel=wid*QBLK+r32;
  #define CMASK(P0,P1,t) do{int jb_=(t)-(NT-4); if(jb_>=0)cmask(P0,P1,jb_,qrel,hi);}while(0)
  bool resc=false;
  #define START(P0,P1) do{ const float rm=rowmax(P0,P1); resc=false; \
    { const float dl=rm; mhat=fadd_s(mhat,dl); \
      _Pragma("unroll") for(int r=0;r<16;++r){P0[r]=fsub_s(P0[r],dl);P1[r]=fsub_s(P1[r],dl);} \
      } \
    _Pragma("unroll") for(int r=0;r<16;++r)P0[r]=__builtin_amdgcn_exp2f(P0[r]); }while(0)
  #define RESC() do{ if(resc){ asm volatile("s_waitcnt lgkmcnt(0)":::"memory"); \
      _Pragma("unroll") for(int d_=0;d_<2;++d_) _Pragma("unroll") for(int r=0;r<16;++r)o[d_][r]*=wsf[crow(r,hi)]; } }while(0)
  f32x16 pA0,pA1,pB0,pB1;
  #define CINIT(C0,C1,t) do{ const lds_f4c cb_=ckb+(t)*16; _Pragma("unroll") for(int g_=0;g_<4;++g_){ const f32x4 a_=cb_[2*g_],b_=cb_[2*g_+8]; \
      C0[4*g_]=a_.x-mhat;C0[4*g_+1]=a_.y-mhat;C0[4*g_+2]=a_.z-mhat;C0[4*g_+3]=a_.w-mhat; C1[4*g_]=b_.x-mhat;C1[4*g_+1]=b_.y-mhat;C1[4*g_+2]=b_.z-mhat;C1[4*g_+3]=b_.w-mhat; } }while(0)
  int sl_prev=0,sl_cur=0,sl_next=SLOTB;
  #define ROT() do{sl_prev=sl_cur;sl_cur=sl_next;sl_next=(sl_next==(NSLOT-1)*SLOTB)?0:sl_next+SLOTB;}while(0)
  DMA_K(2,2*SLOTB);
  WAIT_BAR(3);
  CINIT(pA0,pA1,0); qkt(pA0,pA1,Kbase,qr,r32,hi);asm volatile("s_nop 15\n\ts_nop 7":"+v"(pA0),"+v"(pA1));CMASK(pA0,pA1,0);
  START(pA0,pA1);
  _Pragma("unroll") for(int r=0;r<16;++r)pA1[r]=__builtin_amdgcn_exp2f(pA1[r]);
  CINIT(pB0,pB1,1);
  WAIT_BAR(0);
  DMA_K(3,0);DMA_V(1,SLOTB);
  ROT();
  kload8(kf,kp0+sl_cur);
  WAIT_BAR(2);
  s16x4 vlo[8],vhi[8]; u32x4 pw0,pw1,pw2,pw3;
  #define PKW(P,B) cvtpk_s(P[B],P[B+1])
  #define PAF(k) __builtin_bit_cast(bf16x8,pw##k)
  #define VFR(i) (bf16x8){vlo[i][0],vlo[i][1],vlo[i][2],vlo[i][3],vhi[i][0],vhi[i][1],vhi[i][2],vhi[i][3]}
  #define PIN(x) asm volatile("":"+v"(x))
  #define MX3(a,b,c) __builtin_fmaxf(__builtin_fmaxf((a),(b)),(c))
  #define GAPA(MF,A0,A1,A2,A3,W0,W1,PW) do{ MF; sacc+=A0; sacc+=A1; sacc+=A2; sacc+=A3; PIN(sacc); W0; W1; PIN(PW); SBAR(); }while(0)
  #define EX(v) __builtin_amdgcn_exp2f(v)
  #define GAPB(MF,X,B,NP,NG,NXI) do{ MF; X[B]=EX(X[B]); X[B+1]=EX(X[B+1]); X[B+2]=EX(X[B+2]); X[B+3]=EX(X[B+3]); PIN(X); \
      NP[4*(NG)]=nx_.x-mhat; NP[4*(NG)+1]=nx_.y-mhat; NP[4*(NG)+2]=nx_.z-mhat; NP[4*(NG)+3]=nx_.w-mhat; PIN(NP); nx_=cbn_[NXI]; SBAR(); }while(0)
  #define VRD(i) do{ vlo[i]=vtr(vp_+(((i)>>2)*4096+((i)&3)*1024)); vhi[i]=vtr(vp_+(((i)>>2)*4096+((i)&3)*1024+512)); }while(0)
  #define KRD(G,j) do{ if(G){ kload2(kf,kp0+sl_next,j); SBAR(); } }while(0)
  #define STEP(C0,C1,P0,P1,t,GK,GV,GL) do{ SBAR(); const lds_f4c cbn_=ckb+((t)+1)*16; \
    const lds_cptr vp_=vp0+sl_prev; \
    VRD(0); SBAR(); float sacc=(P0[0]+P0[1]); \
    GAPA(C0=__builtin_amdgcn_mfma_f32_32x32x16_bf16(kf[0],qr[0],C0,0,0,0), P0[2],P0[3],P0[4],P0[5],     pw0[0]=PKW(P0,0), pw0[1]=PKW(P0,2), pw0); \
    VRD(4); SBAR(); GAPA(C1=__builtin_amdgcn_mfma_f32_32x32x16_bf16(kf[1],qr[0],C1,0,0,0), P0[6],P0[7],P0[8],P0[9],     pw0[2]=PKW(P0,4), pw0[3]=PKW(P0,6), pw0); \
    VRD(1); SBAR(); GAPA(C0=__builtin_amdgcn_mfma_f32_32x32x16_bf16(kf[2],qr[1],C0,0,0,0),   P0[10],P0[11],P0[12],P0[13], pw1[0]=PKW(P0,8), pw1[1]=PKW(P0,10), pw1); \
    VRD(5); SBAR(); GAPA(C1=__builtin_amdgcn_mfma_f32_32x32x16_bf16(kf[3],qr[1],C1,0,0,0),   P0[14],P0[15],P1[0],P1[1],   pw1[2]=PKW(P0,12),pw1[3]=PKW(P0,14), pw1); \
    VRD(2); SBAR(); GAPA(C0=__builtin_amdgcn_mfma_f32_32x32x16_bf16(kf[4],qr[2],C0,0,0,0),   P1[2],P1[3],P1[4],P1[5],     pw2[0]=PKW(P1,0), pw2[1]=PKW(P1,2), pw2); \
    VRD(6); SBAR(); GAPA(C1=__builtin_amdgcn_mfma_f32_32x32x16_bf16(kf[5],qr[2],C1,0,0,0),   P1[6],P1[7],P1[8],P1[9],     pw2[2]=PKW(P1,4), pw2[3]=PKW(P1,6), pw2); \
    VRD(3); SBAR(); GAPA(C0=__builtin_amdgcn_mfma_f32_32x32x16_bf16(kf[6],qr[3],C0,0,0,0),   P1[10],P1[11],P1[12],P1[13], pw3[0]=PKW(P1,8), pw3[1]=PKW(P1,10), pw3); \
    VRD(7); SBAR(); GAPA(C1=__builtin_amdgcn_mfma_f32_32x32x16_bf16(kf[7],qr[3],C1,0,0,0),   P1[14],P1[15],0.f,0.f,       pw3[2]=PKW(P1,12),pw3[3]=PKW(P1,14), pw3); \
    l_reg+=sacc; \
    if(GK){DMA_K((t)+3,sl_cur);} if(GV){DMA_V((t)+1,sl_next);} \
    CMASK(C0,C1,t); \
    { float a=MX3(C0[0],C0[1],C1[0]),b=MX3(C0[2],C0[3],C1[1]); a=MX3(a,C1[2],C1[3]); \
      _Pragma("unroll") for(int r=4;r<16;r+=4){a=MX3(a,C0[r],C0[r+1]);b=MX3(b,C0[r+2],C0[r+3]);a=MX3(a,C1[r],C1[r+1]);b=MX3(b,C1[r+2],C1[r+3]);} \
      float rm=__builtin_fmaxf(a,b); { auto rr=__builtin_amdgcn_permlane32_swap(__float_as_uint(rm),__float_as_uint(rm),false,false); rm=__builtin_fmaxf(__uint_as_float(rr[0]),__uint_as_float(rr[1])); } \
      resc=false; \
      if(__builtin_expect(__any(rm>(float)THRL),1)){ const float dl=__builtin_fmaxf(rm,0.f); mhat+=dl; \
        _Pragma("unroll") for(int r=0;r<16;++r){C0[r]-=dl;C1[r]-=dl;} \
        const float f=__builtin_amdgcn_exp2f(-dl); l_reg*=f; if(hi==0)wsf[r32]=f; resc=true; } } \
    f32x4 nx_=cbn_[0]; SBAR(); \
    GAPB(o[0]=__builtin_amdgcn_mfma_f32_32x32x16_bf16(PAF(0),VFR(0),o[0],0,0,0), C0,0, P0,0,2); \
    GAPB(o[1]=__builtin_amdgcn_mfma_f32_32x32x16_bf16(PAF(0),VFR(4),o[1],0,0,0), C0,4, P0,1,4); \
    KRD(GL,0); GAPB(o[0]=__builtin_amdgcn_mfma_f32_32x32x16_bf16(PAF(1),VFR(1),o[0],0,0,0), C0,8, P0,2,6); \
    KRD(GL,1); GAPB(o[1]=__builtin_amdgcn_mfma_f32_32x32x16_bf16(PAF(1),VFR(5),o[1],0,0,0), C0,12, P0,3,8); \
    KRD(GL,2); GAPB(o[0]=__builtin_amdgcn_mfma_f32_32x32x16_bf16(PAF(2),VFR(2),o[0],0,0,0), C1,0, P1,0,10); \
    KRD(GL,3); GAPB(o[1]=__builtin_amdgcn_mfma_f32_32x32x16_bf16(PAF(2),VFR(6),o[1],0,0,0), C1,4, P1,1,12); \
    GAPB(o[0]=__builtin_amdgcn_mfma_f32_32x32x16_bf16(PAF(3),VFR(3),o[0],0,0,0), C1,8, P1,2,14); \
    GAPB(o[1]=__builtin_amdgcn_mfma_f32_32x32x16_bf16(PAF(3),VFR(7),o[1],0,0,0), C1,12, P1,3,14); \
    }while(0)
  int t=1;
  #undef CMASK
  #define CMASK(P0,P1,t) do{}while(0)
  for(;t+5<NT;t+=2){
    STEP(pB0,pB1,pA0,pA1,t,true,true,true);     WAIT_BAR(2); RESC(); ROT();
    STEP(pA0,pA1,pB0,pB1,t+1,true,true,true);   WAIT_BAR(2); RESC(); ROT();
  }
  #undef CMASK
  #define CMASK(P0,P1,t) do{int jb_=(t)-(NT-4); if(jb_>=0)cmask(P0,P1,jb_,qrel,hi);}while(0)
  #define ENDW(tt) do{ if((tt)+3<NT){WAIT_BAR(2);} else if((tt)+2<NT){WAIT_BAR(1);} else {WAIT_BAR(0);} }while(0)
  for(;t+1<NT;t+=2){
    STEP(pB0,pB1,pA0,pA1,t,(t+3<NT),(t+1<NT),(t+1<NT));       ENDW(t);   RESC(); ROT();
    STEP(pA0,pA1,pB0,pB1,t+1,(t+4<NT),(t+2<NT),(t+2<NT));     ENDW(t+1); RESC(); ROT();
  }
  STEP(pB0,pB1,pA0,pA1,NT-1,false,false,false); RESC();
  { float sacc=pB0[0]+pB0[1]; _Pragma("unroll") for(int r=2;r<16;++r)sacc+=pB0[r]; _Pragma("unroll") for(int r=0;r<16;++r)sacc+=pB1[r]; l_reg+=sacc;
    pw0=(u32x4){PKW(pB0,0),PKW(pB0,2),PKW(pB0,4),PKW(pB0,6)};pw1=(u32x4){PKW(pB0,8),PKW(pB0,10),PKW(pB0,12),PKW(pB0,14)};pw2=(u32x4){PKW(pB1,0),PKW(pB1,2),PKW(pB1,4),PKW(pB1,6)};pw3=(u32x4){PKW(pB1,8),PKW(pB1,10),PKW(pB1,12),PKW(pB1,14)};
    SBAR(); pv(o,vb0+sl_cur,PAF(0),PAF(1),PAF(2),PAF(3)); }
  #undef PKW
  #undef PAF
  #undef VFR
  #undef PIN
  #undef MX3
  #undef GAPA
  #undef GAPB
  #undef EX
  #undef VRD
  #undef KRD
  #undef STEP
  #undef ENDW
  {auto rr=__builtin_amdgcn_permlane32_swap(__float_as_uint(l_reg),__float_as_uint(l_reg),false,false);l_reg=__uint_as_float(rr[0])+__uint_as_float(rr[1]);}
  if(hi==0)wsf[32+r32]=l_reg;asm volatile("s_waitcnt lgkmcnt(0)":::"memory");
  float rli[16];
  #pragma unroll
  for(int r=0;r<16;++r)rli[r]=__builtin_amdgcn_rcpf(wsf[32+crow(r,hi)]);
  bf16*Ow=O+(rowbase+q0+wid*QBLK)*ODM+h*D; const bf16*Gw=G+(rowbase+q0+wid*QBLK)*DM+h*D;
  { const lds_fw stg=(lds_fw)(shm3w+LDS_OST)+wid*2048;
    #pragma unroll
    for(int r=0;r<16;++r){const int orow=crow(r,hi);
      #pragma unroll
      for(int d0=0;d0<2;++d0)stg[orow*64+d0*32+r32]=o[d0][r]*rli[r];}
    asm volatile("s_waitcnt lgkmcnt(0)":::"memory");
    int le=lane; asm volatile("":"+v"(le));
    const int ch=le&7; const f32x4 g0=*(const f32x4*)(gain+h*D+ch*8), g1=*(const f32x4*)(gain+h*D+ch*8+4);
    #pragma unroll
    for(int i=0;i<4;++i){const int row=i*8+(le>>3);
      const f32x4 a=*(lds_f4c)(stg+row*64+ch*8), c=*(lds_f4c)(stg+row*64+ch*8+4);
      const u32x4 gw=*(const u32x4*)(Gw+(long)row*DM+ch*8);
      float ss=(a.x*a.x+a.y*a.y)+(a.z*a.z+a.w*a.w)+(c.x*c.x+c.y*c.y)+(c.z*c.z+c.w*c.w);
      ss+=__shfl_xor(ss,1);ss+=__shfl_xor(ss,2);ss+=__shfl_xor(ss,4);
      const float rstd=__builtin_amdgcn_rsqf(ss*(1.f/64.f)+1e-6f);
      float gt[8];
      #pragma unroll
      for(int e=0;e<4;++e){ const unsigned w=gw[e]; const float lo=__uint_as_float(w<<16), hi_=__uint_as_float(w&0xffff0000u);
        gt[2*e]=__builtin_amdgcn_rcpf(1.f+__builtin_amdgcn_exp2f(-1.4426950408889634f*lo)); gt[2*e+1]=__builtin_amdgcn_rcpf(1.f+__builtin_amdgcn_exp2f(-1.4426950408889634f*hi_)); }
      u32x4 v; v.x=cvtpk_s(a.x*rstd*g0.x*gt[0],a.y*rstd*g0.y*gt[1]); v.y=cvtpk_s(a.z*rstd*g0.z*gt[2],a.w*rstd*g0.w*gt[3]);
      v.z=cvtpk_s(c.x*rstd*g1.x*gt[4],c.y*rstd*g1.y*gt[5]); v.w=cvtpk_s(c.z*rstd*g1.z*gt[6],c.w*rstd*g1.w*gt[7]);
      ATTN_STORE16(Ow+(long)row*ODM+ch*8,v);} }
  asm volatile("s_waitcnt lgkmcnt(0)\n\ts_barrier":::"memory");
  #undef DMA_K
  #undef DMA_V
  #undef CMASK
  #undef START
  #undef CINIT
  #undef RESC
  #undef ROT
}
constexpr int ATTN_LDS_BYTES=LDS_BYTES;
#undef SBAR
#undef WAIT_BAR
}

namespace ret_body {
#define RB_LAS __attribute__((address_space(3)))
typedef unsigned short bf16;
typedef short bf16x8 __attribute__((ext_vector_type(8)));
typedef short s16x4 __attribute__((ext_vector_type(4)));
typedef float f32x16 __attribute__((ext_vector_type(16)));
typedef float f32x4 __attribute__((ext_vector_type(4)));
typedef unsigned u32x4 __attribute__((ext_vector_type(4)));
typedef unsigned u32x2 __attribute__((ext_vector_type(2)));
typedef RB_LAS unsigned char* lptr;
constexpr int DM = 4096, ODM = 1024, SEQ = 2048, CH = 128;
constexpr int L_K = 0, L_V = 32768, L_T = 65536, L_STG = 98304, L_SSQ = 132096, RET_LDS_END = 133120;
__device__ __forceinline__ unsigned offb(unsigned row, unsigned ch) { return 2048u * (row >> 3) + 512u * (ch >> 2) + 64u * (row & 7u) + 16u * ((ch & 3u) ^ ((row >> 2) & 3u)); }
__device__ __forceinline__ int crow(int r, int hi) { return (r & 3) + 8 * (r >> 2) + 4 * hi; }
__device__ __forceinline__ s16x4 trr(lptr p) { typedef short v4i16_t __attribute__((ext_vector_type(4))); return __builtin_bit_cast(s16x4, __builtin_amdgcn_ds_read_tr16_b64_v4i16((RB_LAS v4i16_t*)p)); }
typedef float f32x2_t __attribute__((ext_vector_type(2))); typedef __bf16 bf16x2_t __attribute__((ext_vector_type(2)));
__device__ __forceinline__ unsigned cvtpk(float lo, float hi) { f32x2_t v = {lo, hi}; bf16x2_t b = __builtin_convertvector(v, bf16x2_t); return __builtin_bit_cast(unsigned, b); }
#define RB_MFMA(a, b, c) __builtin_amdgcn_mfma_f32_32x32x16_bf16((a), (b), (c), 0, 0, 0)
#define RB_BAR() asm volatile("s_waitcnt vmcnt(0) lgkmcnt(0)\n\ts_barrier" ::: "memory")

__device__ __forceinline__ void ret_unit(int b, const bf16* __restrict__ P, int cq, int ck, int cv, int cg, const float* __restrict__ gain, bf16* __restrict__ O, float lg2, unsigned char* lds_generic) {
    int tid_ = threadIdx.x; asm volatile("" : "+v"(tid_));
    const int tid = tid_, lane = tid & 63, r32 = lane & 31, hi = lane >> 5; const int wid = __builtin_amdgcn_readfirstlane(tid >> 6);
    const int qw = (wid < 4) ? wid : 7 - wid, dvh = wid >> 2, dkq = wid & 3;
    const lptr L = (lptr)lds_generic;
    const float gC = exp2f(128.f * lg2);
    const size_t rowbase = (size_t)b * SEQ;
    const unsigned blk = (lane >> 4) & 1, q4 = (lane & 15) >> 2, p4 = lane & 3;
    const unsigned Y = (r32 >> 2) & 3u, rbase = 2048u * (r32 >> 3) + 64u * (r32 & 7u);
    const unsigned rd_e = rbase + 16u * ((unsigned)hi ^ Y), rd_o = rbase + 16u * ((2u + hi) ^ Y);
    const unsigned xc = 2u * blk + (p4 >> 1);
    const unsigned tn0 = 2048u * hi + 64u * q4 + 16u * (xc ^ (2u * hi)) + 8u * (p4 & 1), tn1 = 2048u * hi + 256u + 64u * q4 + 16u * (xc ^ (2u * hi + 1u)) + 8u * (p4 & 1);
    const unsigned tp0 = 256u * hi + 64u * q4 + 16u * (xc ^ (unsigned)hi) + 8u * (p4 & 1), tp1 = 2048u + 256u * hi + 64u * q4 + 16u * (xc ^ (2u + hi)) + 8u * (p4 & 1);
    const unsigned aT_e = L_T + 16384u * dvh + rd_e, aT_o = L_T + 16384u * dvh + rd_o, aK_e = L_K + rd_e, aK_o = L_K + rd_o;
    const unsigned aVp0 = L_V + 1024u * dvh + tp0, aVp1 = L_V + 1024u * dvh + tp1, aVn0 = L_V + 1024u * dvh + tn0, aVn1 = L_V + 1024u * dvh + tn1, aKn0 = L_K + 512u * dkq + tn0, aKn1 = L_K + 512u * dkq + tn1;
    unsigned wg[4];
#pragma unroll
    for (int g = 0; g < 4; ++g) wg[g] = rbase + 16u * ((unsigned)g ^ Y) + 8u * hi;
    for (int i = tid; i < 2048; i += 512) *(RB_LAS u32x4*)(L + L_T + 16 * i) = (u32x4){0u, 0u, 0u, 0u};
    f32x16 t0, t1;
#pragma unroll
    for (int r = 0; r < 16; ++r) { t0[r] = 0.f; t1[r] = 0.f; }
    u32x4 kpre[4], vpre[4];
#define RB_LOADKV(c) do { _Pragma("unroll") for (int i_ = 0; i_ < 4; ++i_) { const int id_ = tid + 512 * i_; const size_t g_ = (rowbase + (size_t)(c) * CH + (id_ >> 4)) * DM + (id_ & 15) * 8; \
        kpre[i_] = *(const u32x4*)(P + g_ + ck); vpre[i_] = *(const u32x4*)(P + g_ + cv); } } while (0)
#define RB_STOREKV() do { _Pragma("unroll") for (int i_ = 0; i_ < 4; ++i_) { const int id_ = tid + 512 * i_; const unsigned o_ = offb(id_ >> 4, id_ & 15); \
        *(RB_LAS u32x4*)(L + L_K + o_) = kpre[i_]; *(RB_LAS u32x4*)(L + L_V + o_) = vpre[i_]; } } while (0)
    RB_LOADKV(0); RB_STOREKV();
    bf16x8 qf[8];
#define RB_LOADQ(c) do { const bf16* q_ = P + (rowbase + (size_t)(c) * CH + 32 * qw + r32) * DM + cq + 8 * hi; _Pragma("unroll") for (int s_ = 0; s_ < 8; ++s_) qf[s_] = *(const bf16x8*)(q_ + 16 * s_); } while (0)
    RB_LOADQ(0);
    RB_BAR();
    for (int c = 0; c < 16; ++c) {
        if (c + 1 < 16) RB_LOADKV(c + 1);
        u32x2 gt[2][4];
        { const bf16* g_ = P + (rowbase + (size_t)c * CH + 32 * qw + r32) * DM + cg + 64 * dvh + 4 * hi;
#pragma unroll
          for (int cc = 0; cc < 2; ++cc)
#pragma unroll
              for (int g = 0; g < 4; ++g) gt[cc][g] = *(const u32x2*)(g_ + 32 * cc + 8 * g); }
        f32x16 o0, o1;
#pragma unroll
        for (int r = 0; r < 16; ++r) { o0[r] = 0.f; o1[r] = 0.f; }
#pragma unroll
        for (int s = 0; s < 8; ++s) {
            const bf16x8 a0 = *(const RB_LAS bf16x8*)(L + ((s & 1) ? aT_o : aT_e) + 512 * (s >> 1));
            const bf16x8 a1 = *(const RB_LAS bf16x8*)(L + ((s & 1) ? aT_o : aT_e) + 8192 + 512 * (s >> 1));
            o0 = RB_MFMA(a0, qf[s], o0); o1 = RB_MFMA(a1, qf[s], o1);
        }
#pragma unroll
        for (int kb = 0; kb < 4; ++kb) if (kb <= qw) {
            f32x16 p;
#pragma unroll
            for (int r = 0; r < 16; ++r) p[r] = 0.f;
#pragma unroll
            for (int s = 0; s < 8; ++s) { const bf16x8 kf = *(const RB_LAS bf16x8*)(L + ((s & 1) ? aK_o : aK_e) + 8192 * kb + 512 * (s >> 1)); p = RB_MFMA(kf, qf[s], p); }
            if (kb == qw) {
#pragma unroll
                for (int r = 0; r < 16; ++r) if (crow(r, hi) > r32) p[r] = 0.f;
            }
            u32x4 pw0, pw1;
            pw0.x = cvtpk(p[0], p[1]); pw0.y = cvtpk(p[2], p[3]); pw0.z = cvtpk(p[4], p[5]); pw0.w = cvtpk(p[6], p[7]);
            pw1.x = cvtpk(p[8], p[9]); pw1.y = cvtpk(p[10], p[11]); pw1.z = cvtpk(p[12], p[13]); pw1.w = cvtpk(p[14], p[15]);
            const bf16x8 pf0 = __builtin_bit_cast(bf16x8, pw0), pf1 = __builtin_bit_cast(bf16x8, pw1);
#pragma unroll
            for (int s = 0; s < 2; ++s) {
#pragma unroll
                for (int cc = 0; cc < 2; ++cc) {
                    const s16x4 lo = trr(L + aVp0 + 4096 * (2 * kb + s) + 512 * cc), hh = trr(L + aVp1 + 4096 * (2 * kb + s) + 512 * cc);
                    const bf16x8 vf = (bf16x8){lo[0], lo[1], lo[2], lo[3], hh[0], hh[1], hh[2], hh[3]};
                    if (cc == 0) o0 = RB_MFMA(vf, s == 0 ? pf0 : pf1, o0); else o1 = RB_MFMA(vf, s == 0 ? pf0 : pf1, o1);
                }
            }
        }
        if (c + 1 < 16) RB_LOADQ(c + 1);
        { float ss = 0.f;
#pragma unroll
          for (int r = 0; r < 16; ++r) ss += o0[r] * o0[r] + o1[r] * o1[r];
          auto rr = __builtin_amdgcn_permlane32_swap(__float_as_uint(ss), __float_as_uint(ss), false, false);
          ss = __uint_as_float(rr[0]) + __uint_as_float(rr[1]);
          if (hi == 0) *(RB_LAS float*)(L + L_SSQ + 4 * (128 * dvh + 32 * qw + r32)) = ss; }
#pragma unroll
        for (int ks = 0; ks < 8; ++ks) {
            const s16x4 klo = trr(L + aKn0 + 4096 * ks), khh = trr(L + aKn1 + 4096 * ks);
            const bf16x8 kf = (bf16x8){klo[0], klo[1], klo[2], klo[3], khh[0], khh[1], khh[2], khh[3]};
#pragma unroll
            for (int cc = 0; cc < 2; ++cc) {
                const s16x4 lo = trr(L + aVn0 + 4096 * ks + 512 * cc), hh = trr(L + aVn1 + 4096 * ks + 512 * cc);
                const bf16x8 vf = (bf16x8){lo[0], lo[1], lo[2], lo[3], hh[0], hh[1], hh[2], hh[3]};
                if (cc == 0) t0 = RB_MFMA(kf, vf, t0); else t1 = RB_MFMA(kf, vf, t1);
            }
        }
#pragma unroll
        for (int r = 0; r < 16; ++r) { t0[r] *= gC; t1[r] *= gC; }
        RB_BAR();
        { const float ssum = *(const RB_LAS float*)(L + L_SSQ + 4 * (32 * qw + r32)) + *(const RB_LAS float*)(L + L_SSQ + 4 * (128 + 32 * qw + r32));
          const float gn = exp2f((float)(32 * qw + r32) * lg2);
          const float rs = gn * rsqrtf(gn * gn * ssum * (1.f / 128.f) + 1e-6f);
#pragma unroll
          for (int cc = 0; cc < 2; ++cc)
#pragma unroll
              for (int g = 0; g < 4; ++g) {
                  const int dv0 = 64 * dvh + 32 * cc + 8 * g + 4 * hi;
                  const f32x4 gn4 = *(const f32x4*)(gain + dv0);
                  const unsigned w0 = gt[cc][g].x, w1 = gt[cc][g].y;
                  const float z0 = __uint_as_float(w0 << 16), z1 = __uint_as_float(w0 & 0xffff0000u), z2 = __uint_as_float(w1 << 16), z3 = __uint_as_float(w1 & 0xffff0000u);
                  const float s0 = z0 * __builtin_amdgcn_rcpf(1.f + __builtin_amdgcn_exp2f(-1.4426950408889634f * z0)), s1 = z1 * __builtin_amdgcn_rcpf(1.f + __builtin_amdgcn_exp2f(-1.4426950408889634f * z1));
                  const float s2 = z2 * __builtin_amdgcn_rcpf(1.f + __builtin_amdgcn_exp2f(-1.4426950408889634f * z2)), s3 = z3 * __builtin_amdgcn_rcpf(1.f + __builtin_amdgcn_exp2f(-1.4426950408889634f * z3));
                  const f32x16& oo = cc == 0 ? o0 : o1;
                  u32x2 w; w.x = cvtpk(oo[4 * g] * rs * gn4.x * s0, oo[4 * g + 1] * rs * gn4.y * s1); w.y = cvtpk(oo[4 * g + 2] * rs * gn4.z * s2, oo[4 * g + 3] * rs * gn4.w * s3);
                  *(RB_LAS u32x2*)(L + L_STG + 8192 * qw + 1024 * dvh + 512 * cc + wg[g]) = w;
              } }
#pragma unroll
        for (int cc = 0; cc < 2; ++cc)
#pragma unroll
            for (int g = 0; g < 4; ++g) { const f32x16& tt = cc == 0 ? t0 : t1;
                u32x2 w; w.x = cvtpk(tt[4 * g], tt[4 * g + 1]); w.y = cvtpk(tt[4 * g + 2], tt[4 * g + 3]);
                *(RB_LAS u32x2*)(L + L_T + 16384 * dvh + 8192 * cc + 512 * dkq + wg[g]) = w; }
        if (c + 1 < 16) RB_STOREKV();
        RB_BAR();
#pragma unroll
        for (int i = 0; i < 4; ++i) { const int id = tid + 512 * i, row = id >> 4, ch = id & 15;
            const u32x4 v = *(const RB_LAS u32x4*)(L + L_STG + offb(row, ch));
            *(u32x4*)(O + (rowbase + (size_t)c * CH + row) * ODM + ch * 8) = v; }
    }
    RB_BAR();
#undef RB_LOADKV
#undef RB_STOREKV
#undef RB_LOADQ
}
#undef RB_MFMA
#undef RB_BAR
}

constexpr int NWAVES = 8;
#ifndef MK_N_LAUNCHES
#define MK_N_LAUNCHES 1
#endif
constexpr int PER_PHASE = 9;
constexpr int N_LAUNCHES = MK_N_LAUNCHES;

constexpr int BATCH = 32, SEQ = 2048, D = 1024, M = BATCH * SEQ, FF = 4096, NPROJ = 4096, IN_COLS = 4104, NMOD = 6 * D;
constexpr float EPS = 1e-6f;
constexpr float LOG2E = 1.4426950408889634f, C2 = 0.18033688011112042f;
constexpr int C_FQ = 0, C_FK = 512, C_FV = 1024, C_FOG = 1536, C_RQ = 2048, C_RK = 2560, C_RV = 3072, C_RG = 3584;
constexpr int MOD_SHIFT_M = 0, MOD_SCALE_M = 1024, MOD_GATE_M = 2048, MOD_SHIFT_F = 3072, MOD_SCALE_F = 4096, MOD_GATE_F = 5120;

constexpr size_t MiB = 1u << 20;
constexpr size_t WS_CTL = 0, CTL_ZERO_BYTES = 2 * MiB;
constexpr size_t WS_MOD = 1 * MiB;
constexpr size_t WS_WIN = 2 * MiB, WS_WOUT = 10 * MiB, WS_W1 = 12 * MiB, WS_W2 = 20 * MiB;
constexpr size_t WS_WF = 28 * MiB;
constexpr size_t WS_ROPE = 29 * MiB;
constexpr size_t WS_LOGF = 30 * MiB, WS_CUM = 32 * MiB;
constexpr size_t WS_H = 64 * MiB, WS_MIX = 192 * MiB, WS_PROJ = 320 * MiB, WS_U = 320 * MiB, WS_END = 832 * MiB;
constexpr int CW_BAR = 4096;

constexpr int RING_OFF = 0, RING_BYTES = 131072;
constexpr int LDSCTL_OFF = RING_BYTES, MISC_OFF = LDSCTL_OFF + 320;
constexpr int LDS_BYTES = 147456;
#define GAS __attribute__((address_space(1)))
#define LAS __attribute__((address_space(3)))
typedef unsigned short bf16;
typedef unsigned v4u __attribute__((ext_vector_type(4)));
typedef float f32x4 __attribute__((ext_vector_type(4)));
typedef short bf16x8 __attribute__((ext_vector_type(8)));
typedef GAS unsigned gu32;
typedef GAS unsigned long long gu64;
#define RLX_AGENT __ATOMIC_RELAXED, __HIP_MEMORY_SCOPE_AGENT
#define LDS_WAIT() asm volatile("s_waitcnt lgkmcnt(0)" ::: "memory")
#define VM_WAIT() asm volatile("s_waitcnt vmcnt(0)" ::: "memory")
__device__ __forceinline__ unsigned long long rt() { return __builtin_amdgcn_s_memrealtime(); }
__device__ __forceinline__ unsigned f2bf(float f) { unsigned u = __builtin_bit_cast(unsigned, f); return (u + 0x7fffu + ((u >> 16) & 1u)) >> 16; }
__device__ __forceinline__ unsigned pk2(float lo, float hi) { return f2bf(lo) | (f2bf(hi) << 16); }

#define XB_TMO      128
#define XB_XCNT(j)  (256  + 64 * (j))
#define XB_XSUB(j)  (1280 + 64 * (j))
#define XB_XGEN(j)  (2304 + 64 * (j))
#define XB_TOP      3328
#define XB_TOPGEN   3392
#define XCD_BAR_WORDS 3456
#define XB_SPIN_CAP (1u << 18)

__device__ __forceinline__ unsigned xb_ld(unsigned* p)              { return __hip_atomic_load(p, __ATOMIC_RELAXED, __HIP_MEMORY_SCOPE_AGENT); }
__device__ __forceinline__ unsigned xb_add(unsigned* p, unsigned v) { return __hip_atomic_fetch_add(p, v, __ATOMIC_RELAXED, __HIP_MEMORY_SCOPE_AGENT); }
__device__ __forceinline__ unsigned xb_xcc_id() { return (unsigned)__builtin_amdgcn_s_getreg((3 << 11) | 20) & 0xFu; }
#define XB_SPIN(cond, bar) do { unsigned _sp = 0; while (cond) { __builtin_amdgcn_s_sleep(1); \
    if ((++_sp & 255u) == 0u) { if (xb_ld(&(bar)[XB_TMO])) break; if (_sp > XB_SPIN_CAP) { atomicAdd(&(bar)[XB_TMO], 1u); break; } } } } while (0)

struct XcdBarrier {
    unsigned* bar; unsigned x;
    volatile LAS unsigned* st;
};

__device__ __forceinline__ XcdBarrier xcd_barrier_post(unsigned* bar, volatile LAS unsigned* st) {
    XcdBarrier b; b.bar = bar; b.x = xb_xcc_id(); b.st = st;
    if (threadIdx.x == 0) (void)xb_add(&bar[XB_XCNT(b.x)], 1u);
    return b;
}
__device__ __forceinline__ void xcd_barrier_complete(unsigned* bar, unsigned x, unsigned& nloc, unsigned& nx) {
    const unsigned G = gridDim.x * gridDim.y * gridDim.z;
    unsigned sum, cnt, mine, sp = 0u;
    for (;;) {
        sum = 0u; cnt = 0u; mine = 0u;
#pragma unroll
        for (unsigned j = 0; j < 16; ++j) { const unsigned c = xb_ld(&bar[XB_XCNT(j)]); sum += c; cnt += (c > 0u) ? 1u : 0u; mine = (j == x) ? c : mine; }
        if (sum == G) break;
        __builtin_amdgcn_s_sleep(1);
        if ((++sp & 255u) == 0u) { if (xb_ld(&bar[XB_TMO])) break; if (sp > XB_SPIN_CAP) { atomicAdd(&bar[XB_TMO], 1u); break; } }
    }
    nloc = mine > 0u ? mine : 1u; nx = cnt > 0u ? cnt : 1u;
}

__device__ __forceinline__ void xcd_barrier(const XcdBarrier& b) {
    asm volatile("s_waitcnt vmcnt(0)" ::: "memory");
    __syncthreads();
    if (threadIdx.x == 0) {
        unsigned* bar = b.bar;
        __builtin_amdgcn_s_waitcnt(0);
        unsigned nloc = b.st[0], nx = b.st[1];
        if (nloc == 0u) { xcd_barrier_complete(bar, b.x, nloc, nx); b.st[0] = nloc; b.st[1] = nx; }
        const unsigned old = xb_add(&bar[XB_XSUB(b.x)], 1u);
        const unsigned gen = old / nloc;
        if (old + 1u == (gen + 1u) * nloc) {
            __builtin_amdgcn_fence(__ATOMIC_RELEASE, "agent");
            asm volatile("s_waitcnt vmcnt(0)" ::: "memory");
            const unsigned og = xb_add(&bar[XB_TOP], 1u);
            const unsigned tg = og / nx;
            if (og + 1u == (tg + 1u) * nx) xb_add(&bar[XB_TOPGEN], 1u);
            else XB_SPIN(xb_ld(&bar[XB_TOPGEN]) == tg, bar);
            __builtin_amdgcn_fence(__ATOMIC_ACQUIRE, "agent");
            xb_add(&bar[XB_XGEN(b.x)], 1u);
            asm volatile("s_waitcnt vmcnt(0)" ::: "memory");
        } else {
            XB_SPIN(xb_ld(&bar[XB_XGEN(b.x)]) == gen, bar);
            __builtin_amdgcn_fence(__ATOMIC_ACQUIRE, "agent");
            asm volatile("s_waitcnt vmcnt(0)" ::: "memory");
        }
    }
    __syncthreads();
}

struct Frame {
    LAS unsigned char* lds;
    volatile LAS unsigned* MISC;
    gu32* ctl;
    int tid, lane, wave;
    int vcu, G;
    const float *x, *c, *w_ada, *b_ada, *w_in, *b_forget, *qg, *kg, *fog, *rog, *w_out, *w1, *w2; float* out;
    bf16 *Win_t, *Wout_t, *W1_t, *W2_t;
    float *wf, *rope, *logf, *cum, *mod;
    bf16 *H, *MIXB, *PROJ, *U;
};
__device__ __forceinline__ float bf2f(unsigned short v) { return __uint_as_float((unsigned)v << 16); }
__device__ __forceinline__ float bflo(unsigned w) { return __uint_as_float(w << 16); }
__device__ __forceinline__ float bfhi(unsigned w) { return __uint_as_float(w & 0xffff0000u); }
__device__ __forceinline__ void unpack8(const v4u w, float* f) { f[0] = bflo(w.x); f[1] = bfhi(w.x); f[2] = bflo(w.y); f[3] = bfhi(w.y); f[4] = bflo(w.z); f[5] = bfhi(w.z); f[6] = bflo(w.w); f[7] = bfhi(w.w); }
__device__ __forceinline__ v4u pack8(const float* f) { v4u w; w.x = pk2(f[0], f[1]); w.y = pk2(f[2], f[3]); w.z = pk2(f[4], f[5]); w.w = pk2(f[6], f[7]); return w; }

template <int LINEMAP> __device__ __forceinline__ void p0_transpose_item(const float* W, int K, int ldn, int col_off, int nblk, bf16* WT, int row_off, LAS float* scr, int item, int lane) {
    const int kb = item / nblk, nb = item % nblk, k0 = 64 * kb, n0 = 32 * nb;
    const int c0 = row_off + n0; const int a0 = c0 & 255;
    const int drow = (LINEMAP == 2 && c0 >= 2048 && c0 < 3072) ? (c0 & ~255) + 128 * ((a0 >> 6) & 1) + 32 * (2 * (a0 >> 7) + ((a0 >> 5) & 1))
                   : LINEMAP ? (c0 & ~255) + 128 * ((a0 >> 5) & 1) + 32 * (a0 >> 6) : c0;
#pragma unroll 8
    for (int i = 0; i < 32; ++i) { const int kk = 2 * i + (lane >> 5); scr[kk * 33 + (lane & 31)] = W[(size_t)(k0 + kk) * ldn + col_off + n0 + (lane & 31)]; }
    LDS_WAIT(); asm volatile("" ::: "memory");
    const int c = lane & 7;
#pragma unroll
    for (int j = 0; j < 4; ++j) { const int n = (lane >> 3) + 8 * j; const LAS float* s = scr + (8 * c) * 33 + n;
        v4u o; o.x = pk2(s[0 * 33], s[1 * 33]); o.y = pk2(s[2 * 33], s[3 * 33]); o.z = pk2(s[4 * 33], s[5 * 33]); o.w = pk2(s[6 * 33], s[7 * 33]);
        *(GAS v4u*)(WT + (size_t)(drow + n) * K + k0 + 8 * c) = o; }
    LDS_WAIT(); asm volatile("" ::: "memory");
}
__device__ __forceinline__ void p0_mod_item(Frame& F, LAS float* scr, int item) {
    const int cg = item % 96, ks = item / 96; const int e = cg * 64 + F.lane, k0 = ks * 128;
#pragma unroll 4
    for (int i = 0; i < 64; ++i) { const int idx = i * 64 + F.lane; const int kk = idx >> 5, b = idx & 31; const float cv = F.c[b * D + k0 + kk]; scr[idx] = cv / (1.f + expf(-cv)); }
    LDS_WAIT(); asm volatile("" ::: "memory");
    float acc[32];
#pragma unroll
    for (int b = 0; b < 32; ++b) acc[b] = 0.f;
#pragma unroll 4
    for (int kk = 0; kk < 128; ++kk) { const float w = F.w_ada[(size_t)(k0 + kk) * NMOD + e];
#pragma unroll
        for (int b4 = 0; b4 < 8; ++b4) { const f32x4 s = *(const LAS f32x4*)(scr + kk * 32 + 4 * b4);
            acc[4 * b4 + 0] += s.x * w; acc[4 * b4 + 1] += s.y * w; acc[4 * b4 + 2] += s.z * w; acc[4 * b4 + 3] += s.w * w; } }
    const float bias = (ks == 0) ? F.b_ada[e] : 0.f;
#pragma unroll
    for (int b = 0; b < 32; ++b) atomicAdd(&F.mod[b * NMOD + e], acc[b] + bias);
    LDS_WAIT(); asm volatile("" ::: "memory");
}
__device__ __forceinline__ void p0_rope_item(Frame& F, int s) {
    const int j = F.lane;
    double f = 1.0, p = 0.86596432336006535; int e = j;
#pragma unroll
    for (int bit = 0; bit < 6; ++bit) { if (e & 1) f *= p; p *= p; e >>= 1; }
    const double ang = (double)s * f;
    const double kq = rint(ang * 0.63661977236758134);
    const double r = fma(-kq, 1.5707963267948966, ang) - kq * 6.123233995736766e-17;
    const double r2 = r * r;
    const double sn = r * (1.0 + r2 * (-1.0 / 6.0 + r2 * (1.0 / 120.0 + r2 * (-1.0 / 5040.0 + r2 * (1.0 / 362880.0 + r2 * (-1.0 / 39916800.0 + r2 * (1.0 / 6227020800.0)))))));
    const double cs = 1.0 + r2 * (-0.5 + r2 * (1.0 / 24.0 + r2 * (-1.0 / 720.0 + r2 * (1.0 / 40320.0 + r2 * (-1.0 / 3628800.0 + r2 * (1.0 / 479001600.0 + r2 * (-1.0 / 87178291200.0)))))));
    const int q = ((int)kq) & 3;
    const double S = (q == 0) ? sn : (q == 1) ? cs : (q == 2) ? -sn : -cs;
    const double C = (q == 0) ? cs : (q == 1) ? -sn : (q == 2) ? -cs : sn;
    F.rope[s * 128 + j] = (float)C; F.rope[s * 128 + 64 + j] = (float)S;
}
__device__ __forceinline__ void p0_prologue(Frame& F) {
    LAS float* scr = (LAS float*)(F.lds + RING_OFF + F.wave * 16384);
    const int gw = F.vcu * NWAVES + F.wave, NGW = F.G * NWAVES;
    constexpr int I_INA = (D / 64) * (2048 / 32), I_INB = I_INA, I_O = (D / 64) * (D / 32), I_1 = (D / 64) * (FF / 32), I_2 = (FF / 64) * (D / 32);
    constexpr int I_MOD = 96 * 8, I_ROPE = SEQ, I_WF = 8;
    constexpr int NITEMS = I_MOD + I_INA + I_INB + I_O + I_1 + I_2 + I_ROPE + I_WF;
    for (int it = gw; it < NITEMS; it += NGW) {
        int r = it;
        if (r < I_MOD) { p0_mod_item(F, scr, r); continue; } r -= I_MOD;
        if (r < I_INA) { p0_transpose_item<2>(F.w_in, D, IN_COLS, 0, 2048 / 32, F.Win_t, 0, scr, r, F.lane); continue; } r -= I_INA;
        if (r < I_INB) { p0_transpose_item<2>(F.w_in, D, IN_COLS, 2056, 2048 / 32, F.Win_t, 2048, scr, r, F.lane); continue; } r -= I_INB;
        if (r < I_O) { p0_transpose_item<0>(F.w_out, D, D, 0, D / 32, F.Wout_t, 0, scr, r, F.lane); continue; } r -= I_O;
        if (r < I_1) { p0_transpose_item<1>(F.w1, D, FF, 0, FF / 32, F.W1_t, 0, scr, r, F.lane); continue; } r -= I_1;
        if (r < I_2) { p0_transpose_item<0>(F.w2, FF, D, 0, D / 32, F.W2_t, 0, scr, r, F.lane); continue; } r -= I_2;
        if (r < I_ROPE) { p0_rope_item(F, r); continue; } r -= I_ROPE;
        { for (int k = F.lane; k < D; k += 64) F.wf[r * D + k] = F.w_in[(size_t)k * IN_COLS + 2048 + r]; }
    }
}

__device__ __forceinline__ float wave_sum(float v) {
#pragma unroll
    for (int o = 1; o < 64; o <<= 1) v += __shfl_xor(v, o);
    return v;
}
__device__ __forceinline__ float reduce8(const float* p, int lane) {
    const bool b0 = lane & 1, b1 = lane & 2, b2 = lane & 4;
    float q[4], r[2];
#pragma unroll
    for (int i = 0; i < 4; ++i) { const float send = b0 ? p[i] : p[i + 4], keep = b0 ? p[i + 4] : p[i]; q[i] = keep + __shfl_xor(send, 1); }
#pragma unroll
    for (int i = 0; i < 2; ++i) { const float send = b1 ? q[i] : q[i + 2], keep = b1 ? q[i + 2] : q[i]; r[i] = keep + __shfl_xor(send, 2); }
    const float send = b2 ? r[0] : r[1], keep = b2 ? r[1] : r[0];
    float s = keep + __shfl_xor(send, 4);
    s += __shfl_xor(s, 8); s += __shfl_xor(s, 16); s += __shfl_xor(s, 32);
    return s;
}
template <bool FORGET> __device__ __forceinline__ void norm_phase(Frame& F, const float* xin, int mod_scale, int mod_shift) {
    LAS float* sc = (LAS float*)F.lds; LAS float* sh = sc + 1024; LAS float* wfl = sh + 1024; LAS float* bfl = wfl + 8192;
    for (int chunk = F.vcu; chunk < M / 256; chunk += F.G) {
        const int b = chunk >> 3;
        __syncthreads();
        for (int i = F.tid; i < 1024; i += NWAVES * 64) { sc[i] = 1.f + F.mod[b * NMOD + mod_scale + i]; sh[i] = F.mod[b * NMOD + mod_shift + i]; }
        if (FORGET) { for (int i = F.tid; i < 8192; i += NWAVES * 64) wfl[i] = F.wf[i]; if (F.tid < 8) bfl[F.tid] = F.b_forget[F.tid]; }
        __syncthreads();
        for (int rp = 0; rp < 32; ++rp) {
            const int row = chunk * 256 + F.wave * 32 + rp;
            const GAS f32x4* xr = (const GAS f32x4*)(xin + (size_t)row * D) + F.lane;
            f32x4 v[4]; float ss = 0.f;
#pragma unroll
            for (int j = 0; j < 4; ++j) { v[j] = xr[64 * j]; ss += (v[j].x * v[j].x + v[j].y * v[j].y) + (v[j].z * v[j].z + v[j].w * v[j].w); }
            const float rstd = rsqrtf(wave_sum(ss) * (1.f / D) + EPS);
            GAS unsigned long long* o8 = (GAS unsigned long long*)(F.H + (size_t)row * D) + F.lane;
#pragma unroll
            for (int j = 0; j < 4; ++j) { const f32x4 s4 = *(const LAS f32x4*)(sc + 4 * F.lane + 256 * j), h4 = *(const LAS f32x4*)(sh + 4 * F.lane + 256 * j);
                v[j] = v[j] * rstd * s4 + h4;
                o8[64 * j] = (unsigned long long)pk2(v[j].x, v[j].y) | ((unsigned long long)pk2(v[j].z, v[j].w) << 32); }
            if (FORGET) {
                float p[8];
#pragma unroll
                for (int hh = 0; hh < 8; ++hh) { float a = 0.f;
#pragma unroll
                    for (int j = 0; j < 4; ++j) { const f32x4 w4 = *(const LAS f32x4*)(wfl + hh * 1024 + 4 * F.lane + 256 * j); a += (v[j].x * w4.x + v[j].y * w4.y) + (v[j].z * w4.z + v[j].w * w4.w); }
                    p[hh] = a; }
                const float tot = reduce8(p, F.lane);
                if (F.lane < 8) { const int hs = 4 * (F.lane & 1) + 2 * ((F.lane >> 1) & 1) + ((F.lane >> 2) & 1);
                    const float z = tot + bfl[hs];
                    const float lf = fminf(z, 0.f) - log1pf(expf(-fabsf(z)));
                    F.logf[((size_t)(b * 8 + hs)) * SEQ + (row & (SEQ - 1))] = lf; }
            }
        }
    }
}
__device__ __forceinline__ void cumsum_seq(Frame& F, int seq) {
    const float* src = F.logf + (size_t)seq * SEQ + 32 * F.lane; float* dst = F.cum + (size_t)seq * SEQ + 32 * F.lane;
    double run = 0.0; float v[32];
#pragma unroll
    for (int i = 0; i < 8; ++i) { const f32x4 t = *(const f32x4*)(src + 4 * i); v[4 * i] = t.x; v[4 * i + 1] = t.y; v[4 * i + 2] = t.z; v[4 * i + 3] = t.w; }
#pragma unroll
    for (int i = 0; i < 32; ++i) run += (double)v[i];
    double t = run;
#pragma unroll
    for (int o = 1; o < 64; o <<= 1) { const double n = __shfl_up(t, o); if (F.lane >= o) t += n; }
    double acc = t - run;
#pragma unroll
    for (int i = 0; i < 8; ++i) { f32x4 o4; acc += (double)v[4 * i]; o4.x = (float)(acc * 1.4426950408889634); acc += (double)v[4 * i + 1]; o4.y = (float)(acc * 1.4426950408889634);
        acc += (double)v[4 * i + 2]; o4.z = (float)(acc * 1.4426950408889634); acc += (double)v[4 * i + 3]; o4.w = (float)(acc * 1.4426950408889634); *(f32x4*)(dst + 4 * i) = o4; }
}

__device__ __forceinline__ void post_row(Frame& F, size_t row) {
    bf16* p = F.PROJ + row * NPROJ; const int lane = F.lane; const int s = (int)(row & (SEQ - 1));
    {
        const int hd = lane >> 2, sl = lane & 3; bf16* a = p + hd * 64 + sl * 16;
        float v[16]; unpack8(*(const v4u*)a, v); unpack8(*(const v4u*)(a + 8), v + 8);
        float ss = 0.f;
#pragma unroll
        for (int i = 0; i < 16; ++i) ss += v[i] * v[i];
        ss += __shfl_xor(ss, 1); ss += __shfl_xor(ss, 2);
        const float rstd = rsqrtf(ss * (1.f / 64.f) + EPS);
        const float* g = ((hd < 8) ? F.qg : F.kg) + sl * 16; const float scl = (hd < 8) ? C2 * rstd : rstd;
#pragma unroll
        for (int i = 0; i < 16; ++i) v[i] = v[i] * scl * g[i];
        *(v4u*)a = pack8(v); *(v4u*)(a + 8) = pack8(v + 8);
    }
    {
        const int hh = lane >> 3, i0 = (lane & 7) * 8; bf16* a = p + C_RQ + hh * 128 + i0;
        float x1[8], x2[8]; unpack8(*(const v4u*)a, x1); unpack8(*(const v4u*)(a + 64), x2);
        const float* ct = F.rope + s * 128 + i0; const float* st = ct + 64;
        const int hk = hh & 3; const float lg2 = (hk == 0) ? -0.04580368961312479f : (hk == 1) ? -0.02272007650008353f : (hk == 2) ? -0.011315313227834146f : -0.005646563141142063f;
        const float scl = (hh >= 4) ? 0.08838834764831845f * exp2f(-lg2 * (float)(s & 127)) : 1.f;
        float y1[8], y2[8];
#pragma unroll
        for (int i = 0; i < 8; ++i) { const float c = ct[i], sn = st[i]; y1[i] = (x1[i] * c - x2[i] * sn) * scl; y2[i] = (x1[i] * sn + x2[i] * c) * scl; }
        *(v4u*)a = pack8(y1); *(v4u*)(a + 64) = pack8(y2);
    }
}

__device__ __forceinline__ void fox_item(Frame& F, unsigned char* lds_generic, int bh, int qb) {
    attn_body::attn_unit<8>(bh >> 3, bh & 7, qb, (const attn_body::bf16*)(F.PROJ + C_FQ), (const attn_body::bf16*)(F.PROJ + C_FK), (const attn_body::bf16*)(F.PROJ + C_FV),
                            (const attn_body::bf16*)(F.PROJ + C_FOG), F.cum, F.fog, (attn_body::bf16*)F.MIXB, (char*)lds_generic + RING_OFF);
}
__device__ __forceinline__ void ret_item(Frame& F, unsigned char* lds_generic, int bh) {
    const int b = bh >> 2, h = bh & 3;
    const float lg2 = (h == 0) ? -0.04580368961312479f : (h == 1) ? -0.02272007650008353f : (h == 2) ? -0.011315313227834146f : -0.005646563141142063f;
    ret_body::ret_unit(b, F.PROJ, C_RQ + h * 128, C_RK + h * 128, C_RV + h * 128, C_RG + h * 128, F.rog + h * 128, F.MIXB + 512 + h * 128, lg2, lds_generic + RING_OFF);
}
__device__ __forceinline__ void mixer_phase(Frame& F, unsigned char* lds_generic) {
    static_assert(attn_body::ATTN_LDS_BYTES <= RING_BYTES && ret_body::RET_LDS_END <= LDS_BYTES, "mixer LDS");
    if (F.G == 256) {
        const int j = F.vcu >> 1;
        if ((F.vcu & 1) == 0) {
            ret_item(F, lds_generic, j);
            const unsigned long long A = 0xAC5E7ull;
            for (int i = 0; i < 5; ++i) { const int it = (int)(A >> (4 * i)) & 15; fox_item(F, lds_generic, 2 * j + (it >> 3), it & 7); }
        } else {
            const unsigned long long B = 0x80912B34D6Full;
            for (int i = 0; i < 11; ++i) { const int it = (int)(B >> (4 * i)) & 15; fox_item(F, lds_generic, 2 * j + (it >> 3), it & 7); }
        }
    } else {
        for (int u = F.vcu; u < BATCH * 4; u += F.G) ret_item(F, lds_generic, u);
        for (int bh = F.vcu; bh < BATCH * 8; bh += F.G) for (int qb = 7; qb >= 0; --qb) fox_item(F, lds_generic, bh, qb);
    }
}

struct Args { const float* in[13]; float* out; unsigned char* ws; int ph_lo, ph_hi, li, pad; };
__global__ void __launch_bounds__(NWAVES * 64, 2) skel_fwd(Args args) {
    extern __shared__ __attribute__((aligned(16))) unsigned char lds[];
    Frame F;
    F.lds = (LAS unsigned char*)lds;
    F.MISC = (volatile LAS unsigned*)(F.lds + MISC_OFF);
    F.tid = threadIdx.x; F.lane = F.tid & 63; F.wave = __builtin_amdgcn_readfirstlane(F.tid >> 6);
    F.G = gridDim.x; { const int bx = blockIdx.x; F.vcu = (F.G % 8 == 0) ? (bx % 8) * (F.G / 8) + bx / 8 : bx; }
    unsigned char* ws = args.ws;
    F.ctl = (gu32*)(ws + WS_CTL);
    F.x = args.in[0]; F.c = args.in[1]; F.w_ada = args.in[2]; F.b_ada = args.in[3]; F.w_in = args.in[4]; F.b_forget = args.in[5]; F.qg = args.in[6]; F.kg = args.in[7];
    F.fog = args.in[8]; F.rog = args.in[9]; F.w_out = args.in[10]; F.w1 = args.in[11]; F.w2 = args.in[12]; F.out = args.out;
    F.Win_t = (bf16*)(ws + WS_WIN); F.Wout_t = (bf16*)(ws + WS_WOUT); F.W1_t = (bf16*)(ws + WS_W1); F.W2_t = (bf16*)(ws + WS_W2);
    F.wf = (float*)(ws + WS_WF); F.rope = (float*)(ws + WS_ROPE); F.logf = (float*)(ws + WS_LOGF); F.cum = (float*)(ws + WS_CUM); F.mod = (float*)(ws + WS_MOD);
    F.H = (bf16*)(ws + WS_H); F.MIXB = (bf16*)(ws + WS_MIX); F.PROJ = (bf16*)(ws + WS_PROJ); F.U = (bf16*)(ws + WS_U);
    for (int u = F.tid; u < (LDS_BYTES - LDSCTL_OFF) / 4; u += NWAVES * 64) ((LAS unsigned*)(F.lds + LDSCTL_OFF))[u] = 0u;
    __syncthreads();
    XcdBarrier bar; bar.bar = (unsigned*)(F.ctl + CW_BAR); bar.x = 0; bar.st = nullptr;
    if (N_LAUNCHES != PER_PHASE) bar = xcd_barrier_post((unsigned*)(F.ctl + CW_BAR), F.MISC + 8);
#define GRID_BAR() do { if (N_LAUNCHES != PER_PHASE) xcd_barrier(bar); } while (0)
    const int lo = args.ph_lo, hi = args.ph_hi;
#define IN(k) (lo <= (k) && (k) < hi)
#ifndef PROBE_DUP
#define PROBE_DUP 0
#endif
#define DUP(k) for (int rep_ = 0; rep_ < 1 + ((PROBE_DUP >> (k)) & 1); ++rep_)
#define BOTH(k) (IN(k) && IN((k) + 1))
    if (IN(0)) { p0_prologue(F); if (BOTH(0)) GRID_BAR(); }
    if (IN(1)) { DUP(1) norm_phase<true>(F, F.x, MOD_SCALE_M, MOD_SHIFT_M); if (BOTH(1)) GRID_BAR(); }
    if (IN(2)) {
        for (int seq = F.vcu; seq < BATCH * 8; seq += F.G) if (F.wave == 0) cumsum_seq(F, seq);
        pg8::Gemm g{F.H, F.Win_t, M, NPROJ, D}; pg8::StaticOrder S; S.init(M, NPROJ, F.G, (int)blockIdx.x);
        pg8::EpiProj E{F.PROJ, NPROJ, F.qg, F.kg, F.rope, EPS, C2};
        DUP(2) pg8::gemm_phase<pg8::EpiProj, pg8::StaticOrder, PG8_ALIGN, PG8_SP2>(F.lds + RING_OFF, g, S, E);
        if (BOTH(2)) GRID_BAR();
    }
    if (IN(4)) { DUP(4) mixer_phase(F, lds); if (BOTH(4)) GRID_BAR(); }
    if (IN(5)) {
        pg8::Gemm g{F.MIXB, F.Wout_t, M, D, D}; pg8::StaticOrder S; S.init(M, D, F.G, (int)blockIdx.x);
        pg8::EpiResGate<false> E{F.x, F.out, D, F.mod + MOD_GATE_M, NMOD, SEQ / 256};
        DUP(5) pg8::gemm_phase<pg8::EpiResGate<false>, pg8::StaticOrder, PG8_ALIGN, PG8_SP2>(F.lds + RING_OFF, g, S, E);
        if (BOTH(5)) GRID_BAR();
    }
    if (IN(6)) { DUP(6) norm_phase<false>(F, F.out, MOD_SCALE_F, MOD_SHIFT_F); if (BOTH(6)) GRID_BAR(); }
    if (IN(7)) {
        pg8::Gemm g{F.H, F.W1_t, M, FF, D}; pg8::StaticOrder S; S.init(M, FF, F.G, (int)blockIdx.x);
        pg8::EpiBf16<2> E{F.U, FF};
        DUP(7) pg8::gemm_phase<pg8::EpiBf16<2>, pg8::StaticOrder, PG8_ALIGN, PG8_SP2>(F.lds + RING_OFF, g, S, E);
        if (BOTH(7)) GRID_BAR();
    }
    if (IN(8)) {
        pg8::Gemm g{F.U, F.W2_t, M, D, FF}; pg8::StaticOrder S; S.init(M, D, F.G, (int)blockIdx.x);
        pg8::EpiResGate<true> E{F.out, F.out, D, F.mod + MOD_GATE_F, NMOD, SEQ / 256};
        pg8::gemm_phase<pg8::EpiResGate<true>, pg8::StaticOrder, PG8_ALIGN, PG8_SP2>(F.lds + RING_OFF, g, S, E);
    }
#undef IN
#undef BOTH
}

extern "C" void kernel_launch(void* const* d_in, const int* in_sizes, int n_in, void* d_out, int out_size, void* d_ws, size_t ws_size, hipStream_t stream) {
    static int grid = 0;
    if (grid == 0) {
        if (n_in != 13 || in_sizes[0] != M * D || out_size != M * D || ws_size < WS_END) { fprintf(stderr, "kernel_launch: unexpected shapes/workspace (n_in %d, in0 %d, out %d, ws %zu); nothing launched\n", n_in, n_in > 0 ? in_sizes[0] : -1, out_size, ws_size); grid = -1; return; }
        int dev = 0, cus = 0, per_cu = 0;
        if (hipGetDevice(&dev) != hipSuccess || hipDeviceGetAttribute(&cus, hipDeviceAttributeMultiprocessorCount, dev) != hipSuccess) { fprintf(stderr, "kernel_launch: device query failed\n"); grid = -1; return; }
        if (hipFuncSetAttribute((const void*)skel_fwd, hipFuncAttributeMaxDynamicSharedMemorySize, LDS_BYTES) != hipSuccess) { fprintf(stderr, "kernel_launch: hipFuncSetAttribute failed\n"); grid = -1; return; }
        if (hipOccupancyMaxActiveBlocksPerMultiprocessor(&per_cu, (const void*)skel_fwd, NWAVES * 64, LDS_BYTES) != hipSuccess || per_cu < 1) { fprintf(stderr, "kernel_launch: occupancy query reports %d workgroups per CU; nothing launched\n", per_cu); (void)hipGetLastError(); grid = -1; return; }
        grid = cus;
    }
    if (grid < 0) return;
    if (hipMemsetAsync((char*)d_ws + WS_CTL, 0, CTL_ZERO_BYTES, stream) != hipSuccess) { fprintf(stderr, "kernel_launch: hipMemsetAsync failed\n"); return; }
    Args a{};
    for (int i = 0; i < 13; ++i) a.in[i] = (const float*)d_in[i];
    a.out = (float*)d_out; a.ws = (unsigned char*)d_ws;
    for (int li = 0; li < N_LAUNCHES; ++li) {
        a.ph_lo = (N_LAUNCHES == PER_PHASE) ? li : 0; a.ph_hi = (N_LAUNCHES == PER_PHASE) ? li + 1 : PER_PHASE; a.li = li;
        hipLaunchKernelGGL(skel_fwd, dim3(grid), dim3(NWAVES * 64), LDS_BYTES, stream, a);
        const hipError_t le = hipPeekAtLastError();
        if (le != hipSuccess) { fprintf(stderr, "kernel_launch: launch %d failed: %s\n", li, hipGetErrorName(le)); break; }
    }
}
```
